# Optimizing an MI355X kernel written in HIP

```python
import jax
import jax.numpy as jnp
from jax import lax
import numpy as np

D_MODEL = 1024
BATCH = 2
SEQ = 16384
DEPTH = 2

HEAD_DIM = 64
RWKV_HEADS = 6
FOX_HEADS = 6
POOL_GROUPS = 4
POOL_GROUP_DIM = 64
POOL_WINDOWS = (2, 4, 8, 16)
RWKV_WIDTH = RWKV_HEADS * HEAD_DIM
FOX_WIDTH = FOX_HEADS * HEAD_DIM
POOL_WIDTH = POOL_GROUPS * POOL_GROUP_DIM
D_MIX = RWKV_WIDTH + FOX_WIDTH + POOL_WIDTH
DECAY_LORA = 64
ICLR_LORA = 64
VRES_LORA = 32
GATE_LORA = 160
FFN_HIDDEN = -(-8 * D_MODEL // (3 * 256)) * 256
Q_BLOCK = 128
RMS_EPS = 1e-6
GN_EPS = HEAD_DIM * 1e-5

RWKV_COLS = (RWKV_WIDTH, RWKV_WIDTH, RWKV_WIDTH, DECAY_LORA, ICLR_LORA, GATE_LORA)
RWKV_IN = sum(RWKV_COLS)
IN_COLS = (RWKV_IN, FOX_WIDTH, FOX_WIDTH, FOX_WIDTH, FOX_WIDTH, FOX_HEADS, POOL_WIDTH)
D_IN = sum(IN_COLS)

kernel_name = 'hybrid_rwkv7_fox_pool_block'


def _split_cols(t, sizes):
    idx, acc = [], 0
    for s in sizes[:-1]:
        acc += s
        idx.append(acc)
    return jnp.split(t, idx, axis=-1)


def _rms_f32(x, g):
    xf = x.astype(jnp.float32)
    y = xf * lax.rsqrt(jnp.mean(xf * xf, axis=-1, keepdims=True) + RMS_EPS)
    return y * g.astype(jnp.float32)


def rms_norm(x, g):
    return _rms_f32(x, g).astype(x.dtype)


def token_shift(t):
    return jnp.pad(t, ((0, 0), (1, 0), (0, 0)))[:, :-1]


def wkv7_scan(r, decay, k, v, kk, a):
    B, S, H, N = r.shape
    xs = tuple(jnp.moveaxis(t, 1, 0) for t in (r, decay, k, v, kk, a))

    def step(state, inp):
        r_t, w_t, k_t, v_t, kk_t, a_t = inp
        sa = jnp.einsum('bhvk,bhk->bhv', state, -kk_t)
        state = (state * w_t[:, :, None, :]
                 + sa[..., None] * (kk_t * a_t)[:, :, None, :]
                 + v_t[..., None] * k_t[:, :, None, :])
        return state, jnp.einsum('bhvk,bhk->bhv', state, r_t)

    init = jnp.zeros((B, H, N, N), jnp.float32)
    _, ys = lax.scan(step, init, xs)
    return jnp.moveaxis(ys, 0, 1)


def rwkv7_time_mix(feats, v_first, mu, w0, w2, a0, a2, g2, k_k, k_a, r_k, ln_w, ln_b, v_res):
    dtype = feats.dtype
    B, S, _ = feats.shape
    f = feats.astype(jnp.float32)
    f = f + (token_shift(f) - f) * mu.astype(jnp.float32)
    r, k, v, wd, ad, gd = _split_cols(f, RWKV_COLS)
    w_log = -jax.nn.softplus(-(w0 + jnp.tanh(wd) @ w2)) - 0.5
    decay = jnp.exp(-jnp.exp(w_log.astype(jnp.float32)))
    a = jax.nn.sigmoid(a0 + ad @ a2)
    g = jax.nn.sigmoid(gd) @ g2
    if v_res is None:
        v_first = v
    else:
        v0, v1, v2 = v_res
        v = v + (v_first - v) * jax.nn.sigmoid(v0 + (v @ v1) @ v2)
    heads = lambda t: t.astype(jnp.float32).reshape(B, S, RWKV_HEADS, HEAD_DIM)
    kk = heads(k * k_k)
    kk = kk / jnp.maximum(jnp.sqrt(jnp.sum(kk * kk, axis=-1, keepdims=True)), 1e-12)
    k = k * (1.0 + (a - 1.0) * k_a)
    r_h, k_h, v_h, w_h, a_h = heads(r), heads(k), heads(v), heads(decay), heads(a)
    y = wkv7_scan(r_h, w_h, k_h, v_h, kk, a_h)
    mean = jnp.mean(y, axis=-1, keepdims=True)
    var = jnp.mean(jnp.square(y - mean), axis=-1, keepdims=True)
    y = ((y - mean) * lax.rsqrt(var + GN_EPS)).reshape(B, S, RWKV_WIDTH) * ln_w + ln_b
    bonus = jnp.sum(r_h * k_h * r_k.astype(jnp.float32), axis=-1, keepdims=True) * v_h
    y = (y + bonus.reshape(B, S, RWKV_WIDTH)) * g
    return y.astype(dtype), v_first


def forgetting_attention(q, k, v, gate, f_logit, q_g, k_g, f_b):
    dtype = q.dtype
    B, S, _ = q.shape
    nb = S // Q_BLOCK
    split = lambda t: t.reshape(B, S, FOX_HEADS, HEAD_DIM)
    qh = _rms_f32(split(q), q_g)
    kh = _rms_f32(split(k), k_g)
    vh = split(v).astype(jnp.float32)
    log_f = jax.nn.log_sigmoid(f_logit.astype(jnp.float32) + f_b.astype(jnp.float32))
    cum = jnp.cumsum(log_f, axis=1)

    def blocks(t):
        return t.reshape(B, nb, Q_BLOCK, FOX_HEADS, HEAD_DIM).transpose(1, 0, 3, 2, 4)

    qb, kb, vb = blocks(qh), blocks(kh), blocks(vh)
    cb = cum.reshape(B, nb, Q_BLOCK, FOX_HEADS).transpose(1, 0, 3, 2)
    offs = jnp.arange(Q_BLOCK)
    scale = HEAD_DIM ** -0.5

    def one_query_block(args):
        q_i, c_i, i = args
        q_pos = i * Q_BLOCK + offs

        def kv_step(j, carry):
            m, l, acc = carry
            k_j, v_j, c_j = kb[j], vb[j], cb[j]
            k_pos = j * Q_BLOCK + offs
            s = (jnp.einsum('bhqd,bhkd->bhqk', q_i, k_j) * scale
                 + c_i[..., :, None] - c_j[..., None, :])
            s = jnp.where(k_pos[None, :] <= q_pos[:, None], s, -jnp.inf)
            m_new = jnp.maximum(m, jnp.max(s, axis=-1))
            p = jnp.exp(s - m_new[..., None])
            alpha = jnp.exp(m - m_new)
            return (m_new, l * alpha + jnp.sum(p, axis=-1),
                    acc * alpha[..., None] + jnp.einsum('bhqk,bhkd->bhqd', p, v_j))

        init = (jnp.full((B, FOX_HEADS, Q_BLOCK), -jnp.inf, jnp.float32),
                jnp.zeros((B, FOX_HEADS, Q_BLOCK), jnp.float32),
                jnp.zeros((B, FOX_HEADS, Q_BLOCK, HEAD_DIM), jnp.float32))
        _, l, acc = lax.fori_loop(jnp.int32(0), i + 1, kv_step, init)
        return acc / l[..., None]

    out = lax.map(one_query_block, (qb, cb, jnp.arange(nb, dtype=jnp.int32)))
    out = out.transpose(1, 0, 3, 2, 4).reshape(B, S, FOX_WIDTH)
    return (out * jax.nn.sigmoid(gate.astype(jnp.float32))).astype(dtype)


def multiscale_pool(p, w, scale):
    dtype = p.dtype
    B, S, _ = p.shape
    pf = p.astype(jnp.float32).reshape(B, S, POOL_GROUPS, POOL_GROUP_DIM)
    cs = jnp.cumsum(pf, axis=1)
    count_base = jnp.arange(1, S + 1, dtype=jnp.float32)
    outs = []
    for gi, win in enumerate(POOL_WINDOWS):
        c = cs[:, :, gi]
        lag = jnp.pad(c, ((0, 0), (win, 0), (0, 0)))[:, :S]
        mean = (c - lag) / jnp.minimum(count_base, float(win))[None, :, None]
        outs.append(mean - pf[:, :, gi])
    u = jnp.stack(outs, axis=2)
    y = jnp.einsum('bsgc,gcd->bsgd', u, w.astype(jnp.float32)).reshape(B, S, POOL_WIDTH)
    return (y * scale.astype(jnp.float32)).astype(dtype)


def setup_inputs(seed: int = 0) -> dict:
    key = jax.random.key(seed)
    ks = iter(jax.random.split(key, 32))
    L = DEPTH
    f32 = jnp.float32

    def nrm(shape, s):
        return s * jax.random.normal(next(ks), shape, f32)

    def unif(shape, lo, hi):
        return jax.random.uniform(next(ks), shape, f32, lo, hi)

    return {
        'x': nrm((BATCH, SEQ, D_MODEL), 1.0),
        'mix_pre_g': 1.0 + nrm((L, D_MODEL), 0.05),
        'mix_post_g': 1.0 + nrm((L, D_MODEL), 0.05),
        'ffn_pre_g': 1.0 + nrm((L, D_MODEL), 0.05),
        'ffn_post_g': 1.0 + nrm((L, D_MODEL), 0.05),
        'w_in': nrm((L, D_MODEL, D_IN), D_MODEL ** -0.5),
        'w_out': nrm((L, D_MIX, D_MODEL), D_MIX ** -0.5),
        'rwkv_mu': unif((L, RWKV_IN), 0.0, 1.0),
        'rwkv_w0': unif((L, RWKV_WIDTH), -5.0, 1.0),
        'rwkv_w2': nrm((L, DECAY_LORA, RWKV_WIDTH), 0.5 * DECAY_LORA ** -0.5),
        'rwkv_a0': nrm((L, RWKV_WIDTH), 0.1),
        'rwkv_a2': nrm((L, ICLR_LORA, RWKV_WIDTH), 0.5 * ICLR_LORA ** -0.5),
        'rwkv_g2': nrm((L, GATE_LORA, RWKV_WIDTH), GATE_LORA ** -0.5),
        'rwkv_v0': nrm((L - 1, RWKV_WIDTH), 0.1),
        'rwkv_v1': nrm((L - 1, RWKV_WIDTH, VRES_LORA), RWKV_WIDTH ** -0.5),
        'rwkv_v2': nrm((L - 1, VRES_LORA, RWKV_WIDTH), 0.5 * VRES_LORA ** -0.5),
        'rwkv_k_k': 0.85 + nrm((L, RWKV_WIDTH), 0.05),
        'rwkv_k_a': 1.0 + nrm((L, RWKV_WIDTH), 0.05),
        'rwkv_r_k': nrm((L, RWKV_HEADS, HEAD_DIM), 0.1),
        'rwkv_ln_w': 1.0 + nrm((L, RWKV_WIDTH), 0.05),
        'rwkv_ln_b': nrm((L, RWKV_WIDTH), 0.02),
        'fox_q_g': 1.0 + nrm((L, HEAD_DIM), 0.05),
        'fox_k_g': 1.0 + nrm((L, HEAD_DIM), 0.05),
        'fox_f_b': unif((L, FOX_HEADS), 1.0, 4.0),
        'pool_w': nrm((L, POOL_GROUPS, POOL_GROUP_DIM, POOL_GROUP_DIM), POOL_GROUP_DIM ** -0.5),
        'pool_scale': 1.0 + nrm((L, POOL_WIDTH), 0.1),
        'ffn_w_gu': nrm((L, D_MODEL, 2 * FFN_HIDDEN), D_MODEL ** -0.5),
        'ffn_w_down': nrm((L, FFN_HIDDEN, D_MODEL), FFN_HIDDEN ** -0.5),
    }


def reference(x, mix_pre_g, mix_post_g, ffn_pre_g, ffn_post_g, w_in, w_out,
              rwkv_mu, rwkv_w0, rwkv_w2, rwkv_a0, rwkv_a2, rwkv_g2, rwkv_v0, rwkv_v1, rwkv_v2,
              rwkv_k_k, rwkv_k_a, rwkv_r_k, rwkv_ln_w, rwkv_ln_b,
              fox_q_g, fox_k_g, fox_f_b, pool_w, pool_scale, ffn_w_gu, ffn_w_down):
    v_first = None
    for l in range(DEPTH):
        h = rms_norm(x, mix_pre_g[l])
        rwkv_in, fq, fk, fv, fg, ff, pool_in = _split_cols(h @ w_in[l], IN_COLS)
        v_res = None if l == 0 else (rwkv_v0[l - 1], rwkv_v1[l - 1], rwkv_v2[l - 1])
        y_rwkv, v_first = rwkv7_time_mix(rwkv_in, v_first, rwkv_mu[l], rwkv_w0[l], rwkv_w2[l],
                                         rwkv_a0[l], rwkv_a2[l], rwkv_g2[l], rwkv_k_k[l],
                                         rwkv_k_a[l], rwkv_r_k[l], rwkv_ln_w[l], rwkv_ln_b[l], v_res)
        y_fox = forgetting_attention(fq, fk, fv, fg, ff, fox_q_g[l], fox_k_g[l], fox_f_b[l])
        y_pool = multiscale_pool(pool_in, pool_w[l], pool_scale[l])
        mixed = jnp.concatenate([y_rwkv, y_fox, y_pool], axis=-1) @ w_out[l]
        x = x + rms_norm(mixed, mix_post_g[l])
        h = rms_norm(x, ffn_pre_g[l])
        gate, up = jnp.split(h @ ffn_w_gu[l], 2, axis=-1)
        f = (jax.nn.silu(gate) * up) @ ffn_w_down[l]
        x = x + rms_norm(f, ffn_post_g[l])
    return x
```

```cpp
#include <hip/hip_runtime.h>
#include <hip/hip_cooperative_groups.h>
#include <cstdio>
#include <cstdint>
namespace pg8 {
#define PG8_LAS __attribute__((address_space(3)))
typedef unsigned short bf16_t;
typedef short bf16x8 __attribute__((ext_vector_type(8)));
typedef float f32x4 __attribute__((ext_vector_type(4)));
typedef unsigned u32x4 __attribute__((ext_vector_type(4)));
constexpr int BM = 256, BK = 64, HALF = 128, HTB = HALF * BK * 2  , STAGE_BYTES = 8 * HTB, NXCD = 8, WGM = 8;

__host__ __device__ __forceinline__ int lds_byte(int r, int c) { const int st = (r >> 4) * 2 + (c >> 5), rr = r & 15, cc = c & 31, ob = rr * 64 + cc * 2; return st * 1024 + (ob ^ (((ob >> 9) & 1) << 5)); }
__host__ __device__ __forceinline__ void stage_rc(int b, int& R, int& C) { const int st = b / 1024, sb = b % 1024, swz = sb ^ (((sb >> 9) & 1) << 5); R = (st >> 1) * 16 + swz / 64; C = (st & 1) * 32 + (swz % 64) / 2; }
__host__ __device__ __forceinline__ int perm32(int rho) { const int n = rho >> 4, i = rho & 15; return 8 * (i >> 2) + 4 * n + (i & 3); }

struct Unit { int pm, pn; };
struct Gemm { const bf16_t* A; const bf16_t* Bt; int M, N, K; };

struct StaticOrder {
    int nM, nN, nwg, G, c;
    __host__ __device__ void init(int M, int N, int G_, int c_) { nM = M / BM; nN = N / BM; nwg = nM * nN; G = G_; c = c_; }
    __host__ __device__ bool next(int i, Unit& u) const {
        const long L = (long)i * G + c; if (L >= nwg) return false;
        int wgid = (int)L; { const int q = nwg / NXCD, r = nwg % NXCD, xcd = wgid % NXCD, off = wgid / NXCD; wgid = (xcd < r ? xcd * (q + 1) : r * (q + 1) + (xcd - r) * q) + off; }
        const int nig = WGM * nN, gid = wgid / nig, fm = gid * WGM, gsz = (nM - fm) < WGM ? (nM - fm) : WGM;
        u.pm = fm + ((wgid % nig) % gsz); u.pn = (wgid % nig) / gsz; return true;
    }
    __device__ __forceinline__ void a_ready(const Unit&) const {}
    __device__ __forceinline__ void done(const Unit&) const {}
};

__device__ __forceinline__ unsigned cvt_pk_bf16(float lo, float hi) { unsigned r; asm volatile("v_cvt_pk_bf16_f32 %0, %1, %2" : "=v"(r) : "v"(lo), "v"(hi)); return r; }
typedef float f32x2 __attribute__((ext_vector_type(2)));
template <class Epi, class Sched, bool ALIGN_EPI = false, bool SP2 = false>
__device__ __forceinline__ void gemm_phase(PG8_LAS unsigned char* lds, const Gemm g, const Sched& S, const Epi& E) {
    int tid_ = threadIdx.x; asm volatile("" : "+v"(tid_));
    const int tid = tid_, wid = __builtin_amdgcn_readfirstlane(tid >> 6), lane = tid & 63, wr = wid >> 2, wc = wid & 3, fr = lane & 15, fq = lane >> 4;
    const int K = g.K, nt = K / BK;
    unsigned voffA[2], voffB[2];
#pragma unroll
    for (int i = 0; i < 2; ++i) { int R, C; stage_rc(tid * 16 + i * 8192, R, C); const int Rb = Epi::PERM ? ((R & ~31) + perm32(R & 31)) : R;
        voffA[i] = (unsigned)(R * K + C) * 2u; voffB[i] = (unsigned)(Rb * K + C) * 2u; }
    const size_t kstep = (size_t)(BK * 2);
    const size_t hstep = (size_t)HALF * K * 2;
    const size_t tstep = 2 * hstep;
    const unsigned ldsw = (unsigned)wid * 1024u;
    const int aoff = lds_byte(wr * 64 + fr, fq * 8), boff = lds_byte(wc * 32 + fr, fq * 8);
#define PG8_SA(b, h) (((b) * 2 + (h)) * HTB)
#define PG8_SB(b, h) ((4 + (b) * 2 + (h)) * HTB)
#define PG8_STAGE(bufoff, gbase, voff) do { _Pragma("unroll") for (int _i = 0; _i < 2; ++_i) \
        __builtin_amdgcn_global_load_lds((const unsigned*)((const char*)(gbase) + (voff)[_i]), (PG8_LAS unsigned*)(lds + (bufoff) + ldsw + _i * 8192), 16, 0, 0); } while (0)
#define PG8_LDA(dst, b, h) do { _Pragma("unroll") for (int m = 0; m < 4; ++m) _Pragma("unroll") for (int k = 0; k < 2; ++k) dst[m][k] = *(const PG8_LAS bf16x8*)(lds + PG8_SA(b, h) + aoff + m * 2048 + k * 1024); } while (0)
#define PG8_LDB(dst, b, h) do { _Pragma("unroll") for (int n = 0; n < 2; ++n) _Pragma("unroll") for (int k = 0; k < 2; ++k) dst[n][k] = *(const PG8_LAS bf16x8*)(lds + PG8_SB(b, h) + boff + n * 2048 + k * 1024); } while (0)
#define PG8_MMA(ai, bj, At, Bt) do { __builtin_amdgcn_s_setprio(1); _Pragma("unroll") for (int m = 0; m < 4; ++m) _Pragma("unroll") for (int n = 0; n < 2; ++n) _Pragma("unroll") for (int k = 0; k < 2; ++k) \
        acc[ai][bj][m][n] = __builtin_amdgcn_mfma_f32_16x16x32_bf16(Bt[n][k], At[m][k], acc[ai][bj][m][n], 0, 0, 0); __builtin_amdgcn_s_setprio(0); } while (0)
#define PG8_WAIT_V(n) asm volatile("s_waitcnt vmcnt(" #n ")" ::: "memory")
#define PG8_WAIT_L(n) asm volatile("s_waitcnt lgkmcnt(" #n ")" ::: "memory")
#define PG8_BAR __builtin_amdgcn_s_barrier()
#define PG8_SCHED __builtin_amdgcn_sched_barrier(0)
    Unit cur, nxt; int ui = 0;
    if (!S.next(0, cur)) return;
    f32x4 acc[2][2][4][2];
#pragma unroll
    for (int a = 0; a < 2; ++a)
#pragma unroll
        for (int b = 0; b < 2; ++b)
#pragma unroll
            for (int m = 0; m < 4; ++m)
#pragma unroll
                for (int n = 0; n < 2; ++n) acc[a][b][m][n] = (f32x4){0.f, 0.f, 0.f, 0.f};
    bf16x8 At[4][2], B0[2][2], B1[2][2];
    const char* cA = (const char*)g.A + (size_t)cur.pm * tstep; const char* cB = (const char*)g.Bt + (size_t)cur.pn * tstep;
    S.a_ready(cur);
    if constexpr (SP2) {
        PG8_STAGE(PG8_SB(0, 0), cB, voffB); PG8_STAGE(PG8_SB(0, 1), cB + hstep, voffB); PG8_STAGE(PG8_SA(0, 0), cA, voffA); PG8_STAGE(PG8_SA(0, 1), cA + hstep, voffA);
        if (wr == 1) PG8_BAR;
        PG8_WAIT_V(2); PG8_BAR;
        PG8_STAGE(PG8_SB(1, 0), cB + kstep, voffB); PG8_STAGE(PG8_SA(1, 0), cA + kstep, voffA); PG8_STAGE(PG8_SB(1, 1), cB + hstep + kstep, voffB);
        PG8_WAIT_V(6); PG8_BAR;
    } else {
        PG8_STAGE(PG8_SB(0, 0), cB, voffB); PG8_STAGE(PG8_SA(0, 0), cA, voffA); PG8_STAGE(PG8_SB(0, 1), cB + hstep, voffB); PG8_STAGE(PG8_SA(0, 1), cA + hstep, voffA);
        if (wr == 1) PG8_BAR;
        PG8_WAIT_V(4); PG8_BAR;
        PG8_STAGE(PG8_SB(1, 0), cB + kstep, voffB); PG8_STAGE(PG8_SA(1, 0), cA + kstep, voffA); PG8_STAGE(PG8_SB(1, 1), cB + hstep + kstep, voffB);
        PG8_WAIT_V(6); PG8_BAR;
    }
    for (;;) {
        const bool has_next = S.next(ui + 1, nxt);
        const char* nA = has_next ? (const char*)g.A + (size_t)nxt.pm * tstep : cA; const char* nB = has_next ? (const char*)g.Bt + (size_t)nxt.pn * tstep : cB;
        for (int t = 0; t < nt; t += 2) {
            const bool last = (t == nt - 2);
            const char* a1 = cA + (size_t)(t + 1) * kstep;
            const char* a2 = last ? nA : cA + (size_t)(t + 2) * kstep; const char* b2 = last ? nB : cB + (size_t)(t + 2) * kstep;
            const char* a3 = a2 + kstep; const char* b3 = b2 + kstep;
            if (last && has_next) S.a_ready(nxt);
            if constexpr (SP2) {
            PG8_LDB(B0, 0, 0); PG8_LDB(B1, 0, 1); PG8_SCHED; PG8_LDA(At, 0, 0); PG8_STAGE(PG8_SA(1, 1), a1 + hstep, voffA);
            PG8_WAIT_V(8); PG8_WAIT_L(0); PG8_BAR; PG8_MMA(0, 0, At, B0); PG8_MMA(0, 1, At, B1); PG8_BAR; PG8_SCHED;
            PG8_LDA(At, 0, 1); PG8_STAGE(PG8_SB(0, 0), b2, voffB); PG8_STAGE(PG8_SB(0, 1), b2 + hstep, voffB); PG8_STAGE(PG8_SA(0, 0), a2, voffA);
            PG8_WAIT_V(8); PG8_WAIT_L(0); PG8_BAR; PG8_MMA(1, 0, At, B0); PG8_MMA(1, 1, At, B1); PG8_BAR; PG8_SCHED;
            PG8_LDB(B0, 1, 0); PG8_LDB(B1, 1, 1); PG8_SCHED; PG8_LDA(At, 1, 0); PG8_STAGE(PG8_SA(0, 1), a2 + hstep, voffA);
            PG8_WAIT_V(8); PG8_WAIT_L(0); PG8_BAR; PG8_MMA(0, 0, At, B0); PG8_MMA(0, 1, At, B1); PG8_BAR; PG8_SCHED;
            PG8_LDA(At, 1, 1); PG8_STAGE(PG8_SB(1, 0), b3, voffB); PG8_STAGE(PG8_SB(1, 1), b3 + hstep, voffB); PG8_STAGE(PG8_SA(1, 0), a3, voffA);
            PG8_WAIT_V(8); PG8_WAIT_L(0); PG8_BAR; PG8_MMA(1, 0, At, B0); PG8_MMA(1, 1, At, B1); PG8_BAR; PG8_SCHED;
            } else {
            PG8_LDB(B0, 0, 0); PG8_SCHED; PG8_LDA(At, 0, 0); PG8_STAGE(PG8_SA(1, 1), a1 + hstep, voffA);
            PG8_WAIT_L(8); PG8_BAR; PG8_WAIT_L(0); PG8_MMA(0, 0, At, B0); PG8_BAR; PG8_SCHED;
            PG8_LDB(B1, 0, 1); PG8_STAGE(PG8_SB(0, 0), b2, voffB);
            PG8_BAR; PG8_WAIT_L(0); PG8_MMA(0, 1, At, B1); PG8_BAR;
            PG8_LDA(At, 0, 1); PG8_STAGE(PG8_SA(0, 0), a2, voffA);
            PG8_BAR; PG8_WAIT_L(0); PG8_MMA(1, 0, At, B0); PG8_BAR; PG8_SCHED;
            PG8_STAGE(PG8_SB(0, 1), b2 + hstep, voffB);
            PG8_WAIT_V(6); PG8_BAR; PG8_MMA(1, 1, At, B1); PG8_BAR;
            PG8_LDB(B0, 1, 0); PG8_SCHED; PG8_LDA(At, 1, 0); PG8_STAGE(PG8_SA(0, 1), a2 + hstep, voffA);
            PG8_WAIT_L(8); PG8_BAR; PG8_WAIT_L(0); PG8_MMA(0, 0, At, B0); PG8_BAR; PG8_SCHED;
            PG8_LDB(B1, 1, 1); PG8_STAGE(PG8_SB(1, 0), b3, voffB);
            PG8_BAR; PG8_WAIT_L(0); PG8_MMA(0, 1, At, B1); PG8_BAR;
            PG8_LDA(At, 1, 1); PG8_STAGE(PG8_SA(1, 0), a3, voffA);
            PG8_BAR; PG8_WAIT_L(0); PG8_MMA(1, 0, At, B0); PG8_BAR; PG8_SCHED;
            PG8_STAGE(PG8_SB(1, 1), b3 + hstep, voffB);
            PG8_WAIT_V(6); PG8_BAR; PG8_MMA(1, 1, At, B1); PG8_BAR;
            }
        }
        if constexpr (ALIGN_EPI) { if (wr == 0) PG8_BAR; }
        if constexpr (!Epi::AFTER_DRAIN) { E(acc, cur, wr, wc, fr, fq); S.done(cur); }
        if (!has_next) break;
#pragma unroll
        for (int a = 0; a < 2; ++a)
#pragma unroll
            for (int b = 0; b < 2; ++b)
#pragma unroll
                for (int m = 0; m < 4; ++m)
#pragma unroll
                    for (int n = 0; n < 2; ++n) acc[a][b][m][n] = (f32x4){0.f, 0.f, 0.f, 0.f};
        cur = nxt; cA = nA; cB = nB; ++ui;
        if constexpr (ALIGN_EPI) { if (wr == 1) PG8_BAR; }
    }
    PG8_WAIT_V(0);
    if constexpr (!ALIGN_EPI) { if (wr == 0) PG8_BAR; }
    PG8_BAR;
    if constexpr (Epi::AFTER_DRAIN) { E.fused(acc, cur, wr, wc, fr, fq, lds, wid, lane); S.done(cur); }
#undef PG8_SA
#undef PG8_SB
#undef PG8_STAGE
#undef PG8_LDA
#undef PG8_LDB
#undef PG8_MMA
#undef PG8_WAIT_V
#undef PG8_WAIT_L
#undef PG8_BAR
#undef PG8_SCHED
}
}

namespace cg = cooperative_groups;
#ifndef MK_SINGLE
#define MK_SINGLE 0
#endif
constexpr int DM = 1024, BATCH = 2, SEQ = 16384, TT = BATCH * SEQ, DEPTH = 2;
constexpr int NH = 6, HD = 64, RW = 384, DIN = 3238, NIN = 3328, FFH = 2816;
constexpr int FRP = 1536, FXP = 1536, PLP = 256;
constexpr float RMS_EPS = 1e-6f, GN_EPS = 64e-5f, LOG2E = 1.4426950408889634f;
constexpr float QSCALE = 0.125f * 1.4426950408889634f;

constexpr size_t MiB = 1u << 20;
constexpr size_t WS_CTL = 0, CTL_BYTES = 1 * MiB;
constexpr size_t WS_WIN = 1 * MiB, WS_WOUT = 14 * MiB, WS_WGU = 18 * MiB, WS_WDN = 40 * MiB;
constexpr size_t WS_FR = 52 * MiB, WS_MIX = 52 * MiB, WS_H = 52 * MiB;
constexpr size_t WS_FXQ = 148 * MiB, WS_PL = 244 * MiB, WS_FF = 260 * MiB, WS_LF = 261 * MiB, WS_CUM = 262 * MiB;
constexpr size_t WS_VF = 264 * MiB;
constexpr size_t WS_RP = 288 * MiB, WS_HN = 288 * MiB, WS_TMP = 352 * MiB;
constexpr size_t RP_R = WS_RP, RP_K = WS_RP + 24 * MiB, RP_V = WS_RP + 48 * MiB, RP_KK = WS_RP + 72 * MiB, RP_BB = WS_RP + 96 * MiB, RP_LW = WS_RP + 120 * MiB, RP_G = WS_RP + 168 * MiB;
constexpr size_t WS_END = 480 * MiB;
constexpr size_t WIN_L = (size_t)NIN * DM, WOUT_L = (size_t)DM * DM, WGU_L = (size_t)2 * FFH * DM, WDN_L = (size_t)DM * FFH;

constexpr int LDS_BYTES = 147456;

#define LAS __attribute__((address_space(3)))
typedef unsigned short bf16;
typedef float f32x4 __attribute__((ext_vector_type(4)));
typedef float f32x16 __attribute__((ext_vector_type(16)));
typedef short bf16x8 __attribute__((ext_vector_type(8)));
typedef short s16x4 __attribute__((ext_vector_type(4)));
typedef unsigned u32x4 __attribute__((ext_vector_type(4)));
typedef unsigned u32x2 __attribute__((ext_vector_type(2)));

__device__ __forceinline__ float bf2f(bf16 v) { return __uint_as_float((unsigned)v << 16); }
__device__ __forceinline__ unsigned f2bf(float f) { unsigned u = __float_as_uint(f); return (u + 0x7fffu + ((u >> 16) & 1u)) >> 16; }
__device__ __forceinline__ unsigned pk2(float lo, float hi) { return f2bf(lo) | (f2bf(hi) << 16); }
__device__ __forceinline__ float sigmoidf_(float x) { return 1.0f / (1.0f + __expf(-x)); }
__device__ __forceinline__ float wave_sum(float v) {
#pragma unroll
    for (int o = 1; o < 64; o <<= 1) v += __shfl_xor(v, o);
    return v;
}

struct Args { const float* in[28]; float* out; unsigned char* ws; int lo, hi; };
typedef const Args __attribute__((address_space(4)))* ArgsP;
__device__ __forceinline__ Args get_args() {
#if defined(__HIP_DEVICE_COMPILE__)
    ArgsP p = (ArgsP)__builtin_amdgcn_kernarg_segment_ptr(); asm volatile("" : "+s"(p)); return *p;
#else
    return Args{};
#endif
}

namespace pg8 {
struct EpiInProj {
    static constexpr bool PERM = true, AFTER_DRAIN = false;
    bf16_t* FR; bf16_t* FXQ; bf16_t* PL; float* FF;
    __device__ __forceinline__ void operator()(const f32x4 (&acc)[2][2][4][2], const Unit& u, int wr, int wc, int fr, int fq) const {
        bf16_t* base; int ldc, colt;
        if (u.pn < 6) { base = FR; ldc = FRP; colt = u.pn * 256; }
        else if (u.pn < 12) { base = FXQ; ldc = FXP; colt = (u.pn - 6) * 256; }
        else { base = PL; ldc = PLP; colt = 0; }
        const int row0 = u.pm * BM + wr * 64 + fr, col0 = colt + wc * 32 + 8 * fq;
        const bool ffl = (u.pn == 5) && (wc == 1) && (fq == 0);
#pragma unroll
        for (int ai = 0; ai < 2; ++ai)
#pragma unroll
            for (int m = 0; m < 4; ++m) { const int row = row0 + ai * HALF + m * 16; bf16_t* rowp = base + (size_t)row * ldc + col0;
#pragma unroll
                for (int bj = 0; bj < 2; ++bj) { const f32x4 v0 = acc[ai][bj][m][0], v1 = acc[ai][bj][m][1];
                    u32x4 w; w.x = cvt_pk_bf16(v0[0], v0[1]); w.y = cvt_pk_bf16(v0[2], v0[3]); w.z = cvt_pk_bf16(v1[0], v1[1]); w.w = cvt_pk_bf16(v1[2], v1[3]);
                    *(u32x4*)(rowp + bj * HALF) = w;
                    if (bj == 1 && ffl) { *(f32x4*)(FF + (size_t)row * 8) = v0; *(f32x4*)(FF + (size_t)row * 8 + 4) = v1; } } }
    }
};
struct EpiSwiglu {
    static constexpr bool PERM = true, AFTER_DRAIN = false;
    bf16_t* H;
    __device__ __forceinline__ void operator()(const f32x4 (&acc)[2][2][4][2], const Unit& u, int wr, int wc, int fr, int fq) const {
        const int row0 = u.pm * BM + wr * 64 + fr, col0 = u.pn * 128 + wc * 32 + 8 * fq;
#pragma unroll
        for (int ai = 0; ai < 2; ++ai)
#pragma unroll
            for (int m = 0; m < 4; ++m) { bf16_t* rowp = H + (size_t)(row0 + ai * HALF + m * 16) * FFH + col0;
                float h[8];
#pragma unroll
                for (int n = 0; n < 2; ++n)
#pragma unroll
                    for (int e = 0; e < 4; ++e) { const float g = acc[ai][0][m][n][e], up = acc[ai][1][m][n][e]; h[n * 4 + e] = g / (1.0f + __expf(-g)) * up; }
                u32x4 w; w.x = cvt_pk_bf16(h[0], h[1]); w.y = cvt_pk_bf16(h[2], h[3]); w.z = cvt_pk_bf16(h[4], h[5]); w.w = cvt_pk_bf16(h[6], h[7]);
                *(u32x4*)rowp = w; }
    }
};
struct EpiF32 {
    static constexpr bool PERM = false, AFTER_DRAIN = false;
    float* O; int ldc;
    __device__ __forceinline__ void operator()(const f32x4 (&acc)[2][2][4][2], const Unit& u, int wr, int wc, int fr, int fq) const {
        const int row0 = u.pm * BM + wr * 64 + fr, col0 = u.pn * BM + wc * 32 + 4 * fq;
#pragma unroll
        for (int ai = 0; ai < 2; ++ai)
#pragma unroll
            for (int m = 0; m < 4; ++m) { float* rowp = O + (size_t)(row0 + ai * HALF + m * 16) * ldc + col0;
#pragma unroll
                for (int bj = 0; bj < 2; ++bj)
#pragma unroll
                    for (int n = 0; n < 2; ++n) *(f32x4*)(rowp + bj * HALF + n * 16) = acc[ai][bj][m][n]; }
    }
};
}

template <int MODE> __device__ __forceinline__ int wmap(int n) {
    if (MODE == 0) { if (n < 1440) return n; if (n < 2976) return n + 96; if (n < 2982) return n - 1536; return n + 90; }
    if (MODE == 1) { if (n < FFH) return 256 * (n >> 7) + (n & 127); const int j = n - FFH; return 256 * (j >> 7) + 128 + (j & 127); }
    return n;
}
template <int MODE> __device__ __forceinline__ void tr_item(const float* W, int K, int N, bf16* WT, LAS float* scr, int item, int lane) {
    const int nblk = (N + 31) / 32, kb = item / nblk, nb = item % nblk, k0 = 64 * kb, n0 = 32 * nb;
    const int nl = lane & 31, n = n0 + nl;
#pragma unroll 8
    for (int i = 0; i < 32; ++i) { const int kk = 2 * i + (lane >> 5); scr[kk * 33 + nl] = (n < N) ? W[(size_t)(k0 + kk) * N + n] : 0.f; }
    asm volatile("s_waitcnt lgkmcnt(0)" ::: "memory");
    const int c = lane & 7;
#pragma unroll
    for (int j = 0; j < 4; ++j) { const int nn = (lane >> 3) + 8 * j; const LAS float* s = scr + (8 * c) * 33 + nn;
        u32x4 o; o.x = pk2(s[0 * 33], s[1 * 33]); o.y = pk2(s[2 * 33], s[3 * 33]); o.z = pk2(s[4 * 33], s[5 * 33]); o.w = pk2(s[6 * 33], s[7 * 33]);
        if (n0 + nn < N) *(u32x4*)(WT + (size_t)wmap<MODE>(n0 + nn) * K + k0 + 8 * c) = o; }
    asm volatile("s_waitcnt lgkmcnt(0)" ::: "memory");
}
__device__ __forceinline__ void rms_row_bf16(const float* xrow, const float* g, bf16* orow, int lane) {
    const f32x4* xr = (const f32x4*)xrow + lane; const f32x4* gr = (const f32x4*)g + lane;
    f32x4 v[4]; float s = 0.f;
#pragma unroll
    for (int j = 0; j < 4; ++j) { v[j] = xr[64 * j]; s += (v[j].x * v[j].x + v[j].y * v[j].y) + (v[j].z * v[j].z + v[j].w * v[j].w); }
    const float rs = rsqrtf(wave_sum(s) * (1.f / DM) + RMS_EPS);
    unsigned long long* o8 = (unsigned long long*)orow + lane;
#pragma unroll
    for (int j = 0; j < 4; ++j) { const f32x4 gg = gr[64 * j];
        o8[64 * j] = (unsigned long long)pk2(v[j].x * rs * gg.x, v[j].y * rs * gg.y) | ((unsigned long long)pk2(v[j].z * rs * gg.z, v[j].w * rs * gg.w) << 32); }
}
__device__ __forceinline__ void phase_prologue(const Args& a, LAS unsigned char* lds, int tid, int G) {
    const int lane = tid & 63, wave = tid >> 6, gw = blockIdx.x * 8 + wave, NGW = G * 8;
    LAS float* scr = (LAS float*)(lds + wave * 16384);
    unsigned char* ws = a.ws;
    constexpr int I_IN = 16 * 102, I_GU = 16 * 176, I_OUT = 16 * 32, I_DN = 44 * 32, I_L = I_IN + I_GU + I_OUT + I_DN;
    for (int it = gw; it < DEPTH * I_L; it += NGW) {
        const int l = it / I_L; int r = it % I_L;
        if (r < I_IN) { tr_item<0>(a.in[5] + (size_t)l * DM * DIN, DM, DIN, (bf16*)(ws + WS_WIN) + l * WIN_L, scr, r, lane); continue; } r -= I_IN;
        if (r < I_GU) { tr_item<1>(a.in[26] + (size_t)l * DM * 2 * FFH, DM, 2 * FFH, (bf16*)(ws + WS_WGU) + l * WGU_L, scr, r, lane); continue; } r -= I_GU;
        if (r < I_OUT) { tr_item<2>(a.in[6] + (size_t)l * DM * DM, DM, DM, (bf16*)(ws + WS_WOUT) + l * WOUT_L, scr, r, lane); continue; } r -= I_OUT;
        tr_item<2>(a.in[27] + (size_t)l * FFH * DM, FFH, DM, (bf16*)(ws + WS_WDN) + l * WDN_L, scr, r, lane);
    }
    for (int i = blockIdx.x * 512 + tid; i < DEPTH * 90 * (DM / 8); i += G * 512) { const int l = i / (90 * (DM / 8)), r = i % (90 * (DM / 8));
        *(u32x4*)((bf16*)(ws + WS_WIN) + l * WIN_L + (size_t)(1446 + r / (DM / 8)) * DM + (r % (DM / 8)) * 8) = (u32x4){0u, 0u, 0u, 0u}; }
    for (int m = gw; m < TT; m += NGW) rms_row_bf16(a.in[0] + (size_t)m * DM, a.in[1], (bf16*)(ws + WS_HN) + (size_t)m * DM, lane);
}

__device__ __forceinline__ void phase_prep(const Args& a, int layer, LAS unsigned char* lds, int tid, int G) {
    unsigned char* ws = a.ws;
    const int lane = tid & 63, wave = tid >> 6;
    LAS float* F = (LAS float*)lds;
    LAS float* TV = (LAS float*)(lds + 92160);
    const bf16* FR = (const bf16*)(ws + WS_FR); bf16* FXQ = (bf16*)(ws + WS_FXQ); const float* FF = (const float*)(ws + WS_FF);
    const float* mu = a.in[7] + layer * 1440; const float* w0 = a.in[8] + layer * RW; const float* w2 = a.in[9] + (size_t)layer * 64 * RW;
    const float* a0 = a.in[10] + layer * RW; const float* a2 = a.in[11] + (size_t)layer * 64 * RW; const float* g2 = a.in[12] + (size_t)layer * 160 * RW;
    const float* v0 = a.in[13]; const float* v1 = a.in[14]; const float* v2 = a.in[15];
    const float* k_k = a.in[16] + layer * RW; const float* k_a = a.in[17] + layer * RW;
    const float* q_g = a.in[21] + layer * HD; const float* k_g = a.in[22] + layer * HD; const float* f_b = a.in[23] + layer * NH;
    bf16* R = (bf16*)(ws + RP_R); bf16* K = (bf16*)(ws + RP_K); bf16* V = (bf16*)(ws + (layer == 0 ? WS_VF : RP_V)); const bf16* VF = (const bf16*)(ws + WS_VF);
    bf16* KK = (bf16*)(ws + RP_KK); bf16* BB = (bf16*)(ws + RP_BB); float* LW = (float*)(ws + RP_LW); bf16* GG = (bf16*)(ws + RP_G);
    float* LF = (float*)(ws + WS_LF);
    for (int item = blockIdx.x; item < TT / 16; item += G) {
        const int t0 = item * 16, s0 = t0 % SEQ, bb = t0 / SEQ;
        __syncthreads();
        for (int idx = tid; idx < 16 * 1440; idx += 512) { const int tok = idx / 1440, c = idx % 1440;
            const float cur = bf2f(FR[(size_t)(t0 + tok) * FRP + c]); const float prev = (s0 + tok == 0) ? 0.f : bf2f(FR[(size_t)(t0 + tok - 1) * FRP + c]);
            float f = cur + (prev - cur) * mu[c];
            if (c >= 1152 && c < 1216) f = tanhf(f); else if (c >= 1280) f = sigmoidf_(f);
            F[idx] = f; }
        __syncthreads();
        if (layer > 0) { const int tok = tid >> 5, o = tid & 31; float s = 0.f;
            for (int c = 0; c < RW; ++c) s += F[tok * 1440 + 768 + c] * v1[c * 32 + o];
            TV[tok * 32 + o] = s; }
        __syncthreads();
        if (tid < RW) { const int j = tid;
            float aw[16], aa[16], ag[16];
#pragma unroll
            for (int t = 0; t < 16; ++t) { aw[t] = w0[j]; aa[t] = a0[j]; ag[t] = 0.f; }
            for (int i = 0; i < 64; ++i) { const float ww = w2[i * RW + j], av = a2[i * RW + j];
#pragma unroll
                for (int t = 0; t < 16; ++t) { aw[t] += F[t * 1440 + 1152 + i] * ww; aa[t] += F[t * 1440 + 1216 + i] * av; } }
            for (int i = 0; i < 160; ++i) { const float gv = g2[i * RW + j];
#pragma unroll
                for (int t = 0; t < 16; ++t) ag[t] += F[t * 1440 + 1280 + i] * gv; }
            const float kkj = k_k[j], kaj = k_a[j];
#pragma unroll
            for (int t = 0; t < 16; ++t) { const size_t o = (size_t)(t0 + t) * RW + j;
                const float lw = -0.6065306597126334f * sigmoidf_(aw[t]); const float av = sigmoidf_(aa[t]);
                const float r = F[t * 1440 + j], k = F[t * 1440 + 384 + j]; float v = F[t * 1440 + 768 + j];
                if (layer > 0) { float gs = v0[j];
#pragma unroll 8
                    for (int oo = 0; oo < 32; ++oo) gs += TV[t * 32 + oo] * v2[oo * RW + j];
                    v = v + (bf2f(VF[o]) - v) * sigmoidf_(gs); }
                const float kq = k * kkj; const float ss = wave_sum(kq * kq); const float kkn = kq / fmaxf(sqrtf(ss), 1e-12f);
                R[o] = (bf16)f2bf(r); K[o] = (bf16)f2bf(k * (1.0f + (av - 1.0f) * kaj)); V[o] = (bf16)f2bf(v); KK[o] = (bf16)f2bf(kkn); BB[o] = (bf16)f2bf(kkn * av);
                LW[o] = lw; GG[o] = (bf16)f2bf(ag[t]); }
        }
        for (int cmb = wave; cmb < 16 * NH * 2; cmb += 8) { const int tok = cmb / (NH * 2), rem = cmb % (NH * 2), hh = rem >> 1, which = rem & 1;
            bf16* p = FXQ + (size_t)(t0 + tok) * FXP + which * RW + hh * HD + lane; const float v = bf2f(*p);
            const float rs = rsqrtf(wave_sum(v * v) * (1.f / HD) + RMS_EPS);
            *p = (bf16)f2bf(which == 0 ? v * rs * q_g[lane] * QSCALE : v * rs * k_g[lane]); }
        if (tid < 16 * NH) { const int tok = tid / NH, hh = tid % NH; const float x = FF[(size_t)(t0 + tok) * 8 + hh] + f_b[hh];
            LF[(size_t)(bb * NH + hh) * SEQ + s0 + tok] = fminf(x, 0.f) - log1pf(__expf(-fabsf(x))); }
    }
}

__device__ __forceinline__ void phase_cumsum(const Args& a, LAS unsigned char* lds, int tid, int G) {
    const float* LF = (const float*)(a.ws + WS_LF); float* CUM = (float*)(a.ws + WS_CUM);
    LAS double* part = (LAS double*)lds;
    for (int ser = blockIdx.x; ser < BATCH * NH; ser += G) {
        const float* src = LF + (size_t)ser * SEQ + tid * 32; float* dst = CUM + (size_t)ser * SEQ + tid * 32;
        float v[32]; double s = 0.0;
#pragma unroll
        for (int i = 0; i < 32; ++i) { v[i] = src[i]; s += (double)v[i]; }
        __syncthreads(); part[tid] = s; __syncthreads();
        if (tid == 0) { double run = 0.0; for (int i = 0; i < 512; ++i) { const double t = part[i]; part[i] = run; run += t; } }
        __syncthreads();
        double run = part[tid];
#pragma unroll
        for (int i = 0; i < 32; ++i) { run += (double)v[i]; dst[i] = (float)run; }
    }
}

__device__ __forceinline__ float rl(float v, int k) { return __uint_as_float(__builtin_amdgcn_readlane(__float_as_uint(v), k)); }
__device__ __forceinline__ void rwkv_scan_naive(const Args& a, int layer, int bh, int lane) {
    unsigned char* ws = a.ws;
    const int b = bh / NH, h = bh % NH;
    const bf16* R = (const bf16*)(ws + RP_R); const bf16* K = (const bf16*)(ws + RP_K); const bf16* V = (const bf16*)(ws + (layer == 0 ? WS_VF : RP_V));
    const bf16* KK = (const bf16*)(ws + RP_KK); const bf16* BB = (const bf16*)(ws + RP_BB); float* LW = (float*)(ws + RP_LW);
    float S[64];
#pragma unroll
    for (int k = 0; k < 64; ++k) S[k] = 0.f;
    size_t o = (size_t)b * SEQ * RW + h * HD + lane;
    float rn = bf2f(R[o]), kn = bf2f(K[o]), vn = bf2f(V[o]), kkn = bf2f(KK[o]), bn = bf2f(BB[o]), wn = LW[o];
    for (int t = 0; t < SEQ; ++t) {
        const float rc = rn, kc = kn, vc = vn, kkc = -kkn, bc = bn, wc = __expf(wn);
        const size_t oc = o;
        if (t + 1 < SEQ) { o += RW; rn = bf2f(R[o]); kn = bf2f(K[o]); vn = bf2f(V[o]); kkn = bf2f(KK[o]); bn = bf2f(BB[o]); wn = LW[o]; }
        float sa0 = 0.f, sa1 = 0.f, sa2 = 0.f, sa3 = 0.f;
#pragma unroll
        for (int k = 0; k < 64; k += 4) { sa0 += S[k] * rl(kkc, k); sa1 += S[k + 1] * rl(kkc, k + 1); sa2 += S[k + 2] * rl(kkc, k + 2); sa3 += S[k + 3] * rl(kkc, k + 3); }
        const float sa = (sa0 + sa1) + (sa2 + sa3);
        float y0 = 0.f, y1 = 0.f, y2 = 0.f, y3 = 0.f;
#pragma unroll
        for (int k = 0; k < 64; k += 4) {
#pragma unroll
            for (int e = 0; e < 4; ++e) { S[k + e] = S[k + e] * rl(wc, k + e) + sa * rl(bc, k + e) + vc * rl(kc, k + e); }
            y0 += S[k] * rl(rc, k); y1 += S[k + 1] * rl(rc, k + 1); y2 += S[k + 2] * rl(rc, k + 2); y3 += S[k + 3] * rl(rc, k + 3); }
        LW[oc] = (y0 + y1) + (y2 + y3);
    }
}

__device__ __forceinline__ int crow(int r, int hi) { return (r & 3) + 8 * (r >> 2) + 4 * hi; }
__device__ __forceinline__ unsigned cvtpk(float lo, float hi) { typedef float f2 __attribute__((ext_vector_type(2))); typedef __bf16 b2 __attribute__((ext_vector_type(2))); f2 v = {lo, hi}; b2 b = __builtin_convertvector(v, b2); return __builtin_bit_cast(unsigned, b); }
__device__ __forceinline__ s16x4 vtr(LAS const unsigned char* p) { typedef short v4i16_t __attribute__((ext_vector_type(4))); return __builtin_bit_cast(s16x4, __builtin_amdgcn_ds_read_tr16_b64_v4i16((LAS v4i16_t*)p)); }
__device__ __forceinline__ void attn_unit(const Args& a, int b, int h, int qb, LAS unsigned char* lds, int tid) {
    unsigned char* ws = a.ws;
    const bf16* FXQ = (const bf16*)(ws + WS_FXQ); const float* CUM = (const float*)(ws + WS_CUM) + (size_t)(b * NH + h) * SEQ; bf16* MIX = (bf16*)(ws + WS_MIX);
    const int lane = tid & 63, wid = tid >> 6, r32 = lane & 31, hi = lane >> 5;
    const size_t rowbase = (size_t)b * SEQ; const int q0 = qb * 256, qrow = q0 + wid * 32 + r32;
    bf16x8 qf[4];
    { const bf16* qp = FXQ + (rowbase + qrow) * FXP + h * HD + hi * 8;
#pragma unroll
      for (int ks = 0; ks < 4; ++ks) qf[ks] = *(const bf16x8*)(qp + ks * 16); }
    f32x16 o0, o1;
#pragma unroll
    for (int r = 0; r < 16; ++r) { o0[r] = 0.f; o1[r] = 0.f; }
    float m = -INFINITY, l = 0.f;
    const int NT = (q0 + 256) / 64; const float cref = CUM[q0];
    LAS float* ckf = (LAS float*)(lds + 16384);
    for (int kt = 0; kt < NT; ++kt) {
        __syncthreads();
        { const int key = tid >> 3, ch = tid & 7; const size_t grow = rowbase + (size_t)kt * 64 + key;
          const u32x4 kv = *(const u32x4*)(FXQ + grow * FXP + RW + h * HD + ch * 8);
          const u32x4 vv = *(const u32x4*)(FXQ + grow * FXP + 2 * RW + h * HD + ch * 8);
          *(LAS u32x4*)(lds + key * 128 + ((ch ^ (key & 7)) * 16)) = kv;
          *(LAS u32x4*)(lds + 8192 + key * 128 + ch * 16) = vv;
          if (tid < 64) ckf[tid] = (CUM[kt * 64 + tid] - cref) * LOG2E; }
        __syncthreads();
        if (kt * 64 > q0 + wid * 32 + 31) continue;
        f32x16 s0, s1;
#pragma unroll
        for (int r = 0; r < 16; ++r) { s0[r] = 0.f; s1[r] = 0.f; }
#pragma unroll
        for (int ks = 0; ks < 4; ++ks) { const int co = ((2 * ks + hi) ^ (r32 & 7)) * 16;
            const bf16x8 a0 = *(const LAS bf16x8*)(lds + r32 * 128 + co); const bf16x8 a1 = *(const LAS bf16x8*)(lds + (32 + r32) * 128 + co);
            s0 = __builtin_amdgcn_mfma_f32_32x32x16_bf16(a0, qf[ks], s0, 0, 0, 0); s1 = __builtin_amdgcn_mfma_f32_32x32x16_bf16(a1, qf[ks], s1, 0, 0, 0); }
        const bool diag = (kt * 64 + 63 > q0 + wid * 32);
        float mx = -INFINITY;
#pragma unroll
        for (int r = 0; r < 16; ++r) { const int k0 = crow(r, hi); float v0 = s0[r] - ckf[k0], v1 = s1[r] - ckf[32 + k0];
            if (diag) { if (kt * 64 + k0 > qrow) v0 = -INFINITY; if (kt * 64 + 32 + k0 > qrow) v1 = -INFINITY; }
            s0[r] = v0; s1[r] = v1; mx = fmaxf(mx, fmaxf(v0, v1)); }
        mx = fmaxf(mx, __shfl_xor(mx, 32));
        const float mnew = fmaxf(m, mx), alpha = exp2f(m - mnew); m = mnew;
        float ps = 0.f;
#pragma unroll
        for (int r = 0; r < 16; ++r) { s0[r] = exp2f(s0[r] - m); s1[r] = exp2f(s1[r] - m); ps += s0[r] + s1[r]; }
        l = l * alpha + ps;
#pragma unroll
        for (int r = 0; r < 16; ++r) { o0[r] *= alpha; o1[r] *= alpha; }
        bf16x8 pf[4];
#pragma unroll
        for (int s = 0; s < 2; ++s) { u32x4 w0, w1;
            w0.x = cvtpk(s0[8 * s], s0[8 * s + 1]); w0.y = cvtpk(s0[8 * s + 2], s0[8 * s + 3]); w0.z = cvtpk(s0[8 * s + 4], s0[8 * s + 5]); w0.w = cvtpk(s0[8 * s + 6], s0[8 * s + 7]);
            w1.x = cvtpk(s1[8 * s], s1[8 * s + 1]); w1.y = cvtpk(s1[8 * s + 2], s1[8 * s + 3]); w1.z = cvtpk(s1[8 * s + 4], s1[8 * s + 5]); w1.w = cvtpk(s1[8 * s + 6], s1[8 * s + 7]);
            pf[s] = __builtin_bit_cast(bf16x8, w0); pf[2 + s] = __builtin_bit_cast(bf16x8, w1); }
        const int q4 = (lane & 15) >> 2, p4 = lane & 3;
        LAS const unsigned char* vb = lds + 8192 + (4 * hi + q4) * 128 + (16 * ((lane >> 4) & 1) + 4 * p4) * 2;
#pragma unroll
        for (int s = 0; s < 4; ++s) {
#pragma unroll
            for (int db = 0; db < 2; ++db) { const s16x4 lo = vtr(vb + s * 16 * 128 + db * 64), hh = vtr(vb + s * 16 * 128 + 8 * 128 + db * 64);
                const bf16x8 vf = (bf16x8){lo[0], lo[1], lo[2], lo[3], hh[0], hh[1], hh[2], hh[3]};
                if (db == 0) o0 = __builtin_amdgcn_mfma_f32_32x32x16_bf16(vf, pf[s], o0, 0, 0, 0); else o1 = __builtin_amdgcn_mfma_f32_32x32x16_bf16(vf, pf[s], o1, 0, 0, 0); } }
    }
    l += __shfl_xor(l, 32);
    const float inv = 1.0f / l;
    const bf16* gp = FXQ + (rowbase + qrow) * FXP + 3 * RW + h * HD; bf16* op = MIX + (rowbase + qrow) * DM + RW + h * HD;
#pragma unroll
    for (int db = 0; db < 2; ++db)
#pragma unroll
        for (int g = 0; g < 4; ++g) { const int d = 32 * db + 8 * g + 4 * hi; const u32x2 gv = *(const u32x2*)(gp + d);
            const float g0 = sigmoidf_(__uint_as_float(gv.x << 16)), g1 = sigmoidf_(__uint_as_float(gv.x & 0xffff0000u)), g2 = sigmoidf_(__uint_as_float(gv.y << 16)), g3 = sigmoidf_(__uint_as_float(gv.y & 0xffff0000u));
            const float x0 = (db == 0 ? o0[4 * g] : o1[4 * g]) * inv * g0, x1 = (db == 0 ? o0[4 * g + 1] : o1[4 * g + 1]) * inv * g1, x2 = (db == 0 ? o0[4 * g + 2] : o1[4 * g + 2]) * inv * g2, x3 = (db == 0 ? o0[4 * g + 3] : o1[4 * g + 3]) * inv * g3;
            u32x2 w; w.x = cvtpk(x0, x1); w.y = cvtpk(x2, x3); *(u32x2*)(op + d) = w; }
}

__device__ __forceinline__ void phase_pool(const Args& a, int layer, int gw, int NGW, int lane) {
    unsigned char* ws = a.ws; const bf16* PL = (const bf16*)(ws + WS_PL); bf16* MIX = (bf16*)(ws + WS_MIX);
    const float* pw = a.in[24] + (size_t)layer * 4 * 64 * 64; const float* psc = a.in[25] + layer * 256;
    for (int it = gw; it < TT * 4; it += NGW) { const int tok = it >> 2, g = it & 3, win = 2 << g, s = tok % SEQ, n = (s + 1 < win) ? s + 1 : win;
        float sum = 0.f, cur = 0.f;
        for (int i = 0; i < n; ++i) { const float v = bf2f(PL[(size_t)(tok - i) * PLP + g * 64 + lane]); if (i == 0) cur = v; sum += v; }
        const float u = sum / (float)n - cur; const float* wg = pw + g * 4096 + lane; float y = 0.f;
#pragma unroll
        for (int c = 0; c < 64; ++c) y += rl(u, c) * wg[c * 64];
        MIX[(size_t)tok * DM + 768 + g * 64 + lane] = (bf16)f2bf(y * psc[g * 64 + lane]); }
}

__device__ __forceinline__ void phase_rwkv_out(const Args& a, int layer, int gw, int NGW, int lane) {
    unsigned char* ws = a.ws;
    const bf16* R = (const bf16*)(ws + RP_R); const bf16* K = (const bf16*)(ws + RP_K); const bf16* V = (const bf16*)(ws + (layer == 0 ? WS_VF : RP_V));
    const float* Y = (const float*)(ws + RP_LW); const bf16* GG = (const bf16*)(ws + RP_G); bf16* MIX = (bf16*)(ws + WS_MIX);
    const float* r_k = a.in[18] + layer * RW; const float* ln_w = a.in[19] + layer * RW; const float* ln_b = a.in[20] + layer * RW;
    for (int it = gw; it < TT * NH; it += NGW) { const int tok = it / NH, h = it % NH, c = h * HD + lane; const size_t o = (size_t)tok * RW + c;
        const float y = Y[o]; const float mean = wave_sum(y) * (1.f / HD); const float d = y - mean; const float var = wave_sum(d * d) * (1.f / HD);
        const float yn = d * rsqrtf(var + GN_EPS) * ln_w[c] + ln_b[c];
        const float r = bf2f(R[o]), k = bf2f(K[o]), v = bf2f(V[o]); const float bonus = wave_sum(r * k * r_k[c]) * v;
        MIX[(size_t)tok * DM + c] = (bf16)f2bf((yn + bonus) * bf2f(GG[o])); }
}

__device__ __forceinline__ void phase_resnorm(const float* tmp, const float* xin, float* xout, const float* g1, const float* g2, bf16* hn, int gw, int NGW, int lane) {
    for (int m = gw; m < TT; m += NGW) {
        const f32x4* tr = (const f32x4*)(tmp + (size_t)m * DM) + lane; const f32x4* xr = (const f32x4*)(xin + (size_t)m * DM) + lane; f32x4* xo = (f32x4*)(xout + (size_t)m * DM) + lane;
        f32x4 v[4]; float s = 0.f;
#pragma unroll
        for (int j = 0; j < 4; ++j) { v[j] = tr[64 * j]; s += (v[j].x * v[j].x + v[j].y * v[j].y) + (v[j].z * v[j].z + v[j].w * v[j].w); }
        const float rs = rsqrtf(wave_sum(s) * (1.f / DM) + RMS_EPS); float s2 = 0.f;
#pragma unroll
        for (int j = 0; j < 4; ++j) { const f32x4 gg = ((const f32x4*)g1 + lane)[64 * j]; v[j] = xr[64 * j] + v[j] * rs * gg; xo[64 * j] = v[j];
            s2 += (v[j].x * v[j].x + v[j].y * v[j].y) + (v[j].z * v[j].z + v[j].w * v[j].w); }
        if (g2) { const float rs2 = rsqrtf(wave_sum(s2) * (1.f / DM) + RMS_EPS); unsigned long long* o8 = (unsigned long long*)(hn + (size_t)m * DM) + lane;
#pragma unroll
            for (int j = 0; j < 4; ++j) { const f32x4 gg = ((const f32x4*)g2 + lane)[64 * j];
                o8[64 * j] = (unsigned long long)pk2(v[j].x * rs2 * gg.x, v[j].y * rs2 * gg.y) | ((unsigned long long)pk2(v[j].z * rs2 * gg.z, v[j].w * rs2 * gg.w) << 32); } }
    }
}

constexpr int NPHASE = 1 + 10 * DEPTH;
__global__ void __launch_bounds__(512, 2) mega(Args a_unused) {
    extern __shared__ __attribute__((aligned(16))) unsigned char lds_raw[];
    LAS unsigned char* lds = (LAS unsigned char*)lds_raw;
    const int G = gridDim.x, NGW = G * 8;
    int lo, hi; { const Args a0 = get_args(); lo = a0.lo; hi = a0.hi; }
    for (int ph = lo; ph < hi; ++ph) {
        const Args a = get_args(); unsigned char* ws = a.ws;
        int tid = threadIdx.x; asm volatile("" : "+v"(tid));
        const int lane = tid & 63, wave = __builtin_amdgcn_readfirstlane(tid >> 6), gw = blockIdx.x * 8 + wave;
        if (ph > lo) {
#if MK_SINGLE
            cg::this_grid().sync();
#endif
        }
        if (ph == 0) { phase_prologue(a, lds, tid, G); continue; }
        const int layer = (ph - 1) / 10, sub = (ph - 1) % 10;
        const float* xin = layer == 0 ? a.in[0] : a.out;
        switch (sub) {
        case 0: { pg8::Gemm g{(const bf16*)(ws + WS_HN), (const bf16*)(ws + WS_WIN) + layer * WIN_L, TT, NIN, DM}; pg8::StaticOrder S; S.init(TT, NIN, G, (int)blockIdx.x);
                  pg8::EpiInProj E{(bf16*)(ws + WS_FR), (bf16*)(ws + WS_FXQ), (bf16*)(ws + WS_PL), (float*)(ws + WS_FF)};
                  pg8::gemm_phase<pg8::EpiInProj, pg8::StaticOrder, true, true>(lds, g, S, E); } break;
        case 1: phase_prep(a, layer, lds, tid, G); break;
        case 2: phase_cumsum(a, lds, tid, G); break;
        case 3: {
            if (blockIdx.x < BATCH * NH) { if (wave == 0) rwkv_scan_naive(a, layer, blockIdx.x, lane); }
            else { const int nb = G - BATCH * NH, bi = blockIdx.x - BATCH * NH;
                for (int u = bi; u < BATCH * NH * 64; u += nb) { const int qb = 63 - u / (BATCH * NH), bh = u % (BATCH * NH); attn_unit(a, bh / NH, bh % NH, qb, lds, tid); }
                phase_pool(a, layer, bi * 8 + wave, nb * 8, lane); }
        } break;
        case 4: phase_rwkv_out(a, layer, gw, NGW, lane); break;
        case 5: { pg8::Gemm g{(const bf16*)(ws + WS_MIX), (const bf16*)(ws + WS_WOUT) + layer * WOUT_L, TT, DM, DM}; pg8::StaticOrder S; S.init(TT, DM, G, (int)blockIdx.x);
                  pg8::EpiF32 E{(float*)(ws + WS_TMP), DM};
                  pg8::gemm_phase<pg8::EpiF32, pg8::StaticOrder, true, true>(lds, g, S, E); } break;
        case 6: phase_resnorm((const float*)(ws + WS_TMP), xin, a.out, a.in[2] + layer * DM, a.in[3] + layer * DM, (bf16*)(ws + WS_HN), gw, NGW, lane); break;
        case 7: { pg8::Gemm g{(const bf16*)(ws + WS_HN), (const bf16*)(ws + WS_WGU) + layer * WGU_L, TT, 2 * FFH, DM}; pg8::StaticOrder S; S.init(TT, 2 * FFH, G, (int)blockIdx.x);
                  pg8::EpiSwiglu E{(bf16*)(ws + WS_H)};
                  pg8::gemm_phase<pg8::EpiSwiglu, pg8::StaticOrder, true, true>(lds, g, S, E); } break;
        case 8: { pg8::Gemm g{(const bf16*)(ws + WS_H), (const bf16*)(ws + WS_WDN) + layer * WDN_L, TT, DM, FFH}; pg8::StaticOrder S; S.init(TT, DM, G, (int)blockIdx.x);
                  pg8::EpiF32 E{(float*)(ws + WS_TMP), DM};
                  pg8::gemm_phase<pg8::EpiF32, pg8::StaticOrder, true, true>(lds, g, S, E); } break;
        case 9: phase_resnorm((const float*)(ws + WS_TMP), a.out, a.out, a.in[4] + layer * DM, layer + 1 < DEPTH ? a.in[1] + (layer + 1) * DM : nullptr, (bf16*)(ws + WS_HN), gw, NGW, lane); break;
        }
    }
}

extern "C" void kernel_launch(void* const* d_in, const int* in_sizes, int n_in, void* d_out, int out_size, void* d_ws, size_t ws_size, hipStream_t stream) {
    static int grid = 0;
    if (grid == 0) {
        if (n_in != 28 || out_size != TT * DM || ws_size < WS_END) { fprintf(stderr, "kernel_launch: unexpected shapes (n_in %d out %d ws %zu)\n", n_in, out_size, ws_size); grid = -1; return; }
        int dev = 0, cus = 0, per_cu = 0;
        hipGetDevice(&dev); hipDeviceGetAttribute(&cus, hipDeviceAttributeMultiprocessorCount, dev);
        hipFuncSetAttribute((const void*)mega, hipFuncAttributeMaxDynamicSharedMemorySize, LDS_BYTES);
        hipOccupancyMaxActiveBlocksPerMultiprocessor(&per_cu, (const void*)mega, 512, LDS_BYTES);
        if (per_cu < 1) { fprintf(stderr, "kernel_launch: occupancy query says %d blocks per CU\n", per_cu); per_cu = 1; }
        (void)hipGetLastError();
        grid = cus * 1;
    }
    if (grid < 0) return;
    hipMemsetAsync((char*)d_ws + WS_CTL, 0, CTL_BYTES, stream);
    Args a{};
    for (int i = 0; i < 28; ++i) a.in[i] = (const float*)d_in[i];
    a.out = (float*)d_out; a.ws = (unsigned char*)d_ws;
#if MK_SINGLE
    a.lo = 0; a.hi = NPHASE;
    void* args[] = {&a};
    hipError_t e = hipLaunchCooperativeKernel((const void*)mega, dim3(grid), dim3(512), args, LDS_BYTES, stream);
    if (e != hipSuccess) fprintf(stderr, "cooperative launch failed: %s (grid %d)\n", hipGetErrorString(e), grid);
#else
    for (int ph = 0; ph < NPHASE; ++ph) { a.lo = ph; a.hi = ph + 1; hipLaunchKernelGGL(mega, dim3(grid), dim3(512), LDS_BYTES, stream, a); }
#endif
}
```

```cpp
#include <hip/hip_runtime.h>
#include <hip/hip_cooperative_groups.h>
#include <cstdio>
#include <cstdint>
namespace pg8 {
#define PG8_LAS __attribute__((address_space(3)))
typedef unsigned short bf16_t;
typedef short bf16x8 __attribute__((ext_vector_type(8)));
typedef float f32x4 __attribute__((ext_vector_type(4)));
typedef unsigned u32x4 __attribute__((ext_vector_type(4)));
constexpr int BM = 256, BK = 64, HALF = 128, HTB = HALF * BK * 2  , STAGE_BYTES = 8 * HTB, NXCD = 8, WGM = 8;

__host__ __device__ __forceinline__ int lds_byte(int r, int c) { const int st = (r >> 4) * 2 + (c >> 5), rr = r & 15, cc = c & 31, ob = rr * 64 + cc * 2; return st * 1024 + (ob ^ (((ob >> 9) & 1) << 5)); }
__host__ __device__ __forceinline__ void stage_rc(int b, int& R, int& C) { const int st = b / 1024, sb = b % 1024, swz = sb ^ (((sb >> 9) & 1) << 5); R = (st >> 1) * 16 + swz / 64; C = (st & 1) * 32 + (swz % 64) / 2; }
__host__ __device__ __forceinline__ int perm32(int rho) { const int n = rho >> 4, i = rho & 15; return 8 * (i >> 2) + 4 * n + (i & 3); }

struct Unit { int pm, pn; };
struct Gemm { const bf16_t* A; const bf16_t* Bt; int M, N, K; };

struct StaticOrder {
    int nM, nN, nwg, G, c;
    __host__ __device__ void init(int M, int N, int G_, int c_) { nM = M / BM; nN = N / BM; nwg = nM * nN; G = G_; c = c_; }
    __host__ __device__ bool next(int i, Unit& u) const {
        const long L = (long)i * G + c; if (L >= nwg) return false;
        int wgid = (int)L; { const int q = nwg / NXCD, r = nwg % NXCD, xcd = wgid % NXCD, off = wgid / NXCD; wgid = (xcd < r ? xcd * (q + 1) : r * (q + 1) + (xcd - r) * q) + off; }
        const int nig = WGM * nN, gid = wgid / nig, fm = gid * WGM, gsz = (nM - fm) < WGM ? (nM - fm) : WGM;
        u.pm = fm + ((wgid % nig) % gsz); u.pn = (wgid % nig) / gsz; return true;
    }
    __device__ __forceinline__ void a_ready(const Unit&) const {}
    __device__ __forceinline__ void done(const Unit&) const {}
};

__device__ __forceinline__ unsigned cvt_pk_bf16(float lo, float hi) { unsigned r; asm volatile("v_cvt_pk_bf16_f32 %0, %1, %2" : "=v"(r) : "v"(lo), "v"(hi)); return r; }
typedef float f32x2 __attribute__((ext_vector_type(2)));
template <class Epi, class Sched, bool ALIGN_EPI = false, bool SP2 = false>
__device__ __forceinline__ void gemm_phase(PG8_LAS unsigned char* lds, const Gemm g, const Sched& S, const Epi& E) {
    int tid_ = threadIdx.x; asm volatile("" : "+v"(tid_));
    const int tid = tid_, wid = __builtin_amdgcn_readfirstlane(tid >> 6), lane = tid & 63, wr = wid >> 2, wc = wid & 3, fr = lane & 15, fq = lane >> 4;
    const int K = g.K, nt = K / BK;
    unsigned voffA[2], voffB[2];
#pragma unroll
    for (int i = 0; i < 2; ++i) { int R, C; stage_rc(tid * 16 + i * 8192, R, C); const int Rb = Epi::PERM ? ((R & ~31) + perm32(R & 31)) : R;
        voffA[i] = (unsigned)(R * K + C) * 2u; voffB[i] = (unsigned)(Rb * K + C) * 2u; }
    const size_t kstep = (size_t)(BK * 2);
    const size_t hstep = (size_t)HALF * K * 2;
    const size_t tstep = 2 * hstep;
    const unsigned ldsw = (unsigned)wid * 1024u;
    const int aoff = lds_byte(wr * 64 + fr, fq * 8), boff = lds_byte(wc * 32 + fr, fq * 8);
#define PG8_SA(b, h) (((b) * 2 + (h)) * HTB)
#define PG8_SB(b, h) ((4 + (b) * 2 + (h)) * HTB)
#define PG8_STAGE(bufoff, gbase, voff) do { _Pragma("unroll") for (int _i = 0; _i < 2; ++_i) \
        __builtin_amdgcn_global_load_lds((const unsigned*)((const char*)(gbase) + (voff)[_i]), (PG8_LAS unsigned*)(lds + (bufoff) + ldsw + _i * 8192), 16, 0, 0); } while (0)
#define PG8_LDA(dst, b, h) do { _Pragma("unroll") for (int m = 0; m < 4; ++m) _Pragma("unroll") for (int k = 0; k < 2; ++k) dst[m][k] = *(const PG8_LAS bf16x8*)(lds + PG8_SA(b, h) + aoff + m * 2048 + k * 1024); } while (0)
#define PG8_LDB(dst, b, h) do { _Pragma("unroll") for (int n = 0; n < 2; ++n) _Pragma("unroll") for (int k = 0; k < 2; ++k) dst[n][k] = *(const PG8_LAS bf16x8*)(lds + PG8_SB(b, h) + boff + n * 2048 + k * 1024); } while (0)
#define PG8_MMA(ai, bj, At, Bt) do { __builtin_amdgcn_s_setprio(1); _Pragma("unroll") for (int m = 0; m < 4; ++m) _Pragma("unroll") for (int n = 0; n < 2; ++n) _Pragma("unroll") for (int k = 0; k < 2; ++k) \
        acc[ai][bj][m][n] = __builtin_amdgcn_mfma_f32_16x16x32_bf16(Bt[n][k], At[m][k], acc[ai][bj][m][n], 0, 0, 0); __builtin_amdgcn_s_setprio(0); } while (0)
#define PG8_WAIT_V(n) asm volatile("s_waitcnt vmcnt(" #n ")" ::: "memory")
#define PG8_WAIT_L(n) asm volatile("s_waitcnt lgkmcnt(" #n ")" ::: "memory")
#define PG8_BAR __builtin_amdgcn_s_barrier()
#define PG8_SCHED __builtin_amdgcn_sched_barrier(0)
    Unit cur, nxt; int ui = 0;
    if (!S.next(0, cur)) return;
    f32x4 acc[2][2][4][2];
#pragma unroll
    for (int a = 0; a < 2; ++a)
#pragma unroll
        for (int b = 0; b < 2; ++b)
#pragma unroll
            for (int m = 0; m < 4; ++m)
#pragma unroll
                for (int n = 0; n < 2; ++n) acc[a][b][m][n] = (f32x4){0.f, 0.f, 0.f, 0.f};
    bf16x8 At[4][2], B0[2][2], B1[2][2];
    const char* cA = (const char*)g.A + (size_t)cur.pm * tstep; const char* cB = (const char*)g.Bt + (size_t)cur.pn * tstep;
    S.a_ready(cur);
    if constexpr (SP2) {
        PG8_STAGE(PG8_SB(0, 0), cB, voffB); PG8_STAGE(PG8_SB(0, 1), cB + hstep, voffB); PG8_STAGE(PG8_SA(0, 0), cA, voffA); PG8_STAGE(PG8_SA(0, 1), cA + hstep, voffA);
        if (wr == 1) PG8_BAR;
        PG8_WAIT_V(2); PG8_BAR;
        PG8_STAGE(PG8_SB(1, 0), cB + kstep, voffB); PG8_STAGE(PG8_SA(1, 0), cA + kstep, voffA); PG8_STAGE(PG8_SB(1, 1), cB + hstep + kstep, voffB);
        PG8_WAIT_V(6); PG8_BAR;
    } else {
        PG8_STAGE(PG8_SB(0, 0), cB, voffB); PG8_STAGE(PG8_SA(0, 0), cA, voffA); PG8_STAGE(PG8_SB(0, 1), cB + hstep, voffB); PG8_STAGE(PG8_SA(0, 1), cA + hstep, voffA);
        if (wr == 1) PG8_BAR;
        PG8_WAIT_V(4); PG8_BAR;
        PG8_STAGE(PG8_SB(1, 0), cB + kstep, voffB); PG8_STAGE(PG8_SA(1, 0), cA + kstep, voffA); PG8_STAGE(PG8_SB(1, 1), cB + hstep + kstep, voffB);
        PG8_WAIT_V(6); PG8_BAR;
    }
    for (;;) {
        const bool has_next = S.next(ui + 1, nxt);
        const char* nA = has_next ? (const char*)g.A + (size_t)nxt.pm * tstep : cA; const char* nB = has_next ? (const char*)g.Bt + (size_t)nxt.pn * tstep : cB;
        for (int t = 0; t < nt; t += 2) {
            const bool last = (t == nt - 2);
            const char* a1 = cA + (size_t)(t + 1) * kstep;
            const char* a2 = last ? nA : cA + (size_t)(t + 2) * kstep; const char* b2 = last ? nB : cB + (size_t)(t + 2) * kstep;
            const char* a3 = a2 + kstep; const char* b3 = b2 + kstep;
            if (last && has_next) S.a_ready(nxt);
            if constexpr (SP2) {
            PG8_LDB(B0, 0, 0); PG8_LDB(B1, 0, 1); PG8_SCHED; PG8_LDA(At, 0, 0); PG8_STAGE(PG8_SA(1, 1), a1 + hstep, voffA);
            PG8_WAIT_V(8); PG8_WAIT_L(0); PG8_BAR; PG8_MMA(0, 0, At, B0); PG8_MMA(0, 1, At, B1); PG8_BAR; PG8_SCHED;
            PG8_LDA(At, 0, 1); PG8_STAGE(PG8_SB(0, 0), b2, voffB); PG8_STAGE(PG8_SB(0, 1), b2 + hstep, voffB); PG8_STAGE(PG8_SA(0, 0), a2, voffA);
            PG8_WAIT_V(8); PG8_WAIT_L(0); PG8_BAR; PG8_MMA(1, 0, At, B0); PG8_MMA(1, 1, At, B1); PG8_BAR; PG8_SCHED;
            PG8_LDB(B0, 1, 0); PG8_LDB(B1, 1, 1); PG8_SCHED; PG8_LDA(At, 1, 0); PG8_STAGE(PG8_SA(0, 1), a2 + hstep, voffA);
            PG8_WAIT_V(8); PG8_WAIT_L(0); PG8_BAR; PG8_MMA(0, 0, At, B0); PG8_MMA(0, 1, At, B1); PG8_BAR; PG8_SCHED;
            PG8_LDA(At, 1, 1); PG8_STAGE(PG8_SB(1, 0), b3, voffB); PG8_STAGE(PG8_SB(1, 1), b3 + hstep, voffB); PG8_STAGE(PG8_SA(1, 0), a3, voffA);
            PG8_WAIT_V(8); PG8_WAIT_L(0); PG8_BAR; PG8_MMA(1, 0, At, B0); PG8_MMA(1, 1, At, B1); PG8_BAR; PG8_SCHED;
            } else {
            PG8_LDB(B0, 0, 0); PG8_SCHED; PG8_LDA(At, 0, 0); PG8_STAGE(PG8_SA(1, 1), a1 + hstep, voffA);
            PG8_WAIT_L(8); PG8_BAR; PG8_WAIT_L(0); PG8_MMA(0, 0, At, B0); PG8_BAR; PG8_SCHED;
            PG8_LDB(B1, 0, 1); PG8_STAGE(PG8_SB(0, 0), b2, voffB);
            PG8_BAR; PG8_WAIT_L(0); PG8_MMA(0, 1, At, B1); PG8_BAR;
            PG8_LDA(At, 0, 1); PG8_STAGE(PG8_SA(0, 0), a2, voffA);
            PG8_BAR; PG8_WAIT_L(0); PG8_MMA(1, 0, At, B0); PG8_BAR; PG8_SCHED;
            PG8_STAGE(PG8_SB(0, 1), b2 + hstep, voffB);
            PG8_WAIT_V(6); PG8_BAR; PG8_MMA(1, 1, At, B1); PG8_BAR;
            PG8_LDB(B0, 1, 0); PG8_SCHED; PG8_LDA(At, 1, 0); PG8_STAGE(PG8_SA(0, 1), a2 + hstep, voffA);
            PG8_WAIT_L(8); PG8_BAR; PG8_WAIT_L(0); PG8_MMA(0, 0, At, B0); PG8_BAR; PG8_SCHED;
            PG8_LDB(B1, 1, 1); PG8_STAGE(PG8_SB(1, 0), b3, voffB);
            PG8_BAR; PG8_WAIT_L(0); PG8_MMA(0, 1, At, B1); PG8_BAR;
            PG8_LDA(At, 1, 1); PG8_STAGE(PG8_SA(1, 0), a3, voffA);
            PG8_BAR; PG8_WAIT_L(0); PG8_MMA(1, 0, At, B0); PG8_BAR; PG8_SCHED;
            PG8_STAGE(PG8_SB(1, 1), b3 + hstep, voffB);
            PG8_WAIT_V(6); PG8_BAR; PG8_MMA(1, 1, At, B1); PG8_BAR;
            }
        }
        if constexpr (ALIGN_EPI) { if (wr == 0) PG8_BAR; }
        if constexpr (!Epi::AFTER_DRAIN) { E(acc, cur, wr, wc, fr, fq); S.done(cur); }
        if (!has_next) break;
#pragma unroll
        for (int a = 0; a < 2; ++a)
#pragma unroll
            for (int b = 0; b < 2; ++b)
#pragma unroll
                for (int m = 0; m < 4; ++m)
#pragma unroll
                    for (int n = 0; n < 2; ++n) acc[a][b][m][n] = (f32x4){0.f, 0.f, 0.f, 0.f};
        cur = nxt; cA = nA; cB = nB; ++ui;
        if constexpr (ALIGN_EPI) { if (wr == 1) PG8_BAR; }
    }
    PG8_WAIT_V(0);
    if constexpr (!ALIGN_EPI) { if (wr == 0) PG8_BAR; }
    PG8_BAR;
    if constexpr (Epi::AFTER_DRAIN) { E.fused(acc, cur, wr, wc, fr, fq, lds, wid, lane); S.done(cur); }
#undef PG8_SA
#undef PG8_SB
#undef PG8_STAGE
#undef PG8_LDA
#undef PG8_LDB
#undef PG8_MMA
#undef PG8_WAIT_V
#undef PG8_WAIT_L
#undef PG8_BAR
#undef PG8_SCHED
}
}

namespace cg = cooperative_groups;
#ifndef MK_SINGLE
#define MK_SINGLE 1
#endif
constexpr int DM = 1024, BATCH = 2, SEQ = 16384, TT = BATCH * SEQ, DEPTH = 2;
constexpr int NH = 6, HD = 64, RW = 384, DIN = 3238, NIN = 3328, FFH = 2816;
constexpr int FRP = 1536, FXP = 1536, PLP = 256;
constexpr float RMS_EPS = 1e-6f, GN_EPS = 64e-5f, LOG2E = 1.4426950408889634f;
constexpr float QSCALE = 0.125f * 1.4426950408889634f;

constexpr size_t MiB = 1u << 20;
constexpr size_t WS_CTL = 0, CTL_BYTES = 1 * MiB;
constexpr size_t WS_WIN = 1 * MiB, WS_WOUT = 14 * MiB, WS_WGU = 18 * MiB, WS_WDN = 40 * MiB;
constexpr size_t WS_FR = 52 * MiB, WS_MIX = 52 * MiB, WS_H = 52 * MiB;
constexpr size_t WS_FXQ = 148 * MiB, WS_PL = 244 * MiB, WS_FF = 260 * MiB, WS_LF = 261 * MiB, WS_CUM = 262 * MiB;
constexpr size_t WS_VF = 264 * MiB;
constexpr size_t WS_RP = 288 * MiB, WS_HN = 288 * MiB, WS_TMP = 352 * MiB;
constexpr size_t RP_R = WS_RP, RP_K = WS_RP + 24 * MiB, RP_V = WS_RP + 48 * MiB, RP_KK = WS_RP + 72 * MiB, RP_BB = WS_RP + 96 * MiB, RP_LW = WS_RP + 120 * MiB, RP_G = WS_RP + 168 * MiB;
constexpr size_t WS_END = 480 * MiB;
constexpr size_t WIN_L = (size_t)NIN * DM, WOUT_L = (size_t)DM * DM, WGU_L = (size_t)2 * FFH * DM, WDN_L = (size_t)DM * FFH;

constexpr int LDS_BYTES = 147456;

#define LAS __attribute__((address_space(3)))
typedef unsigned short bf16;
typedef float f32x4 __attribute__((ext_vector_type(4)));
typedef float f32x16 __attribute__((ext_vector_type(16)));
typedef short bf16x8 __attribute__((ext_vector_type(8)));
typedef short s16x4 __attribute__((ext_vector_type(4)));
typedef unsigned u32x4 __attribute__((ext_vector_type(4)));
typedef unsigned u32x2 __attribute__((ext_vector_type(2)));

__device__ __forceinline__ float bf2f(bf16 v) { return __uint_as_float((unsigned)v << 16); }
__device__ __forceinline__ unsigned f2bf(float f) { unsigned u = __float_as_uint(f); return (u + 0x7fffu + ((u >> 16) & 1u)) >> 16; }
__device__ __forceinline__ unsigned pk2(float lo, float hi) { return f2bf(lo) | (f2bf(hi) << 16); }
__device__ __forceinline__ float sigmoidf_(float x) { return 1.0f / (1.0f + __expf(-x)); }
__device__ __forceinline__ float wave_sum(float v) {
#pragma unroll
    for (int o = 1; o < 64; o <<= 1) v += __shfl_xor(v, o);
    return v;
}

struct Args { const float* in[28]; float* out; unsigned char* ws; int lo, hi; };
typedef const Args __attribute__((address_space(4)))* ArgsP;
__device__ __forceinline__ Args get_args() {
#if defined(__HIP_DEVICE_COMPILE__)
    ArgsP p = (ArgsP)__builtin_amdgcn_kernarg_segment_ptr(); asm volatile("" : "+s"(p)); return *p;
#else
    return Args{};
#endif
}

namespace pg8 {
struct EpiInProj {
    static constexpr bool PERM = true, AFTER_DRAIN = false;
    bf16_t* FR; bf16_t* FXQ; bf16_t* PL; float* FF;
    __device__ __forceinline__ void operator()(const f32x4 (&acc)[2][2][4][2], const Unit& u, int wr, int wc, int fr, int fq) const {
        bf16_t* base; int ldc, colt;
        if (u.pn < 6) { base = FR; ldc = FRP; colt = u.pn * 256; }
        else if (u.pn < 12) { base = FXQ; ldc = FXP; colt = (u.pn - 6) * 256; }
        else { base = PL; ldc = PLP; colt = 0; }
        const int row0 = u.pm * BM + wr * 64 + fr, col0 = colt + wc * 32 + 8 * fq;
        const bool ffl = (u.pn == 5) && (wc == 1) && (fq == 0);
#pragma unroll
        for (int ai = 0; ai < 2; ++ai)
#pragma unroll
            for (int m = 0; m < 4; ++m) { const int row = row0 + ai * HALF + m * 16; bf16_t* rowp = base + (size_t)row * ldc + col0;
#pragma unroll
                for (int bj = 0; bj < 2; ++bj) { const f32x4 v0 = acc[ai][bj][m][0], v1 = acc[ai][bj][m][1];
                    u32x4 w; w.x = cvt_pk_bf16(v0[0], v0[1]); w.y = cvt_pk_bf16(v0[2], v0[3]); w.z = cvt_pk_bf16(v1[0], v1[1]); w.w = cvt_pk_bf16(v1[2], v1[3]);
                    *(u32x4*)(rowp + bj * HALF) = w;
                    if (bj == 1 && ffl) { *(f32x4*)(FF + (size_t)row * 8) = v0; *(f32x4*)(FF + (size_t)row * 8 + 4) = v1; } } }
    }
};
struct EpiSwiglu {
    static constexpr bool PERM = true, AFTER_DRAIN = false;
    bf16_t* H;
    __device__ __forceinline__ void operator()(const f32x4 (&acc)[2][2][4][2], const Unit& u, int wr, int wc, int fr, int fq) const {
        const int row0 = u.pm * BM + wr * 64 + fr, col0 = u.pn * 128 + wc * 32 + 8 * fq;
#pragma unroll
        for (int ai = 0; ai < 2; ++ai)
#pragma unroll
            for (int m = 0; m < 4; ++m) { bf16_t* rowp = H + (size_t)(row0 + ai * HALF + m * 16) * FFH + col0;
                float h[8];
#pragma unroll
                for (int n = 0; n < 2; ++n)
#pragma unroll
                    for (int e = 0; e < 4; ++e) { const float g = acc[ai][0][m][n][e], up = acc[ai][1][m][n][e]; h[n * 4 + e] = g / (1.0f + __expf(-g)) * up; }
                u32x4 w; w.x = cvt_pk_bf16(h[0], h[1]); w.y = cvt_pk_bf16(h[2], h[3]); w.z = cvt_pk_bf16(h[4], h[5]); w.w = cvt_pk_bf16(h[6], h[7]);
                *(u32x4*)rowp = w; }
    }
};
struct EpiF32 {
    static constexpr bool PERM = false, AFTER_DRAIN = false;
    float* O; int ldc;
    __device__ __forceinline__ void operator()(const f32x4 (&acc)[2][2][4][2], const Unit& u, int wr, int wc, int fr, int fq) const {
        const int row0 = u.pm * BM + wr * 64 + fr, col0 = u.pn * BM + wc * 32 + 4 * fq;
#pragma unroll
        for (int ai = 0; ai < 2; ++ai)
#pragma unroll
            for (int m = 0; m < 4; ++m) { float* rowp = O + (size_t)(row0 + ai * HALF + m * 16) * ldc + col0;
#pragma unroll
                for (int bj = 0; bj < 2; ++bj)
#pragma unroll
                    for (int n = 0; n < 2; ++n) *(f32x4*)(rowp + bj * HALF + n * 16) = acc[ai][bj][m][n]; }
    }
};
}

template <int MODE> __device__ __forceinline__ int wmap(int n) {
    if (MODE == 0) { if (n < 1440) return n; if (n < 2976) return n + 96; if (n < 2982) return n - 1536; return n + 90; }
    if (MODE == 1) { if (n < FFH) return 256 * (n >> 7) + (n & 127); const int j = n - FFH; return 256 * (j >> 7) + 128 + (j & 127); }
    return n;
}
template <int MODE> __device__ __forceinline__ void tr_item(const float* W, int K, int N, bf16* WT, LAS float* scr, int item, int lane) {
    const int nblk = (N + 31) / 32, kb = item / nblk, nb = item % nblk, k0 = 64 * kb, n0 = 32 * nb;
    const int nl = lane & 31, n = n0 + nl;
#pragma unroll 8
    for (int i = 0; i < 32; ++i) { const int kk = 2 * i + (lane >> 5); scr[kk * 33 + nl] = (n < N) ? W[(size_t)(k0 + kk) * N + n] : 0.f; }
    asm volatile("s_waitcnt lgkmcnt(0)" ::: "memory");
    const int c = lane & 7;
#pragma unroll
    for (int j = 0; j < 4; ++j) { const int nn = (lane >> 3) + 8 * j; const LAS float* s = scr + (8 * c) * 33 + nn;
        u32x4 o; o.x = pk2(s[0 * 33], s[1 * 33]); o.y = pk2(s[2 * 33], s[3 * 33]); o.z = pk2(s[4 * 33], s[5 * 33]); o.w = pk2(s[6 * 33], s[7 * 33]);
        if (n0 + nn < N) *(u32x4*)(WT + (size_t)wmap<MODE>(n0 + nn) * K + k0 + 8 * c) = o; }
    asm volatile("s_waitcnt lgkmcnt(0)" ::: "memory");
}
__device__ __forceinline__ void rms_row_bf16(const float* xrow, const float* g, bf16* orow, int lane) {
    const f32x4* xr = (const f32x4*)xrow + lane; const f32x4* gr = (const f32x4*)g + lane;
    f32x4 v[4]; float s = 0.f;
#pragma unroll
    for (int j = 0; j < 4; ++j) { v[j] = xr[64 * j]; s += (v[j].x * v[j].x + v[j].y * v[j].y) + (v[j].z * v[j].z + v[j].w * v[j].w); }
    const float rs = rsqrtf(wave_sum(s) * (1.f / DM) + RMS_EPS);
    unsigned long long* o8 = (unsigned long long*)orow + lane;
#pragma unroll
    for (int j = 0; j < 4; ++j) { const f32x4 gg = gr[64 * j];
        o8[64 * j] = (unsigned long long)pk2(v[j].x * rs * gg.x, v[j].y * rs * gg.y) | ((unsigned long long)pk2(v[j].z * rs * gg.z, v[j].w * rs * gg.w) << 32); }
}
__device__ __forceinline__ void phase_prologue(const Args& a, LAS unsigned char* lds, int tid, int G) {
    const int lane = tid & 63, wave = tid >> 6, gw = blockIdx.x * 8 + wave, NGW = G * 8;
    LAS float* scr = (LAS float*)(lds + wave * 16384);
    unsigned char* ws = a.ws;
    constexpr int I_IN = 16 * 102, I_GU = 16 * 176, I_OUT = 16 * 32, I_DN = 44 * 32, I_L = I_IN + I_GU + I_OUT + I_DN;
    for (int it = gw; it < DEPTH * I_L; it += NGW) {
        const int l = it / I_L; int r = it % I_L;
        if (r < I_IN) { tr_item<0>(a.in[5] + (size_t)l * DM * DIN, DM, DIN, (bf16*)(ws + WS_WIN) + l * WIN_L, scr, r, lane); continue; } r -= I_IN;
        if (r < I_GU) { tr_item<1>(a.in[26] + (size_t)l * DM * 2 * FFH, DM, 2 * FFH, (bf16*)(ws + WS_WGU) + l * WGU_L, scr, r, lane); continue; } r -= I_GU;
        if (r < I_OUT) { tr_item<2>(a.in[6] + (size_t)l * DM * DM, DM, DM, (bf16*)(ws + WS_WOUT) + l * WOUT_L, scr, r, lane); continue; } r -= I_OUT;
        tr_item<2>(a.in[27] + (size_t)l * FFH * DM, FFH, DM, (bf16*)(ws + WS_WDN) + l * WDN_L, scr, r, lane);
    }
    for (int i = blockIdx.x * 512 + tid; i < DEPTH * 90 * (DM / 8); i += G * 512) { const int l = i / (90 * (DM / 8)), r = i % (90 * (DM / 8));
        *(u32x4*)((bf16*)(ws + WS_WIN) + l * WIN_L + (size_t)(1446 + r / (DM / 8)) * DM + (r % (DM / 8)) * 8) = (u32x4){0u, 0u, 0u, 0u}; }
    for (int m = gw; m < TT; m += NGW) rms_row_bf16(a.in[0] + (size_t)m * DM, a.in[1], (bf16*)(ws + WS_HN) + (size_t)m * DM, lane);
}

__device__ __forceinline__ void phase_prep(const Args& a, int layer, LAS unsigned char* lds, int tid, int G) {
    unsigned char* ws = a.ws;
    const int lane = tid & 63, wave = tid >> 6;
    LAS float* F = (LAS float*)lds;
    LAS float* TV = (LAS float*)(lds + 92160);
    const bf16* FR = (const bf16*)(ws + WS_FR); bf16* FXQ = (bf16*)(ws + WS_FXQ); const float* FF = (const float*)(ws + WS_FF);
    const float* mu = a.in[7] + layer * 1440; const float* w0 = a.in[8] + layer * RW; const float* w2 = a.in[9] + (size_t)layer * 64 * RW;
    const float* a0 = a.in[10] + layer * RW; const float* a2 = a.in[11] + (size_t)layer * 64 * RW; const float* g2 = a.in[12] + (size_t)layer * 160 * RW;
    const float* v0 = a.in[13]; const float* v1 = a.in[14]; const float* v2 = a.in[15];
    const float* k_k = a.in[16] + layer * RW; const float* k_a = a.in[17] + layer * RW;
    const float* q_g = a.in[21] + layer * HD; const float* k_g = a.in[22] + layer * HD; const float* f_b = a.in[23] + layer * NH;
    bf16* R = (bf16*)(ws + RP_R); bf16* K = (bf16*)(ws + RP_K); bf16* V = (bf16*)(ws + (layer == 0 ? WS_VF : RP_V)); const bf16* VF = (const bf16*)(ws + WS_VF);
    bf16* KK = (bf16*)(ws + RP_KK); bf16* BB = (bf16*)(ws + RP_BB); float* LW = (float*)(ws + RP_LW); bf16* GG = (bf16*)(ws + RP_G);
    float* LF = (float*)(ws + WS_LF);
    for (int item = blockIdx.x; item < TT / 16; item += G) {
        const int t0 = item * 16, s0 = t0 % SEQ, bb = t0 / SEQ;
        __syncthreads();
        for (int idx = tid; idx < 16 * 1440; idx += 512) { const int tok = idx / 1440, c = idx % 1440;
            const float cur = bf2f(FR[(size_t)(t0 + tok) * FRP + c]); const float prev = (s0 + tok == 0) ? 0.f : bf2f(FR[(size_t)(t0 + tok - 1) * FRP + c]);
            float f = cur + (prev - cur) * mu[c];
            if (c >= 1152 && c < 1216) f = tanhf(f); else if (c >= 1280) f = sigmoidf_(f);
            F[idx] = f; }
        __syncthreads();
        if (layer > 0) { const int tok = tid >> 5, o = tid & 31; float s = 0.f;
            for (int c = 0; c < RW; ++c) s += F[tok * 1440 + 768 + c] * v1[c * 32 + o];
            TV[tok * 32 + o] = s; }
        __syncthreads();
        if (tid < RW) { const int j = tid;
            float aw[16], aa[16], ag[16];
#pragma unroll
            for (int t = 0; t < 16; ++t) { aw[t] = w0[j]; aa[t] = a0[j]; ag[t] = 0.f; }
            for (int i = 0; i < 64; ++i) { const float ww = w2[i * RW + j], av = a2[i * RW + j];
#pragma unroll
                for (int t = 0; t < 16; ++t) { aw[t] += F[t * 1440 + 1152 + i] * ww; aa[t] += F[t * 1440 + 1216 + i] * av; } }
            for (int i = 0; i < 160; ++i) { const float gv = g2[i * RW + j];
#pragma unroll
                for (int t = 0; t < 16; ++t) ag[t] += F[t * 1440 + 1280 + i] * gv; }
            const float kkj = k_k[j], kaj = k_a[j];
#pragma unroll
            for (int t = 0; t < 16; ++t) { const size_t o = (size_t)(t0 + t) * RW + j;
                const float lw = -0.6065306597126334f * sigmoidf_(aw[t]); const float av = sigmoidf_(aa[t]);
                const float r = F[t * 1440 + j], k = F[t * 1440 + 384 + j]; float v = F[t * 1440 + 768 + j];
                if (layer > 0) { float gs = v0[j];
#pragma unroll 8
                    for (int oo = 0; oo < 32; ++oo) gs += TV[t * 32 + oo] * v2[oo * RW + j];
                    v = v + (bf2f(VF[o]) - v) * sigmoidf_(gs); }
                const float kq = k * kkj; const float ss = wave_sum(kq * kq); const float kkn = kq / fmaxf(sqrtf(ss), 1e-12f);
                R[o] = (bf16)f2bf(r); K[o] = (bf16)f2bf(k * (1.0f + (av - 1.0f) * kaj)); V[o] = (bf16)f2bf(v); KK[o] = (bf16)f2bf(kkn); BB[o] = (bf16)f2bf(kkn * av);
                LW[o] = lw; GG[o] = (bf16)f2bf(ag[t]); }
        }
        for (int cmb = wave; cmb < 16 * NH * 2; cmb += 8) { const int tok = cmb / (NH * 2), rem = cmb % (NH * 2), hh = rem >> 1, which = rem & 1;
            bf16* p = FXQ + (size_t)(t0 + tok) * FXP + which * RW + hh * HD + lane; const float v = bf2f(*p);
            const float rs = rsqrtf(wave_sum(v * v) * (1.f / HD) + RMS_EPS);
            *p = (bf16)f2bf(which == 0 ? v * rs * q_g[lane] * QSCALE : v * rs * k_g[lane]); }
        if (tid < 16 * NH) { const int tok = tid / NH, hh = tid % NH; const float x = FF[(size_t)(t0 + tok) * 8 + hh] + f_b[hh];
            LF[(size_t)(bb * NH + hh) * SEQ + s0 + tok] = fminf(x, 0.f) - log1pf(__expf(-fabsf(x))); }
    }
}

__device__ __forceinline__ void phase_cumsum(const Args& a, LAS unsigned char* lds, int tid, int G) {
    const float* LF = (const float*)(a.ws + WS_LF); float* CUM = (float*)(a.ws + WS_CUM);
    LAS double* part = (LAS double*)lds;
    for (int ser = blockIdx.x; ser < BATCH * NH; ser += G) {
        const float* src = LF + (size_t)ser * SEQ + tid * 32; float* dst = CUM + (size_t)ser * SEQ + tid * 32;
        float v[32]; double s = 0.0;
#pragma unroll
        for (int i = 0; i < 32; ++i) { v[i] = src[i]; s += (double)v[i]; }
        __syncthreads(); part[tid] = s; __syncthreads();
        if (tid == 0) { double run = 0.0; for (int i = 0; i < 512; ++i) { const double t = part[i]; part[i] = run; run += t; } }
        __syncthreads();
        double run = part[tid];
#pragma unroll
        for (int i = 0; i < 32; ++i) { run += (double)v[i]; dst[i] = (float)run; }
    }
}

__device__ __forceinline__ float rl(float v, int k) { return __uint_as_float(__builtin_amdgcn_readlane(__float_as_uint(v), k)); }
__device__ __forceinline__ void rwkv_scan_naive(const Args& a, int layer, int bh, int lane) {
    unsigned char* ws = a.ws;
    const int b = bh / NH, h = bh % NH;
    const bf16* R = (const bf16*)(ws + RP_R); const bf16* K = (const bf16*)(ws + RP_K); const bf16* V = (const bf16*)(ws + (layer == 0 ? WS_VF : RP_V));
    const bf16* KK = (const bf16*)(ws + RP_KK); const bf16* BB = (const bf16*)(ws + RP_BB); float* LW = (float*)(ws + RP_LW);
    float S[64];
#pragma unroll
    for (int k = 0; k < 64; ++k) S[k] = 0.f;
    size_t o = (size_t)b * SEQ * RW + h * HD + lane;
    float rn = bf2f(R[o]), kn = bf2f(K[o]), vn = bf2f(V[o]), kkn = bf2f(KK[o]), bn = bf2f(BB[o]), wn = LW[o];
    for (int t = 0; t < SEQ; ++t) {
        const float rc = rn, kc = kn, vc = vn, kkc = -kkn, bc = bn, wc = __expf(wn);
        const size_t oc = o;
        if (t + 1 < SEQ) { o += RW; rn = bf2f(R[o]); kn = bf2f(K[o]); vn = bf2f(V[o]); kkn = bf2f(KK[o]); bn = bf2f(BB[o]); wn = LW[o]; }
        float sa0 = 0.f, sa1 = 0.f, sa2 = 0.f, sa3 = 0.f;
#pragma unroll
        for (int k = 0; k < 64; k += 4) { sa0 += S[k] * rl(kkc, k); sa1 += S[k + 1] * rl(kkc, k + 1); sa2 += S[k + 2] * rl(kkc, k + 2); sa3 += S[k + 3] * rl(kkc, k + 3); }
        const float sa = (sa0 + sa1) + (sa2 + sa3);
        float y0 = 0.f, y1 = 0.f, y2 = 0.f, y3 = 0.f;
#pragma unroll
        for (int k = 0; k < 64; k += 4) {
#pragma unroll
            for (int e = 0; e < 4; ++e) { S[k + e] = S[k + e] * rl(wc, k + e) + sa * rl(bc, k + e) + vc * rl(kc, k + e); }
            y0 += S[k] * rl(rc, k); y1 += S[k + 1] * rl(rc, k + 1); y2 += S[k + 2] * rl(rc, k + 2); y3 += S[k + 3] * rl(rc, k + 3); }
        LW[oc] = (y0 + y1) + (y2 + y3);
    }
}

__device__ __forceinline__ int crow(int r, int hi) { return (r & 3) + 8 * (r >> 2) + 4 * hi; }
__device__ __forceinline__ unsigned cvtpk(float lo, float hi) { typedef float f2 __attribute__((ext_vector_type(2))); typedef __bf16 b2 __attribute__((ext_vector_type(2))); f2 v = {lo, hi}; b2 b = __builtin_convertvector(v, b2); return __builtin_bit_cast(unsigned, b); }
__device__ __forceinline__ s16x4 vtr(LAS const unsigned char* p) { typedef short v4i16_t __attribute__((ext_vector_type(4))); return __builtin_bit_cast(s16x4, __builtin_amdgcn_ds_read_tr16_b64_v4i16((LAS v4i16_t*)p)); }
__device__ __forceinline__ void attn_unit(const Args& a, int b, int h, int qb, LAS unsigned char* lds, int tid) {
    unsigned char* ws = a.ws;
    const bf16* FXQ = (const bf16*)(ws + WS_FXQ); const float* CUM = (const float*)(ws + WS_CUM) + (size_t)(b * NH + h) * SEQ; bf16* MIX = (bf16*)(ws + WS_MIX);
    const int lane = tid & 63, wid = tid >> 6, r32 = lane & 31, hi = lane >> 5;
    const size_t rowbase = (size_t)b * SEQ; const int q0 = qb * 256, qrow = q0 + wid * 32 + r32;
    bf16x8 qf[4];
    { const bf16* qp = FXQ + (rowbase + qrow) * FXP + h * HD + hi * 8;
#pragma unroll
      for (int ks = 0; ks < 4; ++ks) qf[ks] = *(const bf16x8*)(qp + ks * 16); }
    f32x16 o0, o1;
#pragma unroll
    for (int r = 0; r < 16; ++r) { o0[r] = 0.f; o1[r] = 0.f; }
    float m = -INFINITY, l = 0.f;
    const int NT = (q0 + 256) / 64; const float cref = CUM[q0];
    LAS float* ckf = (LAS float*)(lds + 16384);
    for (int kt = 0; kt < NT; ++kt) {
        __syncthreads();
        { const int key = tid >> 3, ch = tid & 7; const size_t grow = rowbase + (size_t)kt * 64 + key;
          const u32x4 kv = *(const u32x4*)(FXQ + grow * FXP + RW + h * HD + ch * 8);
          const u32x4 vv = *(const u32x4*)(FXQ + grow * FXP + 2 * RW + h * HD + ch * 8);
          *(LAS u32x4*)(lds + key * 128 + ((ch ^ (key & 7)) * 16)) = kv;
          *(LAS u32x4*)(lds + 8192 + key * 128 + ch * 16) = vv;
          if (tid < 64) ckf[tid] = (CUM[kt * 64 + tid] - cref) * LOG2E; }
        __syncthreads();
        if (kt * 64 > q0 + wid * 32 + 31) continue;
        f32x16 s0, s1;
#pragma unroll
        for (int r = 0; r < 16; ++r) { s0[r] = 0.f; s1[r] = 0.f; }
#pragma unroll
        for (int ks = 0; ks < 4; ++ks) { const int co = ((2 * ks + hi) ^ (r32 & 7)) * 16;
            const bf16x8 a0 = *(const LAS bf16x8*)(lds + r32 * 128 + co); const bf16x8 a1 = *(const LAS bf16x8*)(lds + (32 + r32) * 128 + co);
            s0 = __builtin_amdgcn_mfma_f32_32x32x16_bf16(a0, qf[ks], s0, 0, 0, 0); s1 = __builtin_amdgcn_mfma_f32_32x32x16_bf16(a1, qf[ks], s1, 0, 0, 0); }
        const bool diag = (kt * 64 + 63 > q0 + wid * 32);
        float mx = -INFINITY;
#pragma unroll
        for (int r = 0; r < 16; ++r) { const int k0 = crow(r, hi); float v0 = s0[r] - ckf[k0], v1 = s1[r] - ckf[32 + k0];
            if (diag) { if (kt * 64 + k0 > qrow) v0 = -INFINITY; if (kt * 64 + 32 + k0 > qrow) v1 = -INFINITY; }
            s0[r] = v0; s1[r] = v1; mx = fmaxf(mx, fmaxf(v0, v1)); }
        mx = fmaxf(mx, __shfl_xor(mx, 32));
        const float mnew = fmaxf(m, mx), alpha = exp2f(m - mnew); m = mnew;
        float ps = 0.f;
#pragma unroll
        for (int r = 0; r < 16; ++r) { s0[r] = exp2f(s0[r] - m); s1[r] = exp2f(s1[r] - m); ps += s0[r] + s1[r]; }
        l = l * alpha + ps;
#pragma unroll
        for (int r = 0; r < 16; ++r) { o0[r] *= alpha; o1[r] *= alpha; }
        bf16x8 pf[4];
#pragma unroll
        for (int s = 0; s < 2; ++s) { u32x4 w0, w1;
            w0.x = cvtpk(s0[8 * s], s0[8 * s + 1]); w0.y = cvtpk(s0[8 * s + 2], s0[8 * s + 3]); w0.z = cvtpk(s0[8 * s + 4], s0[8 * s + 5]); w0.w = cvtpk(s0[8 * s + 6], s0[8 * s + 7]);
            w1.x = cvtpk(s1[8 * s], s1[8 * s + 1]); w1.y = cvtpk(s1[8 * s + 2], s1[8 * s + 3]); w1.z = cvtpk(s1[8 * s + 4], s1[8 * s + 5]); w1.w = cvtpk(s1[8 * s + 6], s1[8 * s + 7]);
            pf[s] = __builtin_bit_cast(bf16x8, w0); pf[2 + s] = __builtin_bit_cast(bf16x8, w1); }
        const int q4 = (lane & 15) >> 2, p4 = lane & 3;
        LAS const unsigned char* vb = lds + 8192 + (4 * hi + q4) * 128 + (16 * ((lane >> 4) & 1) + 4 * p4) * 2;
#pragma unroll
        for (int s = 0; s < 4; ++s) {
#pragma unroll
            for (int db = 0; db < 2; ++db) { const s16x4 lo = vtr(vb + s * 16 * 128 + db * 64), hh = vtr(vb + s * 16 * 128 + 8 * 128 + db * 64);
                const bf16x8 vf = (bf16x8){lo[0], lo[1], lo[2], lo[3], hh[0], hh[1], hh[2], hh[3]};
                if (db == 0) o0 = __builtin_amdgcn_mfma_f32_32x32x16_bf16(vf, pf[s], o0, 0, 0, 0); else o1 = __builtin_amdgcn_mfma_f32_32x32x16_bf16(vf, pf[s], o1, 0, 0, 0); } }
    }
    l += __shfl_xor(l, 32);
    const float inv = 1.0f / l;
    const bf16* gp = FXQ + (rowbase + qrow) * FXP + 3 * RW + h * HD; bf16* op = MIX + (rowbase + qrow) * DM + RW + h * HD;
#pragma unroll
    for (int db = 0; db < 2; ++db)
#pragma unroll
        for (int g = 0; g < 4; ++g) { const int d = 32 * db + 8 * g + 4 * hi; const u32x2 gv = *(const u32x2*)(gp + d);
            const float g0 = sigmoidf_(__uint_as_float(gv.x << 16)), g1 = sigmoidf_(__uint_as_float(gv.x & 0xffff0000u)), g2 = sigmoidf_(__uint_as_float(gv.y << 16)), g3 = sigmoidf_(__uint_as_float(gv.y & 0xffff0000u));
            const float x0 = (db == 0 ? o0[4 * g] : o1[4 * g]) * inv * g0, x1 = (db == 0 ? o0[4 * g + 1] : o1[4 * g + 1]) * inv * g1, x2 = (db == 0 ? o0[4 * g + 2] : o1[4 * g + 2]) * inv * g2, x3 = (db == 0 ? o0[4 * g + 3] : o1[4 * g + 3]) * inv * g3;
            u32x2 w; w.x = cvtpk(x0, x1); w.y = cvtpk(x2, x3); *(u32x2*)(op + d) = w; }
}

__device__ __forceinline__ void phase_pool(const Args& a, int layer, int gw, int NGW, int lane) {
    unsigned char* ws = a.ws; const bf16* PL = (const bf16*)(ws + WS_PL); bf16* MIX = (bf16*)(ws + WS_MIX);
    const float* pw = a.in[24] + (size_t)layer * 4 * 64 * 64; const float* psc = a.in[25] + layer * 256;
    for (int it = gw; it < TT * 4; it += NGW) { const int tok = it >> 2, g = it & 3, win = 2 << g, s = tok % SEQ, n = (s + 1 < win) ? s + 1 : win;
        float sum = 0.f, cur = 0.f;
        for (int i = 0; i < n; ++i) { const float v = bf2f(PL[(size_t)(tok - i) * PLP + g * 64 + lane]); if (i == 0) cur = v; sum += v; }
        const float u = sum / (float)n - cur; const float* wg = pw + g * 4096 + lane; float y = 0.f;
#pragma unroll
        for (int c = 0; c < 64; ++c) y += rl(u, c) * wg[c * 64];
        MIX[(size_t)tok * DM + 768 + g * 64 + lane] = (bf16)f2bf(y * psc[g * 64 + lane]); }
}

__device__ __forceinline__ void phase_rwkv_out(const Args& a, int layer, int gw, int NGW, int lane) {
    unsigned char* ws = a.ws;
    const bf16* R = (const bf16*)(ws + RP_R); const bf16* K = (const bf16*)(ws + RP_K); const bf16* V = (const bf16*)(ws + (layer == 0 ? WS_VF : RP_V));
    const float* Y = (const float*)(ws + RP_LW); const bf16* GG = (const bf16*)(ws + RP_G); bf16* MIX = (bf16*)(ws + WS_MIX);
    const float* r_k = a.in[18] + layer * RW; const float* ln_w = a.in[19] + layer * RW; const float* ln_b = a.in[20] + layer * RW;
    for (int it = gw; it < TT * NH; it += NGW) { const int tok = it / NH, h = it % NH, c = h * HD + lane; const size_t o = (size_t)tok * RW + c;
        const float y = Y[o]; const float mean = wave_sum(y) * (1.f / HD); const float d = y - mean; const float var = wave_sum(d * d) * (1.f / HD);
        const float yn = d * rsqrtf(var + GN_EPS) * ln_w[c] + ln_b[c];
        const float r = bf2f(R[o]), k = bf2f(K[o]), v = bf2f(V[o]); const float bonus = wave_sum(r * k * r_k[c]) * v;
        MIX[(size_t)tok * DM + c] = (bf16)f2bf((yn + bonus) * bf2f(GG[o])); }
}

__device__ __forceinline__ void phase_resnorm(const float* tmp, const float* xin, float* xout, const float* g1, const float* g2, bf16* hn, int gw, int NGW, int lane) {
    for (int m = gw; m < TT; m += NGW) {
        const f32x4* tr = (const f32x4*)(tmp + (size_t)m * DM) + lane; const f32x4* xr = (const f32x4*)(xin + (size_t)m * DM) + lane; f32x4* xo = (f32x4*)(xout + (size_t)m * DM) + lane;
        f32x4 v[4]; float s = 0.f;
#pragma unroll
        for (int j = 0; j < 4; ++j) { v[j] = tr[64 * j]; s += (v[j].x * v[j].x + v[j].y * v[j].y) + (v[j].z * v[j].z + v[j].w * v[j].w); }
        const float rs = rsqrtf(wave_sum(s) * (1.f / DM) + RMS_EPS); float s2 = 0.f;
#pragma unroll
        for (int j = 0; j < 4; ++j) { const f32x4 gg = ((const f32x4*)g1 + lane)[64 * j]; v[j] = xr[64 * j] + v[j] * rs * gg; xo[64 * j] = v[j];
            s2 += (v[j].x * v[j].x + v[j].y * v[j].y) + (v[j].z * v[j].z + v[j].w * v[j].w); }
        if (g2) { const float rs2 = rsqrtf(wave_sum(s2) * (1.f / DM) + RMS_EPS); unsigned long long* o8 = (unsigned long long*)(hn + (size_t)m * DM) + lane;
#pragma unroll
            for (int j = 0; j < 4; ++j) { const f32x4 gg = ((const f32x4*)g2 + lane)[64 * j];
                o8[64 * j] = (unsigned long long)pk2(v[j].x * rs2 * gg.x, v[j].y * rs2 * gg.y) | ((unsigned long long)pk2(v[j].z * rs2 * gg.z, v[j].w * rs2 * gg.w) << 32); } }
    }
}

constexpr int NPHASE = 1 + 10 * DEPTH;
__global__ void __launch_bounds__(512, 2) mega(Args a_unused) {
    extern __shared__ __attribute__((aligned(16))) unsigned char lds_raw[];
    LAS unsigned char* lds = (LAS unsigned char*)lds_raw;
    const int G = gridDim.x, NGW = G * 8;
    int lo, hi; { const Args a0 = get_args(); lo = a0.lo; hi = a0.hi; }
    for (int ph = lo; ph < hi; ++ph) {
        const Args a = get_args(); unsigned char* ws = a.ws;
        int tid = threadIdx.x; asm volatile("" : "+v"(tid));
        const int lane = tid & 63, wave = __builtin_amdgcn_readfirstlane(tid >> 6), gw = blockIdx.x * 8 + wave;
        if (ph > lo) {
#if MK_SINGLE
            cg::this_grid().sync();
#endif
        }
        if (ph == 0) { phase_prologue(a, lds, tid, G); continue; }
        const int layer = (ph - 1) / 10, sub = (ph - 1) % 10;
        const float* xin = layer == 0 ? a.in[0] : a.out;
        switch (sub) {
        case 0: { pg8::Gemm g{(const bf16*)(ws + WS_HN), (const bf16*)(ws + WS_WIN) + layer * WIN_L, TT, NIN, DM}; pg8::StaticOrder S; S.init(TT, NIN, G, (int)blockIdx.x);
                  pg8::EpiInProj E{(bf16*)(ws + WS_FR), (bf16*)(ws + WS_FXQ), (bf16*)(ws + WS_PL), (float*)(ws + WS_FF)};
                  pg8::gemm_phase<pg8::EpiInProj, pg8::StaticOrder, true, true>(lds, g, S, E); } break;
        case 1: phase_prep(a, layer, lds, tid, G); break;
        case 2: phase_cumsum(a, lds, tid, G); break;
        case 3: {
            if (blockIdx.x < BATCH * NH) { if (wave == 0) rwkv_scan_naive(a, layer, blockIdx.x, lane); }
            else { const int nb = G - BATCH * NH, bi = blockIdx.x - BATCH * NH;
                for (int u = bi; u < BATCH * NH * 64; u += nb) { const int qb = 63 - u / (BATCH * NH), bh = u % (BATCH * NH); attn_unit(a, bh / NH, bh % NH, qb, lds, tid); }
                phase_pool(a, layer, bi * 8 + wave, nb * 8, lane); }
        } break;
        case 4: phase_rwkv_out(a, layer, gw, NGW, lane); break;
        case 5: { pg8::Gemm g{(const bf16*)(ws + WS_MIX), (const bf16*)(ws + WS_WOUT) + layer * WOUT_L, TT, DM, DM}; pg8::StaticOrder S; S.init(TT, DM, G, (int)blockIdx.x);
                  pg8::EpiF32 E{(float*)(ws + WS_TMP), DM};
                  pg8::gemm_phase<pg8::EpiF32, pg8::StaticOrder, true, true>(lds, g, S, E); } break;
        case 6: phase_resnorm((const float*)(ws + WS_TMP), xin, a.out, a.in[2] + layer * DM, a.in[3] + layer * DM, (bf16*)(ws + WS_HN), gw, NGW, lane); break;
        case 7: { pg8::Gemm g{(const bf16*)(ws + WS_HN), (const bf16*)(ws + WS_WGU) + layer * WGU_L, TT, 2 * FFH, DM}; pg8::StaticOrder S; S.init(TT, 2 * FFH, G, (int)blockIdx.x);
                  pg8::EpiSwiglu E{(bf16*)(ws + WS_H)};
                  pg8::gemm_phase<pg8::EpiSwiglu, pg8::StaticOrder, true, true>(lds, g, S, E); } break;
        case 8: { pg8::Gemm g{(const bf16*)(ws + WS_H), (const bf16*)(ws + WS_WDN) + layer * WDN_L, TT, DM, FFH}; pg8::StaticOrder S; S.init(TT, DM, G, (int)blockIdx.x);
                  pg8::EpiF32 E{(float*)(ws + WS_TMP), DM};
                  pg8::gemm_phase<pg8::EpiF32, pg8::StaticOrder, true, true>(lds, g, S, E); } break;
        case 9: phase_resnorm((const float*)(ws + WS_TMP), a.out, a.out, a.in[4] + layer * DM, layer + 1 < DEPTH ? a.in[1] + (layer + 1) * DM : nullptr, (bf16*)(ws + WS_HN), gw, NGW, lane); break;
        }
    }
}

extern "C" void kernel_launch(void* const* d_in, const int* in_sizes, int n_in, void* d_out, int out_size, void* d_ws, size_t ws_size, hipStream_t stream) {
    static int grid = 0;
    if (grid == 0) {
        if (n_in != 28 || out_size != TT * DM || ws_size < WS_END) { fprintf(stderr, "kernel_launch: unexpected shapes (n_in %d out %d ws %zu)\n", n_in, out_size, ws_size); grid = -1; return; }
        int dev = 0, cus = 0, per_cu = 0;
        hipGetDevice(&dev); hipDeviceGetAttribute(&cus, hipDeviceAttributeMultiprocessorCount, dev);
        hipFuncSetAttribute((const void*)mega, hipFuncAttributeMaxDynamicSharedMemorySize, LDS_BYTES);
        hipOccupancyMaxActiveBlocksPerMultiprocessor(&per_cu, (const void*)mega, 512, LDS_BYTES);
        if (per_cu < 1) { fprintf(stderr, "kernel_launch: occupancy query says %d blocks per CU\n", per_cu); per_cu = 1; }
        (void)hipGetLastError();
        grid = cus * 1;
    }
    if (grid < 0) return;
    hipMemsetAsync((char*)d_ws + WS_CTL, 0, CTL_BYTES, stream);
    Args a{};
    for (int i = 0; i < 28; ++i) a.in[i] = (const float*)d_in[i];
    a.out = (float*)d_out; a.ws = (unsigned char*)d_ws;
#if MK_SINGLE
    a.lo = 0; a.hi = NPHASE;
    void* args[] = {&a};
    hipError_t e = hipLaunchCooperativeKernel((const void*)mega, dim3(grid), dim3(512), args, LDS_BYTES, stream);
    if (e != hipSuccess) fprintf(stderr, "cooperative launch failed: %s (grid %d)\n", hipGetErrorString(e), grid);
#else
    for (int ph = 0; ph < NPHASE; ++ph) { a.lo = ph; a.hi = ph + 1; hipLaunchKernelGGL(mega, dim3(grid), dim3(512), LDS_BYTES, stream, a); }
#endif
}
```

```cpp
#include <hip/hip_runtime.h>
#include <hip/hip_cooperative_groups.h>
#include <cstdio>
#include <cstdint>
namespace pg8 {
#define PG8_LAS __attribute__((address_space(3)))
typedef unsigned short bf16_t;
typedef short bf16x8 __attribute__((ext_vector_type(8)));
typedef float f32x4 __attribute__((ext_vector_type(4)));
typedef unsigned u32x4 __attribute__((ext_vector_type(4)));
constexpr int BM = 256, BK = 64, HALF = 128, HTB = HALF * BK * 2  , STAGE_BYTES = 8 * HTB, NXCD = 8, WGM = 8;

__host__ __device__ __forceinline__ int lds_byte(int r, int c) { const int st = (r >> 4) * 2 + (c >> 5), rr = r & 15, cc = c & 31, ob = rr * 64 + cc * 2; return st * 1024 + (ob ^ (((ob >> 9) & 1) << 5)); }
__host__ __device__ __forceinline__ void stage_rc(int b, int& R, int& C) { const int st = b / 1024, sb = b % 1024, swz = sb ^ (((sb >> 9) & 1) << 5); R = (st >> 1) * 16 + swz / 64; C = (st & 1) * 32 + (swz % 64) / 2; }
__host__ __device__ __forceinline__ int perm32(int rho) { const int n = rho >> 4, i = rho & 15; return 8 * (i >> 2) + 4 * n + (i & 3); }

struct Unit { int pm, pn; };
struct Gemm { const bf16_t* A; const bf16_t* Bt; int M, N, K; };

struct StaticOrder {
    int nM, nN, nwg, G, c;
    __host__ __device__ void init(int M, int N, int G_, int c_) { nM = M / BM; nN = N / BM; nwg = nM * nN; G = G_; c = c_; }
    __host__ __device__ bool next(int i, Unit& u) const {
        const long L = (long)i * G + c; if (L >= nwg) return false;
        int wgid = (int)L; { const int q = nwg / NXCD, r = nwg % NXCD, xcd = wgid % NXCD, off = wgid / NXCD; wgid = (xcd < r ? xcd * (q + 1) : r * (q + 1) + (xcd - r) * q) + off; }
        const int nig = WGM * nN, gid = wgid / nig, fm = gid * WGM, gsz = (nM - fm) < WGM ? (nM - fm) : WGM;
        u.pm = fm + ((wgid % nig) % gsz); u.pn = (wgid % nig) / gsz; return true;
    }
    __device__ __forceinline__ void a_ready(const Unit&) const {}
    __device__ __forceinline__ void done(const Unit&) const {}
};

__device__ __forceinline__ unsigned cvt_pk_bf16(float lo, float hi) { unsigned r; asm volatile("v_cvt_pk_bf16_f32 %0, %1, %2" : "=v"(r) : "v"(lo), "v"(hi)); return r; }
typedef float f32x2 __attribute__((ext_vector_type(2)));
template <class Epi, class Sched, bool ALIGN_EPI = false, bool SP2 = false>
__device__ __forceinline__ void gemm_phase(PG8_LAS unsigned char* lds, const Gemm g, const Sched& S, const Epi& E) {
    int tid_ = threadIdx.x; asm volatile("" : "+v"(tid_));
    const int tid = tid_, wid = __builtin_amdgcn_readfirstlane(tid >> 6), lane = tid & 63, wr = wid >> 2, wc = wid & 3, fr = lane & 15, fq = lane >> 4;
    const int K = g.K, nt = K / BK;
    unsigned voffA[2], voffB[2];
#pragma unroll
    for (int i = 0; i < 2; ++i) { int R, C; stage_rc(tid * 16 + i * 8192, R, C); const int Rb = Epi::PERM ? ((R & ~31) + perm32(R & 31)) : R;
        voffA[i] = (unsigned)(R * K + C) * 2u; voffB[i] = (unsigned)(Rb * K + C) * 2u; }
    const size_t kstep = (size_t)(BK * 2);
    const size_t hstep = (size_t)HALF * K * 2;
    const size_t tstep = 2 * hstep;
    const unsigned ldsw = (unsigned)wid * 1024u;
    const int aoff = lds_byte(wr * 64 + fr, fq * 8), boff = lds_byte(wc * 32 + fr, fq * 8);
#define PG8_SA(b, h) (((b) * 2 + (h)) * HTB)
#define PG8_SB(b, h) ((4 + (b) * 2 + (h)) * HTB)
#define PG8_STAGE(bufoff, gbase, voff) do { _Pragma("unroll") for (int _i = 0; _i < 2; ++_i) \
        __builtin_amdgcn_global_load_lds((const unsigned*)((const char*)(gbase) + (voff)[_i]), (PG8_LAS unsigned*)(lds + (bufoff) + ldsw + _i * 8192), 16, 0, 0); } while (0)
#define PG8_LDA(dst, b, h) do { _Pragma("unroll") for (int m = 0; m < 4; ++m) _Pragma("unroll") for (int k = 0; k < 2; ++k) dst[m][k] = *(const PG8_LAS bf16x8*)(lds + PG8_SA(b, h) + aoff + m * 2048 + k * 1024); } while (0)
#define PG8_LDB(dst, b, h) do { _Pragma("unroll") for (int n = 0; n < 2; ++n) _Pragma("unroll") for (int k = 0; k < 2; ++k) dst[n][k] = *(const PG8_LAS bf16x8*)(lds + PG8_SB(b, h) + boff + n * 2048 + k * 1024); } while (0)
#define PG8_MMA(ai, bj, At, Bt) do { __builtin_amdgcn_s_setprio(1); _Pragma("unroll") for (int m = 0; m < 4; ++m) _Pragma("unroll") for (int n = 0; n < 2; ++n) _Pragma("unroll") for (int k = 0; k < 2; ++k) \
        acc[ai][bj][m][n] = __builtin_amdgcn_mfma_f32_16x16x32_bf16(Bt[n][k], At[m][k], acc[ai][bj][m][n], 0, 0, 0); __builtin_amdgcn_s_setprio(0); } while (0)
#define PG8_WAIT_V(n) asm volatile("s_waitcnt vmcnt(" #n ")" ::: "memory")
#define PG8_WAIT_L(n) asm volatile("s_waitcnt lgkmcnt(" #n ")" ::: "memory")
#define PG8_BAR __builtin_amdgcn_s_barrier()
#define PG8_SCHED __builtin_amdgcn_sched_barrier(0)
    Unit cur, nxt; int ui = 0;
    if (!S.next(0, cur)) return;
    f32x4 acc[2][2][4][2];
#pragma unroll
    for (int a = 0; a < 2; ++a)
#pragma unroll
        for (int b = 0; b < 2; ++b)
#pragma unroll
            for (int m = 0; m < 4; ++m)
#pragma unroll
                for (int n = 0; n < 2; ++n) acc[a][b][m][n] = (f32x4){0.f, 0.f, 0.f, 0.f};
    bf16x8 At[4][2], B0[2][2], B1[2][2];
    const char* cA = (const char*)g.A + (size_t)cur.pm * tstep; const char* cB = (const char*)g.Bt + (size_t)cur.pn * tstep;
    S.a_ready(cur);
    if constexpr (SP2) {
        PG8_STAGE(PG8_SB(0, 0), cB, voffB); PG8_STAGE(PG8_SB(0, 1), cB + hstep, voffB); PG8_STAGE(PG8_SA(0, 0), cA, voffA); PG8_STAGE(PG8_SA(0, 1), cA + hstep, voffA);
        if (wr == 1) PG8_BAR;
        PG8_WAIT_V(2); PG8_BAR;
        PG8_STAGE(PG8_SB(1, 0), cB + kstep, voffB); PG8_STAGE(PG8_SA(1, 0), cA + kstep, voffA); PG8_STAGE(PG8_SB(1, 1), cB + hstep + kstep, voffB);
        PG8_WAIT_V(6); PG8_BAR;
    } else {
        PG8_STAGE(PG8_SB(0, 0), cB, voffB); PG8_STAGE(PG8_SA(0, 0), cA, voffA); PG8_STAGE(PG8_SB(0, 1), cB + hstep, voffB); PG8_STAGE(PG8_SA(0, 1), cA + hstep, voffA);
        if (wr == 1) PG8_BAR;
        PG8_WAIT_V(4); PG8_BAR;
        PG8_STAGE(PG8_SB(1, 0), cB + kstep, voffB); PG8_STAGE(PG8_SA(1, 0), cA + kstep, voffA); PG8_STAGE(PG8_SB(1, 1), cB + hstep + kstep, voffB);
        PG8_WAIT_V(6); PG8_BAR;
    }
    for (;;) {
        const bool has_next = S.next(ui + 1, nxt);
        const char* nA = has_next ? (const char*)g.A + (size_t)nxt.pm * tstep : cA; const char* nB = has_next ? (const char*)g.Bt + (size_t)nxt.pn * tstep : cB;
        for (int t = 0; t < nt; t += 2) {
            const bool last = (t == nt - 2);
            const char* a1 = cA + (size_t)(t + 1) * kstep;
            const char* a2 = last ? nA : cA + (size_t)(t + 2) * kstep; const char* b2 = last ? nB : cB + (size_t)(t + 2) * kstep;
            const char* a3 = a2 + kstep; const char* b3 = b2 + kstep;
            if (last && has_next) S.a_ready(nxt);
            if constexpr (SP2) {
            PG8_LDB(B0, 0, 0); PG8_LDB(B1, 0, 1); PG8_SCHED; PG8_LDA(At, 0, 0); PG8_STAGE(PG8_SA(1, 1), a1 + hstep, voffA);
            PG8_WAIT_V(8); PG8_WAIT_L(0); PG8_BAR; PG8_MMA(0, 0, At, B0); PG8_MMA(0, 1, At, B1); PG8_BAR; PG8_SCHED;
            PG8_LDA(At, 0, 1); PG8_STAGE(PG8_SB(0, 0), b2, voffB); PG8_STAGE(PG8_SB(0, 1), b2 + hstep, voffB); PG8_STAGE(PG8_SA(0, 0), a2, voffA);
            PG8_WAIT_V(8); PG8_WAIT_L(0); PG8_BAR; PG8_MMA(1, 0, At, B0); PG8_MMA(1, 1, At, B1); PG8_BAR; PG8_SCHED;
            PG8_LDB(B0, 1, 0); PG8_LDB(B1, 1, 1); PG8_SCHED; PG8_LDA(At, 1, 0); PG8_STAGE(PG8_SA(0, 1), a2 + hstep, voffA);
            PG8_WAIT_V(8); PG8_WAIT_L(0); PG8_BAR; PG8_MMA(0, 0, At, B0); PG8_MMA(0, 1, At, B1); PG8_BAR; PG8_SCHED;
            PG8_LDA(At, 1, 1); PG8_STAGE(PG8_SB(1, 0), b3, voffB); PG8_STAGE(PG8_SB(1, 1), b3 + hstep, voffB); PG8_STAGE(PG8_SA(1, 0), a3, voffA);
            PG8_WAIT_V(8); PG8_WAIT_L(0); PG8_BAR; PG8_MMA(1, 0, At, B0); PG8_MMA(1, 1, At, B1); PG8_BAR; PG8_SCHED;
            } else {
            PG8_LDB(B0, 0, 0); PG8_SCHED; PG8_LDA(At, 0, 0); PG8_STAGE(PG8_SA(1, 1), a1 + hstep, voffA);
            PG8_WAIT_L(8); PG8_BAR; PG8_WAIT_L(0); PG8_MMA(0, 0, At, B0); PG8_BAR; PG8_SCHED;
            PG8_LDB(B1, 0, 1); PG8_STAGE(PG8_SB(0, 0), b2, voffB);
            PG8_BAR; PG8_WAIT_L(0); PG8_MMA(0, 1, At, B1); PG8_BAR;
            PG8_LDA(At, 0, 1); PG8_STAGE(PG8_SA(0, 0), a2, voffA);
            PG8_BAR; PG8_WAIT_L(0); PG8_MMA(1, 0, At, B0); PG8_BAR; PG8_SCHED;
            PG8_STAGE(PG8_SB(0, 1), b2 + hstep, voffB);
            PG8_WAIT_V(6); PG8_BAR; PG8_MMA(1, 1, At, B1); PG8_BAR;
            PG8_LDB(B0, 1, 0); PG8_SCHED; PG8_LDA(At, 1, 0); PG8_STAGE(PG8_SA(0, 1), a2 + hstep, voffA);
            PG8_WAIT_L(8); PG8_BAR; PG8_WAIT_L(0); PG8_MMA(0, 0, At, B0); PG8_BAR; PG8_SCHED;
            PG8_LDB(B1, 1, 1); PG8_STAGE(PG8_SB(1, 0), b3, voffB);
            PG8_BAR; PG8_WAIT_L(0); PG8_MMA(0, 1, At, B1); PG8_BAR;
            PG8_LDA(At, 1, 1); PG8_STAGE(PG8_SA(1, 0), a3, voffA);
            PG8_BAR; PG8_WAIT_L(0); PG8_MMA(1, 0, At, B0); PG8_BAR; PG8_SCHED;
            PG8_STAGE(PG8_SB(1, 1), b3 + hstep, voffB);
            PG8_WAIT_V(6); PG8_BAR; PG8_MMA(1, 1, At, B1); PG8_BAR;
            }
        }
        if constexpr (ALIGN_EPI) { if (wr == 0) PG8_BAR; }
        if constexpr (!Epi::AFTER_DRAIN) { E(acc, cur, wr, wc, fr, fq); S.done(cur); }
        if (!has_next) break;
#pragma unroll
        for (int a = 0; a < 2; ++a)
#pragma unroll
            for (int b = 0; b < 2; ++b)
#pragma unroll
                for (int m = 0; m < 4; ++m)
#pragma unroll
                    for (int n = 0; n < 2; ++n) acc[a][b][m][n] = (f32x4){0.f, 0.f, 0.f, 0.f};
        cur = nxt; cA = nA; cB = nB; ++ui;
        if constexpr (ALIGN_EPI) { if (wr == 1) PG8_BAR; }
    }
    PG8_WAIT_V(0);
    if constexpr (!ALIGN_EPI) { if (wr == 0) PG8_BAR; }
    PG8_BAR;
    if constexpr (Epi::AFTER_DRAIN) { E.fused(acc, cur, wr, wc, fr, fq, lds, wid, lane); S.done(cur); }
#undef PG8_SA
#undef PG8_SB
#undef PG8_STAGE
#undef PG8_LDA
#undef PG8_LDB
#undef PG8_MMA
#undef PG8_WAIT_V
#undef PG8_WAIT_L
#undef PG8_BAR
#undef PG8_SCHED
}
}

namespace cg = cooperative_groups;
#ifndef MK_SINGLE
#define MK_SINGLE 1
#endif
constexpr int DM = 1024, BATCH = 2, SEQ = 16384, TT = BATCH * SEQ, DEPTH = 2;
constexpr int NH = 6, HD = 64, RW = 384, DIN = 3238, NIN = 3328, FFH = 2816;
constexpr int FRP = 1536, FXP = 1536, PLP = 256;
constexpr float RMS_EPS = 1e-6f, GN_EPS = 64e-5f, LOG2E = 1.4426950408889634f;
constexpr float QSCALE = 0.125f * 1.4426950408889634f;

constexpr size_t MiB = 1u << 20;
constexpr size_t WS_CTL = 0, CTL_BYTES = 1 * MiB;
constexpr size_t WS_WIN = 1 * MiB, WS_WOUT = 14 * MiB, WS_WGU = 18 * MiB, WS_WDN = 40 * MiB;
constexpr size_t WS_FR = 52 * MiB, WS_MIX = 52 * MiB, WS_H = 52 * MiB;
constexpr size_t WS_FXQ = 148 * MiB, WS_PL = 244 * MiB, WS_FF = 260 * MiB, WS_LF = 261 * MiB, WS_CUM = 262 * MiB;
constexpr size_t WS_VF = 264 * MiB;
constexpr size_t WS_RP = 288 * MiB, WS_HN = 288 * MiB, WS_TMP = 352 * MiB;
constexpr size_t RP_R = WS_RP, RP_K = WS_RP + 24 * MiB, RP_V = WS_RP + 48 * MiB, RP_KK = WS_RP + 72 * MiB, RP_BB = WS_RP + 96 * MiB, RP_LW = WS_RP + 120 * MiB, RP_G = WS_RP + 168 * MiB;
constexpr size_t WS_YB = 116 * MiB;
constexpr size_t WS_Y0 = 480 * MiB, WS_PC = 504 * MiB, WS_BONUS = 505 * MiB;
constexpr size_t WS_END = 506 * MiB;
constexpr size_t WIN_L = (size_t)NIN * DM, WOUT_L = (size_t)DM * DM, WGU_L = (size_t)2 * FFH * DM, WDN_L = (size_t)DM * FFH;

constexpr int LDS_BYTES = 147456;

#define LAS __attribute__((address_space(3)))
typedef unsigned short bf16;
typedef float f32x4 __attribute__((ext_vector_type(4)));
typedef float f32x16 __attribute__((ext_vector_type(16)));
typedef short bf16x8 __attribute__((ext_vector_type(8)));
typedef short s16x4 __attribute__((ext_vector_type(4)));
typedef unsigned u32x4 __attribute__((ext_vector_type(4)));
typedef unsigned u32x2 __attribute__((ext_vector_type(2)));

__device__ __forceinline__ float bf2f(bf16 v) { return __uint_as_float((unsigned)v << 16); }
__device__ __forceinline__ unsigned f2bf(float f) { unsigned u = __float_as_uint(f); return (u + 0x7fffu + ((u >> 16) & 1u)) >> 16; }
__device__ __forceinline__ unsigned pk2(float lo, float hi) { return f2bf(lo) | (f2bf(hi) << 16); }
__device__ __forceinline__ float sigmoidf_(float x) { return 1.0f / (1.0f + __expf(-x)); }
__device__ __forceinline__ float wave_sum(float v) {
#pragma unroll
    for (int o = 1; o < 64; o <<= 1) v += __shfl_xor(v, o);
    return v;
}

struct Args { const float* in[28]; float* out; unsigned char* ws; int lo, hi; };
typedef const Args __attribute__((address_space(4)))* ArgsP;
__device__ __forceinline__ Args get_args() {
#if defined(__HIP_DEVICE_COMPILE__)
    ArgsP p = (ArgsP)__builtin_amdgcn_kernarg_segment_ptr(); asm volatile("" : "+s"(p)); return *p;
#else
    return Args{};
#endif
}

namespace pg8 {
struct EpiInProj {
    static constexpr bool PERM = true, AFTER_DRAIN = false;
    bf16_t* FR; bf16_t* FXQ; bf16_t* PL; float* FF;
    __device__ __forceinline__ void operator()(const f32x4 (&acc)[2][2][4][2], const Unit& u, int wr, int wc, int fr, int fq) const {
        bf16_t* base; int ldc, colt;
        if (u.pn < 6) { base = FR; ldc = FRP; colt = u.pn * 256; }
        else if (u.pn < 12) { base = FXQ; ldc = FXP; colt = (u.pn - 6) * 256; }
        else { base = PL; ldc = PLP; colt = 0; }
        const int row0 = u.pm * BM + wr * 64 + fr, col0 = colt + wc * 32 + 8 * fq;
        const bool ffl = (u.pn == 5) && (wc == 1) && (fq == 0);
#pragma unroll
        for (int ai = 0; ai < 2; ++ai)
#pragma unroll
            for (int m = 0; m < 4; ++m) { const int row = row0 + ai * HALF + m * 16; bf16_t* rowp = base + (size_t)row * ldc + col0;
#pragma unroll
                for (int bj = 0; bj < 2; ++bj) { const f32x4 v0 = acc[ai][bj][m][0], v1 = acc[ai][bj][m][1];
                    u32x4 w; w.x = cvt_pk_bf16(v0[0], v0[1]); w.y = cvt_pk_bf16(v0[2], v0[3]); w.z = cvt_pk_bf16(v1[0], v1[1]); w.w = cvt_pk_bf16(v1[2], v1[3]);
                    *(u32x4*)(rowp + bj * HALF) = w;
                    if (bj == 1 && ffl) { *(f32x4*)(FF + (size_t)row * 8) = v0; *(f32x4*)(FF + (size_t)row * 8 + 4) = v1; } } }
    }
};
struct EpiSwiglu {
    static constexpr bool PERM = true, AFTER_DRAIN = false;
    bf16_t* H;
    __device__ __forceinline__ void operator()(const f32x4 (&acc)[2][2][4][2], const Unit& u, int wr, int wc, int fr, int fq) const {
        const int row0 = u.pm * BM + wr * 64 + fr, col0 = u.pn * 128 + wc * 32 + 8 * fq;
#pragma unroll
        for (int ai = 0; ai < 2; ++ai)
#pragma unroll
            for (int m = 0; m < 4; ++m) { bf16_t* rowp = H + (size_t)(row0 + ai * HALF + m * 16) * FFH + col0;
                float h[8];
#pragma unroll
                for (int n = 0; n < 2; ++n)
#pragma unroll
                    for (int e = 0; e < 4; ++e) { const float g = acc[ai][0][m][n][e], up = acc[ai][1][m][n][e]; h[n * 4 + e] = g / (1.0f + __expf(-g)) * up; }
                u32x4 w; w.x = cvt_pk_bf16(h[0], h[1]); w.y = cvt_pk_bf16(h[2], h[3]); w.z = cvt_pk_bf16(h[4], h[5]); w.w = cvt_pk_bf16(h[6], h[7]);
                *(u32x4*)rowp = w; }
    }
};
struct EpiF32 {
    static constexpr bool PERM = false, AFTER_DRAIN = false;
    float* O; int ldc;
    __device__ __forceinline__ void operator()(const f32x4 (&acc)[2][2][4][2], const Unit& u, int wr, int wc, int fr, int fq) const {
        const int row0 = u.pm * BM + wr * 64 + fr, col0 = u.pn * BM + wc * 32 + 4 * fq;
#pragma unroll
        for (int ai = 0; ai < 2; ++ai)
#pragma unroll
            for (int m = 0; m < 4; ++m) { float* rowp = O + (size_t)(row0 + ai * HALF + m * 16) * ldc + col0;
#pragma unroll
                for (int bj = 0; bj < 2; ++bj)
#pragma unroll
                    for (int n = 0; n < 2; ++n) *(f32x4*)(rowp + bj * HALF + n * 16) = acc[ai][bj][m][n]; }
    }
};
}

template <int MODE> __device__ __forceinline__ int wmap(int n) {
    if (MODE == 0) { if (n < 1440) return n; if (n < 2976) return n + 96; if (n < 2982) return n - 1536; return n + 90; }
    if (MODE == 1) { if (n < FFH) return 256 * (n >> 7) + (n & 127); const int j = n - FFH; return 256 * (j >> 7) + 128 + (j & 127); }
    return n;
}
template <int MODE> __device__ __forceinline__ void tr_item(const float* W, int K, int N, bf16* WT, LAS float* scr, int item, int lane) {
    const int nblk = (N + 31) / 32, kb = item / nblk, nb = item % nblk, k0 = 64 * kb, n0 = 32 * nb;
    const int nl = lane & 31, n = n0 + nl;
#pragma unroll 8
    for (int i = 0; i < 32; ++i) { const int kk = 2 * i + (lane >> 5); scr[kk * 33 + nl] = (n < N) ? W[(size_t)(k0 + kk) * N + n] : 0.f; }
    asm volatile("s_waitcnt lgkmcnt(0)" ::: "memory");
    const int c = lane & 7;
#pragma unroll
    for (int j = 0; j < 4; ++j) { const int nn = (lane >> 3) + 8 * j; const LAS float* s = scr + (8 * c) * 33 + nn;
        u32x4 o; o.x = pk2(s[0 * 33], s[1 * 33]); o.y = pk2(s[2 * 33], s[3 * 33]); o.z = pk2(s[4 * 33], s[5 * 33]); o.w = pk2(s[6 * 33], s[7 * 33]);
        if (n0 + nn < N) *(u32x4*)(WT + (size_t)wmap<MODE>(n0 + nn) * K + k0 + 8 * c) = o; }
    asm volatile("s_waitcnt lgkmcnt(0)" ::: "memory");
}
__device__ __forceinline__ void rms_row_bf16(const float* xrow, const float* g, bf16* orow, int lane) {
    const f32x4* xr = (const f32x4*)xrow + lane; const f32x4* gr = (const f32x4*)g + lane;
    f32x4 v[4]; float s = 0.f;
#pragma unroll
    for (int j = 0; j < 4; ++j) { v[j] = xr[64 * j]; s += (v[j].x * v[j].x + v[j].y * v[j].y) + (v[j].z * v[j].z + v[j].w * v[j].w); }
    const float rs = rsqrtf(wave_sum(s) * (1.f / DM) + RMS_EPS);
    unsigned long long* o8 = (unsigned long long*)orow + lane;
#pragma unroll
    for (int j = 0; j < 4; ++j) { const f32x4 gg = gr[64 * j];
        o8[64 * j] = (unsigned long long)pk2(v[j].x * rs * gg.x, v[j].y * rs * gg.y) | ((unsigned long long)pk2(v[j].z * rs * gg.z, v[j].w * rs * gg.w) << 32); }
}
__device__ __forceinline__ void phase_prologue(const Args& a, LAS unsigned char* lds, int tid, int G) {
    const int lane = tid & 63, wave = tid >> 6, gw = blockIdx.x * 8 + wave, NGW = G * 8;
    LAS float* scr = (LAS float*)(lds + wave * 16384);
    unsigned char* ws = a.ws;
    constexpr int I_IN = 16 * 102, I_GU = 16 * 176, I_OUT = 16 * 32, I_DN = 44 * 32, I_L = I_IN + I_GU + I_OUT + I_DN;
    for (int it = gw; it < DEPTH * I_L; it += NGW) {
        const int l = it / I_L; int r = it % I_L;
        if (r < I_IN) { tr_item<0>(a.in[5] + (size_t)l * DM * DIN, DM, DIN, (bf16*)(ws + WS_WIN) + l * WIN_L, scr, r, lane); continue; } r -= I_IN;
        if (r < I_GU) { tr_item<1>(a.in[26] + (size_t)l * DM * 2 * FFH, DM, 2 * FFH, (bf16*)(ws + WS_WGU) + l * WGU_L, scr, r, lane); continue; } r -= I_GU;
        if (r < I_OUT) { tr_item<2>(a.in[6] + (size_t)l * DM * DM, DM, DM, (bf16*)(ws + WS_WOUT) + l * WOUT_L, scr, r, lane); continue; } r -= I_OUT;
        tr_item<2>(a.in[27] + (size_t)l * FFH * DM, FFH, DM, (bf16*)(ws + WS_WDN) + l * WDN_L, scr, r, lane);
    }
    for (int i = blockIdx.x * 512 + tid; i < DEPTH * 90 * (DM / 8); i += G * 512) { const int l = i / (90 * (DM / 8)), r = i % (90 * (DM / 8));
        *(u32x4*)((bf16*)(ws + WS_WIN) + l * WIN_L + (size_t)(1446 + r / (DM / 8)) * DM + (r % (DM / 8)) * 8) = (u32x4){0u, 0u, 0u, 0u}; }
    for (int m = gw; m < TT; m += NGW) rms_row_bf16(a.in[0] + (size_t)m * DM, a.in[1], (bf16*)(ws + WS_HN) + (size_t)m * DM, lane);
}

__device__ __forceinline__ void phase_prep(const Args& a, int layer, LAS unsigned char* lds, int tid, int G) {
    unsigned char* ws = a.ws;
    const int lane = tid & 63, wave = tid >> 6;
    LAS float* F = (LAS float*)lds;
    LAS float* TV = (LAS float*)(lds + 92160);
    const bf16* FR = (const bf16*)(ws + WS_FR); bf16* FXQ = (bf16*)(ws + WS_FXQ); const float* FF = (const float*)(ws + WS_FF);
    const float* mu = a.in[7] + layer * 1440; const float* w0 = a.in[8] + layer * RW; const float* w2 = a.in[9] + (size_t)layer * 64 * RW;
    const float* a0 = a.in[10] + layer * RW; const float* a2 = a.in[11] + (size_t)layer * 64 * RW; const float* g2 = a.in[12] + (size_t)layer * 160 * RW;
    const float* v0 = a.in[13]; const float* v1 = a.in[14]; const float* v2 = a.in[15];
    const float* k_k = a.in[16] + layer * RW; const float* k_a = a.in[17] + layer * RW;
    const float* q_g = a.in[21] + layer * HD; const float* k_g = a.in[22] + layer * HD; const float* f_b = a.in[23] + layer * NH;
    bf16* R = (bf16*)(ws + RP_R); bf16* K = (bf16*)(ws + RP_K); bf16* V = (bf16*)(ws + (layer == 0 ? WS_VF : RP_V)); const bf16* VF = (const bf16*)(ws + WS_VF);
    bf16* KK = (bf16*)(ws + RP_KK); bf16* BB = (bf16*)(ws + RP_BB); float* LW = (float*)(ws + RP_LW); bf16* GG = (bf16*)(ws + RP_G);
    float* LF = (float*)(ws + WS_LF); float* BONUS = (float*)(ws + WS_BONUS); const float* r_k = a.in[18] + layer * RW;
    for (int item = blockIdx.x; item < TT / 16; item += G) {
        const int t0 = item * 16, s0 = t0 % SEQ, bb = t0 / SEQ;
        __syncthreads();
        for (int idx = tid; idx < 16 * 1440; idx += 512) { const int tok = idx / 1440, c = idx % 1440;
            const float cur = bf2f(FR[(size_t)(t0 + tok) * FRP + c]); const float prev = (s0 + tok == 0) ? 0.f : bf2f(FR[(size_t)(t0 + tok - 1) * FRP + c]);
            float f = cur + (prev - cur) * mu[c];
            if (c >= 1152 && c < 1216) f = tanhf(f); else if (c >= 1280) f = sigmoidf_(f);
            F[idx] = f; }
        __syncthreads();
        if (layer > 0) { const int tok = tid >> 5, o = tid & 31; float s = 0.f;
            for (int c = 0; c < RW; ++c) s += F[tok * 1440 + 768 + c] * v1[c * 32 + o];
            TV[tok * 32 + o] = s; }
        __syncthreads();
        if (tid < RW) { const int j = tid;
            float aw[16], aa[16], ag[16];
#pragma unroll
            for (int t = 0; t < 16; ++t) { aw[t] = w0[j]; aa[t] = a0[j]; ag[t] = 0.f; }
            for (int i = 0; i < 64; ++i) { const float ww = w2[i * RW + j], av = a2[i * RW + j];
#pragma unroll
                for (int t = 0; t < 16; ++t) { aw[t] += F[t * 1440 + 1152 + i] * ww; aa[t] += F[t * 1440 + 1216 + i] * av; } }
            for (int i = 0; i < 160; ++i) { const float gv = g2[i * RW + j];
#pragma unroll
                for (int t = 0; t < 16; ++t) ag[t] += F[t * 1440 + 1280 + i] * gv; }
            const float kkj = k_k[j], kaj = k_a[j];
#pragma unroll
            for (int t = 0; t < 16; ++t) { const size_t o = (size_t)(t0 + t) * RW + j;
                const float lw = -0.6065306597126334f * sigmoidf_(aw[t]); const float av = sigmoidf_(aa[t]);
                const float r = F[t * 1440 + j], k = F[t * 1440 + 384 + j]; float v = F[t * 1440 + 768 + j];
                if (layer > 0) { float gs = v0[j];
#pragma unroll 8
                    for (int oo = 0; oo < 32; ++oo) gs += TV[t * 32 + oo] * v2[oo * RW + j];
                    v = v + (bf2f(VF[o]) - v) * sigmoidf_(gs); }
                const float kq = k * kkj; const float ss = wave_sum(kq * kq); const float kkn = kq / fmaxf(sqrtf(ss), 1e-12f);
                { const float bs = wave_sum(r * (k * (1.0f + (av - 1.0f) * kaj)) * r_k[j]); if (lane == 0) BONUS[(size_t)(t0 + t) * NH + wave] = bs; }
                R[o] = (bf16)f2bf(r); K[o] = (bf16)f2bf(k * (1.0f + (av - 1.0f) * kaj)); V[o] = (bf16)f2bf(v); KK[o] = (bf16)f2bf(kkn); BB[o] = (bf16)f2bf(kkn * av);
                LW[o] = lw; GG[o] = (bf16)f2bf(ag[t]); }
        }
        for (int cmb = wave; cmb < 16 * NH * 2; cmb += 8) { const int tok = cmb / (NH * 2), rem = cmb % (NH * 2), hh = rem >> 1, which = rem & 1;
            bf16* p = FXQ + (size_t)(t0 + tok) * FXP + which * RW + hh * HD + lane; const float v = bf2f(*p);
            const float rs = rsqrtf(wave_sum(v * v) * (1.f / HD) + RMS_EPS);
            *p = (bf16)f2bf(which == 0 ? v * rs * q_g[lane] * QSCALE : v * rs * k_g[lane]); }
        if (tid < 16 * NH) { const int tok = tid / NH, hh = tid % NH; const float x = FF[(size_t)(t0 + tok) * 8 + hh] + f_b[hh];
            LF[(size_t)(bb * NH + hh) * SEQ + s0 + tok] = fminf(x, 0.f) - log1pf(__expf(-fabsf(x))); }
    }
}

__device__ __forceinline__ void phase_cumsum(const Args& a, LAS unsigned char* lds, int tid, int G) {
    const float* LF = (const float*)(a.ws + WS_LF); float* CUM = (float*)(a.ws + WS_CUM);
    LAS double* part = (LAS double*)lds;
    for (int ser = blockIdx.x; ser < BATCH * NH; ser += G) {
        const float* src = LF + (size_t)ser * SEQ + tid * 32; float* dst = CUM + (size_t)ser * SEQ + tid * 32;
        float v[32]; double s = 0.0;
#pragma unroll
        for (int i = 0; i < 32; ++i) { v[i] = src[i]; s += (double)v[i]; }
        __syncthreads(); part[tid] = s; __syncthreads();
        if (tid == 0) { double run = 0.0; for (int i = 0; i < 512; ++i) { const double t = part[i]; part[i] = run; run += t; } }
        __syncthreads();
        double run = part[tid];
#pragma unroll
        for (int i = 0; i < 32; ++i) { run += (double)v[i]; dst[i] = (float)run; }
    }
}

__device__ __forceinline__ float rl(float v, int k) { return __uint_as_float(__builtin_amdgcn_readlane(__float_as_uint(v), k)); }
__device__ __forceinline__ void rwkv_scan_naive(const Args& a, int layer, int bh, int lane) {
    unsigned char* ws = a.ws;
    const int b = bh / NH, h = bh % NH;
    const bf16* R = (const bf16*)(ws + RP_R); const bf16* K = (const bf16*)(ws + RP_K); const bf16* V = (const bf16*)(ws + (layer == 0 ? WS_VF : RP_V));
    const bf16* KK = (const bf16*)(ws + RP_KK); const bf16* BB = (const bf16*)(ws + RP_BB); float* LW = (float*)(ws + RP_LW);
    float S[64];
#pragma unroll
    for (int k = 0; k < 64; ++k) S[k] = 0.f;
    size_t o = (size_t)b * SEQ * RW + h * HD + lane;
    float rn = bf2f(R[o]), kn = bf2f(K[o]), vn = bf2f(V[o]), kkn = bf2f(KK[o]), bn = bf2f(BB[o]), wn = LW[o];
    for (int t = 0; t < SEQ; ++t) {
        const float rc = rn, kc = kn, vc = vn, kkc = -kkn, bc = bn, wc = __expf(wn);
        const size_t oc = o;
        if (t + 1 < SEQ) { o += RW; rn = bf2f(R[o]); kn = bf2f(K[o]); vn = bf2f(V[o]); kkn = bf2f(KK[o]); bn = bf2f(BB[o]); wn = LW[o]; }
        float sa0 = 0.f, sa1 = 0.f, sa2 = 0.f, sa3 = 0.f;
#pragma unroll
        for (int k = 0; k < 64; k += 4) { sa0 += S[k] * rl(kkc, k); sa1 += S[k + 1] * rl(kkc, k + 1); sa2 += S[k + 2] * rl(kkc, k + 2); sa3 += S[k + 3] * rl(kkc, k + 3); }
        const float sa = (sa0 + sa1) + (sa2 + sa3);
        float y0 = 0.f, y1 = 0.f, y2 = 0.f, y3 = 0.f;
#pragma unroll
        for (int k = 0; k < 64; k += 4) {
#pragma unroll
            for (int e = 0; e < 4; ++e) { S[k + e] = S[k + e] * rl(wc, k + e) + sa * rl(bc, k + e) + vc * rl(kc, k + e); }
            y0 += S[k] * rl(rc, k); y1 += S[k + 1] * rl(rc, k + 1); y2 += S[k + 2] * rl(rc, k + 2); y3 += S[k + 3] * rl(rc, k + 3); }
        LW[oc] = (y0 + y1) + (y2 + y3);
    }
}

__device__ __forceinline__ int crow(int r, int hi) { return (r & 3) + 8 * (r >> 2) + 4 * hi; }
__device__ __forceinline__ unsigned cvtpk(float lo, float hi) { typedef float f2 __attribute__((ext_vector_type(2))); typedef __bf16 b2 __attribute__((ext_vector_type(2))); f2 v = {lo, hi}; b2 b = __builtin_convertvector(v, b2); return __builtin_bit_cast(unsigned, b); }
__device__ __forceinline__ s16x4 vtr(LAS const unsigned char* p) { typedef short v4i16_t __attribute__((ext_vector_type(4))); return __builtin_bit_cast(s16x4, __builtin_amdgcn_ds_read_tr16_b64_v4i16((LAS v4i16_t*)p)); }

__device__ __forceinline__ int swz(int row, int col) { return row * 128 + ((((col >> 3) ^ (row & 7)) << 4) | ((col & 7) << 1)); }
__device__ __forceinline__ int fragA_off(int m, int n) { const int f = (m >> 5) * 4 + (n >> 4), nn = n & 15, hi = (nn >> 2) & 1, j = (nn & 3) + 4 * (nn >> 3); return ((f * 64 + (m & 31) + 32 * hi) * 8 + j) * 2; }
__device__ __forceinline__ int accC_off(int m, int v) { const int mm = m & 31, hi = (mm >> 2) & 1, reg = (mm & 3) + 4 * (mm >> 3); return ((((v >> 5) * 2 + (m >> 5)) * 64 + (v & 31) + 32 * hi) * 16 + reg) * 2; }
__device__ __forceinline__ unsigned char* slot16(unsigned char* arr, int t0, int h, int o) { return arr + (size_t)(t0 + (o >> 7)) * (RW * 2) + h * 128 + (o & 127); }
__device__ __forceinline__ unsigned char* slot32(unsigned char* arr, int t0, int h, int o) { return arr + (size_t)(t0 + (o >> 8)) * (RW * 4) + h * 256 + (o & 255); }

constexpr int PL_LC = 0, PL_X1 = 16384, PL_Y1 = 32768, PL_VT = 49152, PL_KPT = 57344, PL_A2 = 65536, PL_AAB = 81920, PL_RHS = 98304, PL_BTP = 131072, PL_ARB = 0;

__device__ __forceinline__ void phase_rwkv_pre(const Args& a, int layer, LAS unsigned char* lds, int tid, int G) {
    unsigned char* ws = a.ws;
    unsigned char* Rb = ws + RP_R; unsigned char* Kb = ws + RP_K; unsigned char* KKb = ws + RP_KK; unsigned char* BBb = ws + RP_BB; unsigned char* LWb = ws + RP_LW;
    const bf16* V = (const bf16*)(ws + (layer == 0 ? WS_VF : RP_V));
    LAS float* LC = (LAS float*)(lds + PL_LC); LAS float* AAB = (LAS float*)(lds + PL_AAB); LAS float* RHS = (LAS float*)(lds + PL_RHS);
    for (int item = blockIdx.x; item < BATCH * 256 * NH; item += G) {
        const int h = item % NH, bc = item / NH, t0 = (bc >> 8) * SEQ + (bc & 255) * 64;
        int tid_l = tid; asm volatile("" : "+v"(tid_l));
        const int lane = tid_l & 63, wave = __builtin_amdgcn_readfirstlane(tid_l >> 6), r32 = lane & 31, hi = lane >> 5;
        const int t = tid_l >> 3, kc = tid_l & 7; const size_t oel = (size_t)(t0 + t) * RW + h * HD + kc * 8;
        const u32x4 r8 = *(const u32x4*)((const bf16*)Rb + oel), k8 = *(const u32x4*)((const bf16*)Kb + oel), kk8 = *(const u32x4*)((const bf16*)KKb + oel), b8 = *(const u32x4*)((const bf16*)BBb + oel), v8 = *(const u32x4*)(V + oel);
        const f32x4 lw0 = *(const f32x4*)((const float*)LWb + oel), lw1 = *(const f32x4*)((const float*)LWb + oel + 4);
        __syncthreads();
        *(LAS f32x4*)(LC + t * 64 + kc * 8) = lw0; *(LAS f32x4*)(LC + t * 64 + kc * 8 + 4) = lw1;
        __syncthreads();
        if (tid < 64) { float run = 0.f;
#pragma unroll 8
            for (int tt = 0; tt < 64; ++tt) { run += LC[tt * 64 + tid]; LC[tt * 64 + tid] = run; } }
        __syncthreads();
        {
            float rr[8], kp[8], kn[8], bb[8], vv[8];
#pragma unroll
            for (int e = 0; e < 4; ++e) { rr[2 * e] = __uint_as_float(r8[e] << 16); rr[2 * e + 1] = __uint_as_float(r8[e] & 0xffff0000u); kp[2 * e] = __uint_as_float(k8[e] << 16); kp[2 * e + 1] = __uint_as_float(k8[e] & 0xffff0000u);
                kn[2 * e] = __uint_as_float(kk8[e] << 16); kn[2 * e + 1] = __uint_as_float(kk8[e] & 0xffff0000u); bb[2 * e] = __uint_as_float(b8[e] << 16); bb[2 * e + 1] = __uint_as_float(b8[e] & 0xffff0000u); }
            float at[8], bt[8], kt[8], rt[8], btp[8], ktp[8];
#pragma unroll
            for (int e = 0; e < 8; ++e) { const int k = kc * 8 + e; const float lc = LC[t * 64 + k], lp = t ? LC[(t - 1) * 64 + k] : 0.f, le = LC[63 * 64 + k];
                at[e] = -kn[e] * __expf(lp); const float en = __expf(-lc); bt[e] = bb[e] * en; kt[e] = kp[e] * en; rt[e] = rr[e] * __expf(lc); const float ee = __expf(le - lc); btp[e] = bb[e] * ee; ktp[e] = kp[e] * ee;
                if (t == 63) ((float*)(ws + WS_PC))[(size_t)item * 64 + k] = __expf(le); }
            u32x4 w;
            w.x = cvtpk(at[0], at[1]); w.y = cvtpk(at[2], at[3]); w.z = cvtpk(at[4], at[5]); w.w = cvtpk(at[6], at[7]); *(LAS u32x4*)(lds + PL_X1 + swz(t, kc * 8)) = w;
            const u32x4 wr_ = (u32x4){cvtpk(rt[0], rt[1]), cvtpk(rt[2], rt[3]), cvtpk(rt[4], rt[5]), cvtpk(rt[6], rt[7])}; *(LAS u32x4*)(lds + PL_X1 + swz(64 + t, kc * 8)) = wr_;
            w.x = cvtpk(bt[0], bt[1]); w.y = cvtpk(bt[2], bt[3]); w.z = cvtpk(bt[4], bt[5]); w.w = cvtpk(bt[6], bt[7]); *(LAS u32x4*)(lds + PL_Y1 + swz(t, kc * 8)) = w;
            w.x = cvtpk(kt[0], kt[1]); w.y = cvtpk(kt[2], kt[3]); w.z = cvtpk(kt[4], kt[5]); w.w = cvtpk(kt[6], kt[7]); *(LAS u32x4*)(lds + PL_Y1 + swz(64 + t, kc * 8)) = w;
            *(LAS f32x4*)(RHS + t * 128 + kc * 8) = (f32x4){at[0], at[1], at[2], at[3]}; *(LAS f32x4*)(RHS + t * 128 + kc * 8 + 4) = (f32x4){at[4], at[5], at[6], at[7]};
#pragma unroll
            for (int e = 0; e < 8; ++e) { const int k = kc * 8 + e;
                *(LAS bf16*)(lds + PL_VT + swz(k, t)) = (bf16)((e & 1) ? (v8[e >> 1] >> 16) : (v8[e >> 1] & 0xffffu));
                *(LAS bf16*)(lds + PL_KPT + swz(k, t)) = (bf16)f2bf(ktp[e]);
                *(LAS bf16*)(lds + PL_BTP + k * 128 + t * 2) = (bf16)f2bf(btp[e]); }
            { const int o0 = fragA_off(t, kc * 8), o1 = fragA_off(t, kc * 8 + 4);
              *(u32x2*)slot16(KKb, t0, h, o0) = (u32x2){wr_.x, wr_.y}; *(u32x2*)slot16(KKb, t0, h, o1) = (u32x2){wr_.z, wr_.w}; }
        }
        __syncthreads();
        {
            const int rt4 = wave >> 1;
#pragma unroll
            for (int cc = 0; cc < 2; ++cc) { const int ct = 2 * (wave & 1) + cc;
                f32x16 acc;
#pragma unroll
                for (int r = 0; r < 16; ++r) acc[r] = 0.f;
#pragma unroll
                for (int ks = 0; ks < 4; ++ks) { const bf16x8 af = *(const LAS bf16x8*)(lds + PL_X1 + swz(32 * rt4 + r32, (2 * ks + hi) * 8)); const bf16x8 bf = *(const LAS bf16x8*)(lds + PL_Y1 + swz(32 * ct + r32, (2 * ks + hi) * 8));
                    acc = __builtin_amdgcn_mfma_f32_32x32x16_bf16(af, bf, acc, 0, 0, 0); }
                const int i = 32 * (ct & 1) + r32;
#pragma unroll
                for (int r = 0; r < 16; ++r) { const int tt = 32 * (rt4 & 1) + crow(r, hi);
                    if (rt4 < 2) { const float v = (i < tt) ? acc[r] : 0.f; if (ct < 2) AAB[tt * 64 + i] = v; else *(LAS bf16*)(lds + PL_A2 + swz(tt, i)) = (bf16)f2bf(v); }
                    else { const float v = (i <= tt) ? acc[r] : 0.f; if (ct < 2) *(LAS bf16*)(lds + PL_ARB + tt * 128 + i * 2) = (bf16)f2bf(v); else *(LAS bf16*)(lds + PL_A2 + swz(64 + tt, i)) = (bf16)f2bf(v); } }
            }
        }
        __syncthreads();
        {
            const int rt4 = wave >> 1, ct = wave & 1;
            f32x16 acc;
#pragma unroll
            for (int r = 0; r < 16; ++r) acc[r] = 0.f;
#pragma unroll
            for (int is = 0; is < 4; ++is) { const bf16x8 af = *(const LAS bf16x8*)(lds + PL_A2 + swz(32 * rt4 + r32, (2 * is + hi) * 8)); const bf16x8 bf = *(const LAS bf16x8*)(lds + PL_VT + swz(32 * ct + r32, (2 * is + hi) * 8));
                acc = __builtin_amdgcn_mfma_f32_32x32x16_bf16(af, bf, acc, 0, 0, 0); }
            if (rt4 < 2) {
#pragma unroll
                for (int r = 0; r < 16; ++r) RHS[(32 * rt4 + crow(r, hi)) * 128 + 64 + 32 * ct + r32] = acc[r];
            } else { u32x4 w0, w1; w0.x = cvtpk(acc[0], acc[1]); w0.y = cvtpk(acc[2], acc[3]); w0.z = cvtpk(acc[4], acc[5]); w0.w = cvtpk(acc[6], acc[7]); w1.x = cvtpk(acc[8], acc[9]); w1.y = cvtpk(acc[10], acc[11]); w1.z = cvtpk(acc[12], acc[13]); w1.w = cvtpk(acc[14], acc[15]);
                unsigned char* y0 = ws + WS_Y0 + (size_t)item * 8192 + ((ct * 2 + (rt4 - 2)) * 64 + lane) * 32; *(u32x4*)y0 = w0; *(u32x4*)(y0 + 16) = w1; }
            if (wave < 4) { const int kt2 = wave >> 1, vh = wave & 1;
#pragma unroll
                for (int r = 0; r < 16; ++r) acc[r] = 0.f;
#pragma unroll
                for (int ts = 0; ts < 4; ++ts) { const bf16x8 af = *(const LAS bf16x8*)(lds + PL_KPT + swz(32 * kt2 + r32, (2 * ts + hi) * 8)); const bf16x8 bf = *(const LAS bf16x8*)(lds + PL_VT + swz(32 * vh + r32, (2 * ts + hi) * 8));
                    acc = __builtin_amdgcn_mfma_f32_32x32x16_bf16(af, bf, acc, 0, 0, 0); }
                u32x4 w0, w1; w0.x = cvtpk(acc[0], acc[1]); w0.y = cvtpk(acc[2], acc[3]); w0.z = cvtpk(acc[4], acc[5]); w0.w = cvtpk(acc[6], acc[7]); w1.x = cvtpk(acc[8], acc[9]); w1.y = cvtpk(acc[10], acc[11]); w1.z = cvtpk(acc[12], acc[13]); w1.w = cvtpk(acc[14], acc[15]);
                const int o = 8192 + ((vh * 2 + kt2) * 64 + lane) * 32; *(u32x4*)slot32(LWb, t0, h, o) = w0; *(u32x4*)slot32(LWb, t0, h, o + 16) = w1; }
        }
        __syncthreads();
        if (tid < 128) { const int c = tid; float x[64];
            LAS float* AABp = AAB; asm volatile("" : "+v"(AABp));
            LAS float* RHSc = RHS + c; asm volatile("" : "+v"(RHSc));
#pragma unroll
            for (int tt = 0; tt < 64; ++tt) { float s = RHSc[tt * 128];
#pragma unroll
                for (int i4 = 0; i4 < (tt + 3) / 4; ++i4) { const f32x4 av = *(const LAS f32x4*)(AABp + tt * 64 + i4 * 4);
                    s += av[0] * x[i4 * 4]; if (i4 * 4 + 1 < tt) s += av[1] * x[i4 * 4 + 1]; if (i4 * 4 + 2 < tt) s += av[2] * x[i4 * 4 + 2]; if (i4 * 4 + 3 < tt) s += av[3] * x[i4 * 4 + 3]; }
                x[tt] = s; RHSc[tt * 128] = s; }
        }
        __syncthreads();
        { const int f = tid_l >> 6, l2 = tid_l & 63, m = 32 * (f >> 2) + (l2 & 31), n0 = 16 * (f & 3) + 4 * (l2 >> 5);
          u32x4 w; w.x = cvtpk(RHS[m * 128 + n0], RHS[m * 128 + n0 + 1]); w.y = cvtpk(RHS[m * 128 + n0 + 2], RHS[m * 128 + n0 + 3]); w.z = cvtpk(RHS[m * 128 + n0 + 8], RHS[m * 128 + n0 + 9]); w.w = cvtpk(RHS[m * 128 + n0 + 10], RHS[m * 128 + n0 + 11]);
          *(u32x4*)slot16(Rb, t0, h, tid_l * 16) = w;
          const u32x2 b0 = *(const LAS u32x2*)(lds + PL_BTP + m * 128 + n0 * 2), b1 = *(const LAS u32x2*)(lds + PL_BTP + m * 128 + (n0 + 8) * 2);
          *(u32x4*)slot16(Kb, t0, h, tid_l * 16) = (u32x4){b0.x, b0.y, b1.x, b1.y};
          const u32x2 a0 = *(const LAS u32x2*)(lds + PL_ARB + m * 128 + n0 * 2), a1 = *(const LAS u32x2*)(lds + PL_ARB + m * 128 + (n0 + 8) * 2);
          *(u32x4*)slot16(BBb, t0, h, tid_l * 16) = (u32x4){a0.x, a0.y, a1.x, a1.y};
          const int half = tid_l & 1, l3 = (tid_l >> 1) & 63, tl = tid_l >> 7, mt = tl & 1, vh = tl >> 1, v = 64 + 32 * vh + (l3 & 31), rb = 32 * mt + 16 * half + 4 * (l3 >> 5);
          w.x = cvtpk(RHS[rb * 128 + v], RHS[(rb + 1) * 128 + v]); w.y = cvtpk(RHS[(rb + 2) * 128 + v], RHS[(rb + 3) * 128 + v]); w.z = cvtpk(RHS[(rb + 8) * 128 + v], RHS[(rb + 9) * 128 + v]); w.w = cvtpk(RHS[(rb + 10) * 128 + v], RHS[(rb + 11) * 128 + v]);
          *(u32x4*)slot32(LWb, t0, h, tid_l * 16) = w; }
    }
}

__device__ __forceinline__ bf16x8 pack8(const f32x16& x, int s) { u32x4 w; w.x = cvtpk(x[8 * s], x[8 * s + 1]); w.y = cvtpk(x[8 * s + 2], x[8 * s + 3]); w.z = cvtpk(x[8 * s + 4], x[8 * s + 5]); w.w = cvtpk(x[8 * s + 6], x[8 * s + 7]); return __builtin_bit_cast(bf16x8, w); }
__device__ __forceinline__ f32x16 unpack16(const u32x4 a, const u32x4 b) { f32x16 o;
#pragma unroll
    for (int e = 0; e < 4; ++e) { o[2 * e] = __uint_as_float(a[e] << 16); o[2 * e + 1] = __uint_as_float(a[e] & 0xffff0000u); o[8 + 2 * e] = __uint_as_float(b[e] << 16); o[8 + 2 * e + 1] = __uint_as_float(b[e] & 0xffff0000u); }
    return o; }
__device__ __forceinline__ void rwkv_scan_chunked(const Args& a, int layer, int bh, int vh, int lane) {
    unsigned char* ws = a.ws; const int b = bh / NH, h = bh % NH, r32 = lane & 31, hi = lane >> 5;
    unsigned char* Rb = ws + RP_R; unsigned char* Kb = ws + RP_K; unsigned char* KKb = ws + RP_KK; unsigned char* BBb = ws + RP_BB; unsigned char* LWb = ws + RP_LW;
    bf16* YB = (bf16*)(ws + WS_YB);
    f32x16 sT[2];
#pragma unroll
    for (int r = 0; r < 16; ++r) { sT[0][r] = 0.f; sT[1][r] = 0.f; }
    for (int c = 0; c < 256; ++c) {
        const int t0 = b * SEQ + c * 64, item = (b * 256 + c) * NH + h;
#define FRAG(arr, f) (*(const bf16x8*)slot16(arr, t0, h, ((f) * 64 + lane) * 16))
#define CTILE(o) unpack16(*(const u32x4*)slot32(LWb, t0, h, (o)), *(const u32x4*)slot32(LWb, t0, h, (o) + 16))
        bf16x8 s0f[4];
#pragma unroll
        for (int ks = 0; ks < 4; ++ks) s0f[ks] = pack8(sT[ks >> 1], ks & 1);
        f32x16 u[2], y[2];
#pragma unroll
        for (int ti = 0; ti < 2; ++ti) { u[ti] = CTILE(((vh * 2 + ti) * 64 + lane) * 32);
            const unsigned char* y0 = ws + WS_Y0 + (size_t)item * 8192 + ((vh * 2 + ti) * 64 + lane) * 32; y[ti] = unpack16(*(const u32x4*)y0, *(const u32x4*)(y0 + 16));
#pragma unroll
            for (int ks = 0; ks < 4; ++ks) { u[ti] = __builtin_amdgcn_mfma_f32_32x32x16_bf16(FRAG(Rb, ti * 4 + ks), s0f[ks], u[ti], 0, 0, 0); y[ti] = __builtin_amdgcn_mfma_f32_32x32x16_bf16(FRAG(KKb, ti * 4 + ks), s0f[ks], y[ti], 0, 0, 0); } }
        bf16x8 uf[4];
#pragma unroll
        for (int ts = 0; ts < 4; ++ts) uf[ts] = pack8(u[ts >> 1], ts & 1);
#pragma unroll
        for (int ti = 0; ti < 2; ++ti) {
#pragma unroll
            for (int ts = 0; ts < 4; ++ts) y[ti] = __builtin_amdgcn_mfma_f32_32x32x16_bf16(FRAG(BBb, ti * 4 + ts), uf[ts], y[ti], 0, 0, 0);
#pragma unroll
            for (int r = 0; r < 16; ++r) YB[(size_t)(t0 + 32 * ti + crow(r, hi)) * RW + h * HD + vh * 32 + r32] = (bf16)f2bf(y[ti][r]); }
        const float* pc = (const float*)(ws + WS_PC) + (size_t)item * 64;
#pragma unroll
        for (int ki = 0; ki < 2; ++ki) { const f32x16 kv = CTILE(8192 + ((vh * 2 + ki) * 64 + lane) * 32);
#pragma unroll
            for (int g = 0; g < 4; ++g) { const f32x4 p4 = *(const f32x4*)(pc + 32 * ki + 8 * g + 4 * hi);
#pragma unroll
                for (int e = 0; e < 4; ++e) sT[ki][4 * g + e] = sT[ki][4 * g + e] * p4[e] + kv[4 * g + e]; }
#pragma unroll
            for (int ts = 0; ts < 4; ++ts) sT[ki] = __builtin_amdgcn_mfma_f32_32x32x16_bf16(FRAG(Kb, ki * 4 + ts), uf[ts], sT[ki], 0, 0, 0); }
#undef FRAG
#undef CTILE
    }
}

__device__ __forceinline__ void attn_unit(const Args& a, int b, int h, int qb, LAS unsigned char* lds, int tid) {
    unsigned char* ws = a.ws;
    const bf16* FXQ = (const bf16*)(ws + WS_FXQ); const float* CUM = (const float*)(ws + WS_CUM) + (size_t)(b * NH + h) * SEQ; bf16* MIX = (bf16*)(ws + WS_MIX);
    const int lane = tid & 63, wid = tid >> 6, r32 = lane & 31, hi = lane >> 5;
    const size_t rowbase = (size_t)b * SEQ; const int q0 = qb * 256, qrow = q0 + wid * 32 + r32;
    bf16x8 qf[4];
    { const bf16* qp = FXQ + (rowbase + qrow) * FXP + h * HD + hi * 8;
#pragma unroll
      for (int ks = 0; ks < 4; ++ks) qf[ks] = *(const bf16x8*)(qp + ks * 16); }
    f32x16 o0, o1;
#pragma unroll
    for (int r = 0; r < 16; ++r) { o0[r] = 0.f; o1[r] = 0.f; }
    float m = -INFINITY, l = 0.f;
    const int NT = (q0 + 256) / 64; const float cref = CUM[q0];
    LAS float* ckf = (LAS float*)(lds + 16384);
    for (int kt = 0; kt < NT; ++kt) {
        __syncthreads();
        { const int key = tid >> 3, ch = tid & 7; const size_t grow = rowbase + (size_t)kt * 64 + key;
          const u32x4 kv = *(const u32x4*)(FXQ + grow * FXP + RW + h * HD + ch * 8);
          const u32x4 vv = *(const u32x4*)(FXQ + grow * FXP + 2 * RW + h * HD + ch * 8);
          *(LAS u32x4*)(lds + key * 128 + ((ch ^ (key & 7)) * 16)) = kv;
          *(LAS u32x4*)(lds + 8192 + key * 128 + ch * 16) = vv;
          if (tid < 64) ckf[tid] = (CUM[kt * 64 + tid] - cref) * LOG2E; }
        __syncthreads();
        if (kt * 64 > q0 + wid * 32 + 31) continue;
        f32x16 s0, s1;
#pragma unroll
        for (int r = 0; r < 16; ++r) { s0[r] = 0.f; s1[r] = 0.f; }
#pragma unroll
        for (int ks = 0; ks < 4; ++ks) { const int co = ((2 * ks + hi) ^ (r32 & 7)) * 16;
            const bf16x8 a0 = *(const LAS bf16x8*)(lds + r32 * 128 + co); const bf16x8 a1 = *(const LAS bf16x8*)(lds + (32 + r32) * 128 + co);
            s0 = __builtin_amdgcn_mfma_f32_32x32x16_bf16(a0, qf[ks], s0, 0, 0, 0); s1 = __builtin_amdgcn_mfma_f32_32x32x16_bf16(a1, qf[ks], s1, 0, 0, 0); }
        const bool diag = (kt * 64 + 63 > q0 + wid * 32);
        float mx = -INFINITY;
#pragma unroll
        for (int r = 0; r < 16; ++r) { const int k0 = crow(r, hi); float v0 = s0[r] - ckf[k0], v1 = s1[r] - ckf[32 + k0];
            if (diag) { if (kt * 64 + k0 > qrow) v0 = -INFINITY; if (kt * 64 + 32 + k0 > qrow) v1 = -INFINITY; }
            s0[r] = v0; s1[r] = v1; mx = fmaxf(mx, fmaxf(v0, v1)); }
        mx = fmaxf(mx, __shfl_xor(mx, 32));
        const float mnew = fmaxf(m, mx), alpha = exp2f(m - mnew); m = mnew;
        float ps = 0.f;
#pragma unroll
        for (int r = 0; r < 16; ++r) { s0[r] = exp2f(s0[r] - m); s1[r] = exp2f(s1[r] - m); ps += s0[r] + s1[r]; }
        l = l * alpha + ps;
#pragma unroll
        for (int r = 0; r < 16; ++r) { o0[r] *= alpha; o1[r] *= alpha; }
        bf16x8 pf[4];
#pragma unroll
        for (int s = 0; s < 2; ++s) { u32x4 w0, w1;
            w0.x = cvtpk(s0[8 * s], s0[8 * s + 1]); w0.y = cvtpk(s0[8 * s + 2], s0[8 * s + 3]); w0.z = cvtpk(s0[8 * s + 4], s0[8 * s + 5]); w0.w = cvtpk(s0[8 * s + 6], s0[8 * s + 7]);
            w1.x = cvtpk(s1[8 * s], s1[8 * s + 1]); w1.y = cvtpk(s1[8 * s + 2], s1[8 * s + 3]); w1.z = cvtpk(s1[8 * s + 4], s1[8 * s + 5]); w1.w = cvtpk(s1[8 * s + 6], s1[8 * s + 7]);
            pf[s] = __builtin_bit_cast(bf16x8, w0); pf[2 + s] = __builtin_bit_cast(bf16x8, w1); }
        const int q4 = (lane & 15) >> 2, p4 = lane & 3;
        LAS const unsigned char* vb = lds + 8192 + (4 * hi + q4) * 128 + (16 * ((lane >> 4) & 1) + 4 * p4) * 2;
#pragma unroll
        for (int s = 0; s < 4; ++s) {
#pragma unroll
            for (int db = 0; db < 2; ++db) { const s16x4 lo = vtr(vb + s * 16 * 128 + db * 64), hh = vtr(vb + s * 16 * 128 + 8 * 128 + db * 64);
                const bf16x8 vf = (bf16x8){lo[0], lo[1], lo[2], lo[3], hh[0], hh[1], hh[2], hh[3]};
                if (db == 0) o0 = __builtin_amdgcn_mfma_f32_32x32x16_bf16(vf, pf[s], o0, 0, 0, 0); else o1 = __builtin_amdgcn_mfma_f32_32x32x16_bf16(vf, pf[s], o1, 0, 0, 0); } }
    }
    l += __shfl_xor(l, 32);
    const float inv = 1.0f / l;
    const bf16* gp = FXQ + (rowbase + qrow) * FXP + 3 * RW + h * HD; bf16* op = MIX + (rowbase + qrow) * DM + RW + h * HD;
#pragma unroll
    for (int db = 0; db < 2; ++db)
#pragma unroll
        for (int g = 0; g < 4; ++g) { const int d = 32 * db + 8 * g + 4 * hi; const u32x2 gv = *(const u32x2*)(gp + d);
            const float g0 = sigmoidf_(__uint_as_float(gv.x << 16)), g1 = sigmoidf_(__uint_as_float(gv.x & 0xffff0000u)), g2 = sigmoidf_(__uint_as_float(gv.y << 16)), g3 = sigmoidf_(__uint_as_float(gv.y & 0xffff0000u));
            const float x0 = (db == 0 ? o0[4 * g] : o1[4 * g]) * inv * g0, x1 = (db == 0 ? o0[4 * g + 1] : o1[4 * g + 1]) * inv * g1, x2 = (db == 0 ? o0[4 * g + 2] : o1[4 * g + 2]) * inv * g2, x3 = (db == 0 ? o0[4 * g + 3] : o1[4 * g + 3]) * inv * g3;
            u32x2 w; w.x = cvtpk(x0, x1); w.y = cvtpk(x2, x3); *(u32x2*)(op + d) = w; }
}

__device__ __forceinline__ void phase_pool(const Args& a, int layer, int gw, int NGW, int lane) {
    unsigned char* ws = a.ws; const bf16* PL = (const bf16*)(ws + WS_PL); bf16* MIX = (bf16*)(ws + WS_MIX);
    const float* pw = a.in[24] + (size_t)layer * 4 * 64 * 64; const float* psc = a.in[25] + layer * 256;
    for (int it = gw; it < TT * 4; it += NGW) { const int tok = it >> 2, g = it & 3, win = 2 << g, s = tok % SEQ, n = (s + 1 < win) ? s + 1 : win;
        float sum = 0.f, cur = 0.f;
        for (int i = 0; i < n; ++i) { const float v = bf2f(PL[(size_t)(tok - i) * PLP + g * 64 + lane]); if (i == 0) cur = v; sum += v; }
        const float u = sum / (float)n - cur; const float* wg = pw + g * 4096 + lane; float y = 0.f;
#pragma unroll
        for (int c = 0; c < 64; ++c) y += rl(u, c) * wg[c * 64];
        MIX[(size_t)tok * DM + 768 + g * 64 + lane] = (bf16)f2bf(y * psc[g * 64 + lane]); }
}

__device__ __forceinline__ void phase_rwkv_out(const Args& a, int layer, int gw, int NGW, int lane) {
    unsigned char* ws = a.ws;
    const bf16* V = (const bf16*)(ws + (layer == 0 ? WS_VF : RP_V)); const bf16* YB = (const bf16*)(ws + WS_YB); const float* BONUS = (const float*)(ws + WS_BONUS);
    const bf16* GG = (const bf16*)(ws + RP_G); bf16* MIX = (bf16*)(ws + WS_MIX);
    const float* ln_w = a.in[19] + layer * RW; const float* ln_b = a.in[20] + layer * RW;
    for (int it = gw; it < TT * NH; it += NGW) { const int tok = it / NH, h = it % NH, c = h * HD + lane; const size_t o = (size_t)tok * RW + c;
        const float y = bf2f(YB[o]); const float mean = wave_sum(y) * (1.f / HD); const float d = y - mean; const float var = wave_sum(d * d) * (1.f / HD);
        const float yn = d * rsqrtf(var + GN_EPS) * ln_w[c] + ln_b[c];
        const float bonus = BONUS[it] * bf2f(V[o]);
        MIX[(size_t)tok * DM + c] = (bf16)f2bf((yn + bonus) * bf2f(GG[o])); }
}

__device__ __forceinline__ void phase_resnorm(const float* tmp, const float* xin, float* xout, const float* g1, const float* g2, bf16* hn, int gw, int NGW, int lane) {
    for (int m = gw; m < TT; m += NGW) {
        const f32x4* tr = (const f32x4*)(tmp + (size_t)m * DM) + lane; const f32x4* xr = (const f32x4*)(xin + (size_t)m * DM) + lane; f32x4* xo = (f32x4*)(xout + (size_t)m * DM) + lane;
        f32x4 v[4]; float s = 0.f;
#pragma unroll
        for (int j = 0; j < 4; ++j) { v[j] = tr[64 * j]; s += (v[j].x * v[j].x + v[j].y * v[j].y) + (v[j].z * v[j].z + v[j].w * v[j].w); }
        const float rs = rsqrtf(wave_sum(s) * (1.f / DM) + RMS_EPS); float s2 = 0.f;
#pragma unroll
        for (int j = 0; j < 4; ++j) { const f32x4 gg = ((const f32x4*)g1 + lane)[64 * j]; v[j] = xr[64 * j] + v[j] * rs * gg; xo[64 * j] = v[j];
            s2 += (v[j].x * v[j].x + v[j].y * v[j].y) + (v[j].z * v[j].z + v[j].w * v[j].w); }
        if (g2) { const float rs2 = rsqrtf(wave_sum(s2) * (1.f / DM) + RMS_EPS); unsigned long long* o8 = (unsigned long long*)(hn + (size_t)m * DM) + lane;
#pragma unroll
            for (int j = 0; j < 4; ++j) { const f32x4 gg = ((const f32x4*)g2 + lane)[64 * j];
                o8[64 * j] = (unsigned long long)pk2(v[j].x * rs2 * gg.x, v[j].y * rs2 * gg.y) | ((unsigned long long)pk2(v[j].z * rs2 * gg.z, v[j].w * rs2 * gg.w) << 32); } }
    }
}

constexpr int NPHASE = 1 + 10 * DEPTH;
__global__ void __launch_bounds__(512, 2) mega(Args a_unused) {
    extern __shared__ __attribute__((aligned(16))) unsigned char lds_raw[];
    int lo, hi; { const Args a0 = get_args(); lo = a0.lo; hi = a0.hi; }
    for (int ph = lo; ph < hi; ++ph) {
        const Args a = get_args(); unsigned char* ws = a.ws;
        int tid = threadIdx.x; asm volatile("" : "+v"(tid));
        int bid = blockIdx.x, G = gridDim.x; asm volatile("" : "+s"(bid), "+s"(G));
        LAS unsigned char* lds = (LAS unsigned char*)lds_raw; asm volatile("" : "+s"(lds));
        const int lane = tid & 63, wave = __builtin_amdgcn_readfirstlane(tid >> 6), gw = bid * 8 + wave, NGW = G * 8;
        if (ph > lo) {
#if MK_SINGLE
            cg::this_grid().sync();
#endif
        }
        if (ph == 0) { phase_prologue(a, lds, tid, G); continue; }
        const int layer = (ph - 1) / 10, sub = (ph - 1) % 10;
        const float* xin = layer == 0 ? a.in[0] : a.out;
        switch (sub) {
        case 0: { pg8::Gemm g{(const bf16*)(ws + WS_HN), (const bf16*)(ws + WS_WIN) + layer * WIN_L, TT, NIN, DM}; pg8::StaticOrder S; S.init(TT, NIN, G, bid);
                  pg8::EpiInProj E{(bf16*)(ws + WS_FR), (bf16*)(ws + WS_FXQ), (bf16*)(ws + WS_PL), (float*)(ws + WS_FF)};
                  pg8::gemm_phase<pg8::EpiInProj, pg8::StaticOrder, true, true>(lds, g, S, E); } break;
        case 1: phase_prep(a, layer, lds, tid, G); break;
        case 2: phase_cumsum(a, lds, tid, G); phase_rwkv_pre(a, layer, lds, tid, G); break;
        case 3: {
            if (bid < BATCH * NH) { if (wave < 2) rwkv_scan_chunked(a, layer, bid, wave, lane); }
            else { const int nb = G - BATCH * NH, bi = bid - BATCH * NH;
                for (int u = bi; u < BATCH * NH * 64; u += nb) { const int qb = 63 - u / (BATCH * NH), bh = u % (BATCH * NH); attn_unit(a, bh / NH, bh % NH, qb, lds, tid); }
                phase_pool(a, layer, bi * 8 + wave, nb * 8, lane); }
        } break;
        case 4: phase_rwkv_out(a, layer, gw, NGW, lane); break;
        case 5: { pg8::Gemm g{(const bf16*)(ws + WS_MIX), (const bf16*)(ws + WS_WOUT) + layer * WOUT_L, TT, DM, DM}; pg8::StaticOrder S; S.init(TT, DM, G, bid);
                  pg8::EpiF32 E{(float*)(ws + WS_TMP), DM};
                  pg8::gemm_phase<pg8::EpiF32, pg8::StaticOrder, true, true>(lds, g, S, E); } break;
        case 6: phase_resnorm((const float*)(ws + WS_TMP), xin, a.out, a.in[2] + layer * DM, a.in[3] + layer * DM, (bf16*)(ws + WS_HN), gw, NGW, lane); break;
        case 7: { pg8::Gemm g{(const bf16*)(ws + WS_HN), (const bf16*)(ws + WS_WGU) + layer * WGU_L, TT, 2 * FFH, DM}; pg8::StaticOrder S; S.init(TT, 2 * FFH, G, bid);
                  pg8::EpiSwiglu E{(bf16*)(ws + WS_H)};
                  pg8::gemm_phase<pg8::EpiSwiglu, pg8::StaticOrder, true, true>(lds, g, S, E); } break;
        case 8: { pg8::Gemm g{(const bf16*)(ws + WS_H), (const bf16*)(ws + WS_WDN) + layer * WDN_L, TT, DM, FFH}; pg8::StaticOrder S; S.init(TT, DM, G, bid);
                  pg8::EpiF32 E{(float*)(ws + WS_TMP), DM};
                  pg8::gemm_phase<pg8::EpiF32, pg8::StaticOrder, true, true>(lds, g, S, E); } break;
        case 9: phase_resnorm((const float*)(ws + WS_TMP), a.out, a.out, a.in[4] + layer * DM, layer + 1 < DEPTH ? a.in[1] + (layer + 1) * DM : nullptr, (bf16*)(ws + WS_HN), gw, NGW, lane); break;
        }
    }
}

extern "C" void kernel_launch(void* const* d_in, const int* in_sizes, int n_in, void* d_out, int out_size, void* d_ws, size_t ws_size, hipStream_t stream) {
    static int grid = 0;
    if (grid == 0) {
        if (n_in != 28 || out_size != TT * DM || ws_size < WS_END) { fprintf(stderr, "kernel_launch: unexpected shapes (n_in %d out %d ws %zu)\n", n_in, out_size, ws_size); grid = -1; return; }
        int dev = 0, cus = 0, per_cu = 0;
        hipGetDevice(&dev); hipDeviceGetAttribute(&cus, hipDeviceAttributeMultiprocessorCount, dev);
        hipFuncSetAttribute((const void*)mega, hipFuncAttributeMaxDynamicSharedMemorySize, LDS_BYTES);
        hipOccupancyMaxActiveBlocksPerMultiprocessor(&per_cu, (const void*)mega, 512, LDS_BYTES);
        if (per_cu < 1) { fprintf(stderr, "kernel_launch: occupancy query says %d blocks per CU\n", per_cu); per_cu = 1; }
        (void)hipGetLastError();
        grid = cus * 1;
    }
    if (grid < 0) return;
    hipMemsetAsync((char*)d_ws + WS_CTL, 0, CTL_BYTES, stream);
    Args a{};
    for (int i = 0; i < 28; ++i) a.in[i] = (const float*)d_in[i];
    a.out = (float*)d_out; a.ws = (unsigned char*)d_ws;
#if MK_SINGLE
    a.lo = 0; a.hi = NPHASE;
    void* args[] = {&a};
    hipError_t e = hipLaunchCooperativeKernel((const void*)mega, dim3(grid), dim3(512), args, LDS_BYTES, stream);
    if (e != hipSuccess) fprintf(stderr, "cooperative launch failed: %s (grid %d)\n", hipGetErrorString(e), grid);
#else
    for (int ph = 0; ph < NPHASE; ++ph) { a.lo = ph; a.hi = ph + 1; hipLaunchKernelGGL(mega, dim3(grid), dim3(512), LDS_BYTES, stream, a); }
#endif
}
```

```cpp
#include <hip/hip_runtime.h>
#include <hip/hip_cooperative_groups.h>
#include <cstdio>
#include <cstdint>
namespace pg8 {
#define PG8_LAS __attribute__((address_space(3)))
typedef unsigned short bf16_t;
typedef short bf16x8 __attribute__((ext_vector_type(8)));
typedef float f32x4 __attribute__((ext_vector_type(4)));
typedef unsigned u32x4 __attribute__((ext_vector_type(4)));
constexpr int BM = 256, BK = 64, HALF = 128, HTB = HALF * BK * 2  , STAGE_BYTES = 8 * HTB, NXCD = 8, WGM = 8;

__host__ __device__ __forceinline__ int lds_byte(int r, int c) { const int st = (r >> 4) * 2 + (c >> 5), rr = r & 15, cc = c & 31, ob = rr * 64 + cc * 2; return st * 1024 + (ob ^ (((ob >> 9) & 1) << 5)); }
__host__ __device__ __forceinline__ void stage_rc(int b, int& R, int& C) { const int st = b / 1024, sb = b % 1024, swz = sb ^ (((sb >> 9) & 1) << 5); R = (st >> 1) * 16 + swz / 64; C = (st & 1) * 32 + (swz % 64) / 2; }
__host__ __device__ __forceinline__ int perm32(int rho) { const int n = rho >> 4, i = rho & 15; return 8 * (i >> 2) + 4 * n + (i & 3); }

struct Unit { int pm, pn; };
struct Gemm { const bf16_t* A; const bf16_t* Bt; int M, N, K; };

struct StaticOrder {
    int nM, nN, nwg, G, c;
    __host__ __device__ void init(int M, int N, int G_, int c_) { nM = M / BM; nN = N / BM; nwg = nM * nN; G = G_; c = c_; }
    __host__ __device__ bool next(int i, Unit& u) const {
        const long L = (long)i * G + c; if (L >= nwg) return false;
        int wgid = (int)L; { const int q = nwg / NXCD, r = nwg % NXCD, xcd = wgid % NXCD, off = wgid / NXCD; wgid = (xcd < r ? xcd * (q + 1) : r * (q + 1) + (xcd - r) * q) + off; }
        const int nig = WGM * nN, gid = wgid / nig, fm = gid * WGM, gsz = (nM - fm) < WGM ? (nM - fm) : WGM;
        u.pm = fm + ((wgid % nig) % gsz); u.pn = (wgid % nig) / gsz; return true;
    }
    __device__ __forceinline__ void a_ready(const Unit&) const {}
    __device__ __forceinline__ void done(const Unit&) const {}
};

__device__ __forceinline__ unsigned cvt_pk_bf16(float lo, float hi) { unsigned r; asm volatile("v_cvt_pk_bf16_f32 %0, %1, %2" : "=v"(r) : "v"(lo), "v"(hi)); return r; }
typedef float f32x2 __attribute__((ext_vector_type(2)));
template <class Epi, class Sched, bool ALIGN_EPI = false, bool SP2 = false>
__device__ __forceinline__ void gemm_phase(PG8_LAS unsigned char* lds, const Gemm g, const Sched& S, const Epi& E) {
    int tid_ = threadIdx.x; asm volatile("" : "+v"(tid_));
    const int tid = tid_, wid = __builtin_amdgcn_readfirstlane(tid >> 6), lane = tid & 63, wr = wid >> 2, wc = wid & 3, fr = lane & 15, fq = lane >> 4;
    const int K = g.K, nt = K / BK;
    unsigned voffA[2], voffB[2];
#pragma unroll
    for (int i = 0; i < 2; ++i) { int R, C; stage_rc(tid * 16 + i * 8192, R, C); const int Rb = Epi::PERM ? ((R & ~31) + perm32(R & 31)) : R;
        voffA[i] = (unsigned)(R * K + C) * 2u; voffB[i] = (unsigned)(Rb * K + C) * 2u; }
    const size_t kstep = (size_t)(BK * 2);
    const size_t hstep = (size_t)HALF * K * 2;
    const size_t tstep = 2 * hstep;
    const unsigned ldsw = (unsigned)wid * 1024u;
    const int aoff = lds_byte(wr * 64 + fr, fq * 8), boff = lds_byte(wc * 32 + fr, fq * 8);
#define PG8_SA(b, h) (((b) * 2 + (h)) * HTB)
#define PG8_SB(b, h) ((4 + (b) * 2 + (h)) * HTB)
#define PG8_STAGE(bufoff, gbase, voff) do { _Pragma("unroll") for (int _i = 0; _i < 2; ++_i) \
        __builtin_amdgcn_global_load_lds((const unsigned*)((const char*)(gbase) + (voff)[_i]), (PG8_LAS unsigned*)(lds + (bufoff) + ldsw + _i * 8192), 16, 0, 0); } while (0)
#define PG8_LDA(dst, b, h) do { _Pragma("unroll") for (int m = 0; m < 4; ++m) _Pragma("unroll") for (int k = 0; k < 2; ++k) dst[m][k] = *(const PG8_LAS bf16x8*)(lds + PG8_SA(b, h) + aoff + m * 2048 + k * 1024); } while (0)
#define PG8_LDB(dst, b, h) do { _Pragma("unroll") for (int n = 0; n < 2; ++n) _Pragma("unroll") for (int k = 0; k < 2; ++k) dst[n][k] = *(const PG8_LAS bf16x8*)(lds + PG8_SB(b, h) + boff + n * 2048 + k * 1024); } while (0)
#define PG8_MMA(ai, bj, At, Bt) do { __builtin_amdgcn_s_setprio(1); _Pragma("unroll") for (int m = 0; m < 4; ++m) _Pragma("unroll") for (int n = 0; n < 2; ++n) _Pragma("unroll") for (int k = 0; k < 2; ++k) \
        acc[ai][bj][m][n] = __builtin_amdgcn_mfma_f32_16x16x32_bf16(Bt[n][k], At[m][k], acc[ai][bj][m][n], 0, 0, 0); __builtin_amdgcn_s_setprio(0); } while (0)
#define PG8_WAIT_V(n) asm volatile("s_waitcnt vmcnt(" #n ")" ::: "memory")
#define PG8_WAIT_L(n) asm volatile("s_waitcnt lgkmcnt(" #n ")" ::: "memory")
#define PG8_BAR __builtin_amdgcn_s_barrier()
#define PG8_SCHED __builtin_amdgcn_sched_barrier(0)
    Unit cur, nxt; int ui = 0;
    if (!S.next(0, cur)) return;
    f32x4 acc[2][2][4][2];
#pragma unroll
    for (int a = 0; a < 2; ++a)
#pragma unroll
        for (int b = 0; b < 2; ++b)
#pragma unroll
            for (int m = 0; m < 4; ++m)
#pragma unroll
                for (int n = 0; n < 2; ++n) acc[a][b][m][n] = (f32x4){0.f, 0.f, 0.f, 0.f};
    bf16x8 At[4][2], B0[2][2], B1[2][2];
    const char* cA = (const char*)g.A + (size_t)cur.pm * tstep; const char* cB = (const char*)g.Bt + (size_t)cur.pn * tstep;
    S.a_ready(cur);
    if constexpr (SP2) {
        PG8_STAGE(PG8_SB(0, 0), cB, voffB); PG8_STAGE(PG8_SB(0, 1), cB + hstep, voffB); PG8_STAGE(PG8_SA(0, 0), cA, voffA); PG8_STAGE(PG8_SA(0, 1), cA + hstep, voffA);
        if (wr == 1) PG8_BAR;
        PG8_WAIT_V(2); PG8_BAR;
        PG8_STAGE(PG8_SB(1, 0), cB + kstep, voffB); PG8_STAGE(PG8_SA(1, 0), cA + kstep, voffA); PG8_STAGE(PG8_SB(1, 1), cB + hstep + kstep, voffB);
        PG8_WAIT_V(6); PG8_BAR;
    } else {
        PG8_STAGE(PG8_SB(0, 0), cB, voffB); PG8_STAGE(PG8_SA(0, 0), cA, voffA); PG8_STAGE(PG8_SB(0, 1), cB + hstep, voffB); PG8_STAGE(PG8_SA(0, 1), cA + hstep, voffA);
        if (wr == 1) PG8_BAR;
        PG8_WAIT_V(4); PG8_BAR;
        PG8_STAGE(PG8_SB(1, 0), cB + kstep, voffB); PG8_STAGE(PG8_SA(1, 0), cA + kstep, voffA); PG8_STAGE(PG8_SB(1, 1), cB + hstep + kstep, voffB);
        PG8_WAIT_V(6); PG8_BAR;
    }
    for (;;) {
        const bool has_next = S.next(ui + 1, nxt);
        const char* nA = has_next ? (const char*)g.A + (size_t)nxt.pm * tstep : cA; const char* nB = has_next ? (const char*)g.Bt + (size_t)nxt.pn * tstep : cB;
        for (int t = 0; t < nt; t += 2) {
            const bool last = (t == nt - 2);
            const char* a1 = cA + (size_t)(t + 1) * kstep;
            const char* a2 = last ? nA : cA + (size_t)(t + 2) * kstep; const char* b2 = last ? nB : cB + (size_t)(t + 2) * kstep;
            const char* a3 = a2 + kstep; const char* b3 = b2 + kstep;
            if (last && has_next) S.a_ready(nxt);
            if constexpr (SP2) {
            PG8_LDB(B0, 0, 0); PG8_LDB(B1, 0, 1); PG8_SCHED; PG8_LDA(At, 0, 0); PG8_STAGE(PG8_SA(1, 1), a1 + hstep, voffA);
            PG8_WAIT_V(8); PG8_WAIT_L(0); PG8_BAR; PG8_MMA(0, 0, At, B0); PG8_MMA(0, 1, At, B1); PG8_BAR; PG8_SCHED;
            PG8_LDA(At, 0, 1); PG8_STAGE(PG8_SB(0, 0), b2, voffB); PG8_STAGE(PG8_SB(0, 1), b2 + hstep, voffB); PG8_STAGE(PG8_SA(0, 0), a2, voffA);
            PG8_WAIT_V(8); PG8_WAIT_L(0); PG8_BAR; PG8_MMA(1, 0, At, B0); PG8_MMA(1, 1, At, B1); PG8_BAR; PG8_SCHED;
            PG8_LDB(B0, 1, 0); PG8_LDB(B1, 1, 1); PG8_SCHED; PG8_LDA(At, 1, 0); PG8_STAGE(PG8_SA(0, 1), a2 + hstep, voffA);
            PG8_WAIT_V(8); PG8_WAIT_L(0); PG8_BAR; PG8_MMA(0, 0, At, B0); PG8_MMA(0, 1, At, B1); PG8_BAR; PG8_SCHED;
            PG8_LDA(At, 1, 1); PG8_STAGE(PG8_SB(1, 0), b3, voffB); PG8_STAGE(PG8_SB(1, 1), b3 + hstep, voffB); PG8_STAGE(PG8_SA(1, 0), a3, voffA);
            PG8_WAIT_V(8); PG8_WAIT_L(0); PG8_BAR; PG8_MMA(1, 0, At, B0); PG8_MMA(1, 1, At, B1); PG8_BAR; PG8_SCHED;
            } else {
            PG8_LDB(B0, 0, 0); PG8_SCHED; PG8_LDA(At, 0, 0); PG8_STAGE(PG8_SA(1, 1), a1 + hstep, voffA);
            PG8_WAIT_L(8); PG8_BAR; PG8_WAIT_L(0); PG8_MMA(0, 0, At, B0); PG8_BAR; PG8_SCHED;
            PG8_LDB(B1, 0, 1); PG8_STAGE(PG8_SB(0, 0), b2, voffB);
            PG8_BAR; PG8_WAIT_L(0); PG8_MMA(0, 1, At, B1); PG8_BAR;
            PG8_LDA(At, 0, 1); PG8_STAGE(PG8_SA(0, 0), a2, voffA);
            PG8_BAR; PG8_WAIT_L(0); PG8_MMA(1, 0, At, B0); PG8_BAR; PG8_SCHED;
            PG8_STAGE(PG8_SB(0, 1), b2 + hstep, voffB);
            PG8_WAIT_V(6); PG8_BAR; PG8_MMA(1, 1, At, B1); PG8_BAR;
            PG8_LDB(B0, 1, 0); PG8_SCHED; PG8_LDA(At, 1, 0); PG8_STAGE(PG8_SA(0, 1), a2 + hstep, voffA);
            PG8_WAIT_L(8); PG8_BAR; PG8_WAIT_L(0); PG8_MMA(0, 0, At, B0); PG8_BAR; PG8_SCHED;
            PG8_LDB(B1, 1, 1); PG8_STAGE(PG8_SB(1, 0), b3, voffB);
            PG8_BAR; PG8_WAIT_L(0); PG8_MMA(0, 1, At, B1); PG8_BAR;
            PG8_LDA(At, 1, 1); PG8_STAGE(PG8_SA(1, 0), a3, voffA);
            PG8_BAR; PG8_WAIT_L(0); PG8_MMA(1, 0, At, B0); PG8_BAR; PG8_SCHED;
            PG8_STAGE(PG8_SB(1, 1), b3 + hstep, voffB);
            PG8_WAIT_V(6); PG8_BAR; PG8_MMA(1, 1, At, B1); PG8_BAR;
            }
        }
        if constexpr (ALIGN_EPI) { if (wr == 0) PG8_BAR; }
        if constexpr (!Epi::AFTER_DRAIN) { E(acc, cur, wr, wc, fr, fq); S.done(cur); }
        if (!has_next) break;
#pragma unroll
        for (int a = 0; a < 2; ++a)
#pragma unroll
            for (int b = 0; b < 2; ++b)
#pragma unroll
                for (int m = 0; m < 4; ++m)
#pragma unroll
                    for (int n = 0; n < 2; ++n) acc[a][b][m][n] = (f32x4){0.f, 0.f, 0.f, 0.f};
        cur = nxt; cA = nA; cB = nB; ++ui;
        if constexpr (ALIGN_EPI) { if (wr == 1) PG8_BAR; }
    }
    PG8_WAIT_V(0);
    if constexpr (!ALIGN_EPI) { if (wr == 0) PG8_BAR; }
    PG8_BAR;
    if constexpr (Epi::AFTER_DRAIN) { E.fused(acc, cur, wr, wc, fr, fq, lds, wid, lane); S.done(cur); }
#undef PG8_SA
#undef PG8_SB
#undef PG8_STAGE
#undef PG8_LDA
#undef PG8_LDB
#undef PG8_MMA
#undef PG8_WAIT_V
#undef PG8_WAIT_L
#undef PG8_BAR
#undef PG8_SCHED
}
}

namespace cg = cooperative_groups;
#ifndef MK_SINGLE
#define MK_SINGLE 1
#endif
constexpr int DM = 1024, BATCH = 2, SEQ = 16384, TT = BATCH * SEQ, DEPTH = 2;
constexpr int NH = 6, HD = 64, RW = 384, DIN = 3238, NIN = 3328, FFH = 2816;
constexpr int FRP = 1536, FXP = 1536, PLP = 256;
constexpr float RMS_EPS = 1e-6f, GN_EPS = 64e-5f, LOG2E = 1.4426950408889634f;
constexpr float QSCALE = 0.125f * 1.4426950408889634f;

constexpr size_t MiB = 1u << 20;
constexpr size_t WS_CTL = 0, CTL_BYTES = 1 * MiB;
constexpr size_t WS_WIN = 1 * MiB, WS_WOUT = 14 * MiB, WS_WGU = 18 * MiB, WS_WDN = 40 * MiB;
constexpr size_t WS_FR = 52 * MiB, WS_MIX = 52 * MiB, WS_H = 52 * MiB;
constexpr size_t WS_FXQ = 148 * MiB, WS_PL = 244 * MiB, WS_FF = 260 * MiB, WS_LF = 261 * MiB, WS_CUM = 262 * MiB;
constexpr size_t WS_VF = 264 * MiB;
constexpr size_t WS_RP = 288 * MiB, WS_HN = 288 * MiB, WS_TMP = 352 * MiB;
constexpr size_t RP_R = WS_RP, RP_K = WS_RP + 24 * MiB, RP_V = WS_RP + 48 * MiB, RP_KK = WS_RP + 72 * MiB, RP_BB = WS_RP + 96 * MiB, RP_LW = WS_RP + 120 * MiB, RP_G = WS_RP + 168 * MiB;
constexpr size_t WS_YB = 116 * MiB;
constexpr size_t WS_Y0 = 480 * MiB, WS_PC = 504 * MiB, WS_BONUS = 505 * MiB;
constexpr size_t WS_END = 506 * MiB;
constexpr size_t WIN_L = (size_t)NIN * DM, WOUT_L = (size_t)DM * DM, WGU_L = (size_t)2 * FFH * DM, WDN_L = (size_t)DM * FFH;

constexpr int LDS_BYTES = 147456;

#define LAS __attribute__((address_space(3)))
typedef unsigned short bf16;
typedef float f32x4 __attribute__((ext_vector_type(4)));
typedef float f32x16 __attribute__((ext_vector_type(16)));
typedef short bf16x8 __attribute__((ext_vector_type(8)));
typedef short s16x4 __attribute__((ext_vector_type(4)));
typedef unsigned u32x4 __attribute__((ext_vector_type(4)));
typedef unsigned u32x2 __attribute__((ext_vector_type(2)));

__device__ __forceinline__ float bf2f(bf16 v) { return __uint_as_float((unsigned)v << 16); }
__device__ __forceinline__ unsigned f2bf(float f) { unsigned u = __float_as_uint(f); return (u + 0x7fffu + ((u >> 16) & 1u)) >> 16; }
__device__ __forceinline__ unsigned pk2(float lo, float hi) { return f2bf(lo) | (f2bf(hi) << 16); }
__device__ __forceinline__ float sigmoidf_(float x) { return 1.0f / (1.0f + __expf(-x)); }
__device__ __forceinline__ float wave_sum(float v) {
#pragma unroll
    for (int o = 1; o < 64; o <<= 1) v += __shfl_xor(v, o);
    return v;
}

struct Args { const float* in[28]; float* out; unsigned char* ws; int lo, hi; };
typedef const Args __attribute__((address_space(4)))* ArgsP;
__device__ __forceinline__ Args get_args() {
#if defined(__HIP_DEVICE_COMPILE__)
    ArgsP p = (ArgsP)__builtin_amdgcn_kernarg_segment_ptr(); asm volatile("" : "+s"(p)); return *p;
#else
    return Args{};
#endif
}

namespace pg8 {
struct EpiInProj {
    static constexpr bool PERM = true, AFTER_DRAIN = false;
    bf16_t* FR; bf16_t* FXQ; bf16_t* PL; float* FF;
    __device__ __forceinline__ void operator()(const f32x4 (&acc)[2][2][4][2], const Unit& u, int wr, int wc, int fr, int fq) const {
        bf16_t* base; int ldc, colt;
        if (u.pn < 6) { base = FR; ldc = FRP; colt = u.pn * 256; }
        else if (u.pn < 12) { base = FXQ; ldc = FXP; colt = (u.pn - 6) * 256; }
        else { base = PL; ldc = PLP; colt = 0; }
        const int row0 = u.pm * BM + wr * 64 + fr, col0 = colt + wc * 32 + 8 * fq;
        const bool ffl = (u.pn == 5) && (wc == 1) && (fq == 0);
#pragma unroll
        for (int ai = 0; ai < 2; ++ai)
#pragma unroll
            for (int m = 0; m < 4; ++m) { const int row = row0 + ai * HALF + m * 16; bf16_t* rowp = base + (size_t)row * ldc + col0;
#pragma unroll
                for (int bj = 0; bj < 2; ++bj) { const f32x4 v0 = acc[ai][bj][m][0], v1 = acc[ai][bj][m][1];
                    u32x4 w; w.x = cvt_pk_bf16(v0[0], v0[1]); w.y = cvt_pk_bf16(v0[2], v0[3]); w.z = cvt_pk_bf16(v1[0], v1[1]); w.w = cvt_pk_bf16(v1[2], v1[3]);
                    *(u32x4*)(rowp + bj * HALF) = w;
                    if (bj == 1 && ffl) { *(f32x4*)(FF + (size_t)row * 8) = v0; *(f32x4*)(FF + (size_t)row * 8 + 4) = v1; } } }
    }
};
struct EpiSwiglu {
    static constexpr bool PERM = true, AFTER_DRAIN = false;
    bf16_t* H;
    __device__ __forceinline__ void operator()(const f32x4 (&acc)[2][2][4][2], const Unit& u, int wr, int wc, int fr, int fq) const {
        const int row0 = u.pm * BM + wr * 64 + fr, col0 = u.pn * 128 + wc * 32 + 8 * fq;
#pragma unroll
        for (int ai = 0; ai < 2; ++ai)
#pragma unroll
            for (int m = 0; m < 4; ++m) { bf16_t* rowp = H + (size_t)(row0 + ai * HALF + m * 16) * FFH + col0;
                float h[8];
#pragma unroll
                for (int n = 0; n < 2; ++n)
#pragma unroll
                    for (int e = 0; e < 4; ++e) { const float g = acc[ai][0][m][n][e], up = acc[ai][1][m][n][e]; h[n * 4 + e] = g / (1.0f + __expf(-g)) * up; }
                u32x4 w; w.x = cvt_pk_bf16(h[0], h[1]); w.y = cvt_pk_bf16(h[2], h[3]); w.z = cvt_pk_bf16(h[4], h[5]); w.w = cvt_pk_bf16(h[6], h[7]);
                *(u32x4*)rowp = w; }
    }
};
struct EpiF32 {
    static constexpr bool PERM = false, AFTER_DRAIN = false;
    float* O; int ldc;
    __device__ __forceinline__ void operator()(const f32x4 (&acc)[2][2][4][2], const Unit& u, int wr, int wc, int fr, int fq) const {
        const int row0 = u.pm * BM + wr * 64 + fr, col0 = u.pn * BM + wc * 32 + 4 * fq;
#pragma unroll
        for (int ai = 0; ai < 2; ++ai)
#pragma unroll
            for (int m = 0; m < 4; ++m) { float* rowp = O + (size_t)(row0 + ai * HALF + m * 16) * ldc + col0;
#pragma unroll
                for (int bj = 0; bj < 2; ++bj)
#pragma unroll
                    for (int n = 0; n < 2; ++n) *(f32x4*)(rowp + bj * HALF + n * 16) = acc[ai][bj][m][n]; }
    }
};
}

template <int MODE> __device__ __forceinline__ int wmap(int n) {
    if (MODE == 0) { if (n < 1440) return n; if (n < 2976) return n + 96; if (n < 2982) return n - 1536; return n + 90; }
    if (MODE == 1) { if (n < FFH) return 256 * (n >> 7) + (n & 127); const int j = n - FFH; return 256 * (j >> 7) + 128 + (j & 127); }
    return n;
}
template <int MODE> __device__ __forceinline__ void tr_item(const float* W, int K, int N, bf16* WT, LAS float* scr, int item, int lane) {
    const int nblk = (N + 31) / 32, kb = item / nblk, nb = item % nblk, k0 = 64 * kb, n0 = 32 * nb;
    const int nl = lane & 31, n = n0 + nl;
#pragma unroll 8
    for (int i = 0; i < 32; ++i) { const int kk = 2 * i + (lane >> 5); scr[kk * 33 + nl] = (n < N) ? W[(size_t)(k0 + kk) * N + n] : 0.f; }
    asm volatile("s_waitcnt lgkmcnt(0)" ::: "memory");
    const int c = lane & 7;
#pragma unroll
    for (int j = 0; j < 4; ++j) { const int nn = (lane >> 3) + 8 * j; const LAS float* s = scr + (8 * c) * 33 + nn;
        u32x4 o; o.x = pk2(s[0 * 33], s[1 * 33]); o.y = pk2(s[2 * 33], s[3 * 33]); o.z = pk2(s[4 * 33], s[5 * 33]); o.w = pk2(s[6 * 33], s[7 * 33]);
        if (n0 + nn < N) *(u32x4*)(WT + (size_t)wmap<MODE>(n0 + nn) * K + k0 + 8 * c) = o; }
    asm volatile("s_waitcnt lgkmcnt(0)" ::: "memory");
}
__device__ __forceinline__ void rms_row_bf16(const float* xrow, const float* g, bf16* orow, int lane) {
    const f32x4* xr = (const f32x4*)xrow + lane; const f32x4* gr = (const f32x4*)g + lane;
    f32x4 v[4]; float s = 0.f;
#pragma unroll
    for (int j = 0; j < 4; ++j) { v[j] = xr[64 * j]; s += (v[j].x * v[j].x + v[j].y * v[j].y) + (v[j].z * v[j].z + v[j].w * v[j].w); }
    const float rs = rsqrtf(wave_sum(s) * (1.f / DM) + RMS_EPS);
    unsigned long long* o8 = (unsigned long long*)orow + lane;
#pragma unroll
    for (int j = 0; j < 4; ++j) { const f32x4 gg = gr[64 * j];
        o8[64 * j] = (unsigned long long)pk2(v[j].x * rs * gg.x, v[j].y * rs * gg.y) | ((unsigned long long)pk2(v[j].z * rs * gg.z, v[j].w * rs * gg.w) << 32); }
}
__device__ __forceinline__ void phase_prologue(const Args& a, LAS unsigned char* lds, int tid, int G) {
    const int lane = tid & 63, wave = tid >> 6, gw = blockIdx.x * 8 + wave, NGW = G * 8;
    LAS float* scr = (LAS float*)(lds + wave * 16384);
    unsigned char* ws = a.ws;
    constexpr int I_IN = 16 * 102, I_GU = 16 * 176, I_OUT = 16 * 32, I_DN = 44 * 32, I_L = I_IN + I_GU + I_OUT + I_DN;
    for (int it = gw; it < DEPTH * I_L; it += NGW) {
        const int l = it / I_L; int r = it % I_L;
        if (r < I_IN) { tr_item<0>(a.in[5] + (size_t)l * DM * DIN, DM, DIN, (bf16*)(ws + WS_WIN) + l * WIN_L, scr, r, lane); continue; } r -= I_IN;
        if (r < I_GU) { tr_item<1>(a.in[26] + (size_t)l * DM * 2 * FFH, DM, 2 * FFH, (bf16*)(ws + WS_WGU) + l * WGU_L, scr, r, lane); continue; } r -= I_GU;
        if (r < I_OUT) { tr_item<2>(a.in[6] + (size_t)l * DM * DM, DM, DM, (bf16*)(ws + WS_WOUT) + l * WOUT_L, scr, r, lane); continue; } r -= I_OUT;
        tr_item<2>(a.in[27] + (size_t)l * FFH * DM, FFH, DM, (bf16*)(ws + WS_WDN) + l * WDN_L, scr, r, lane);
    }
    for (int i = blockIdx.x * 512 + tid; i < DEPTH * 90 * (DM / 8); i += G * 512) { const int l = i / (90 * (DM / 8)), r = i % (90 * (DM / 8));
        *(u32x4*)((bf16*)(ws + WS_WIN) + l * WIN_L + (size_t)(1446 + r / (DM / 8)) * DM + (r % (DM / 8)) * 8) = (u32x4){0u, 0u, 0u, 0u}; }
    for (int m = gw; m < TT; m += NGW) rms_row_bf16(a.in[0] + (size_t)m * DM, a.in[1], (bf16*)(ws + WS_HN) + (size_t)m * DM, lane);
}

__device__ __forceinline__ void phase_prep(const Args& a, int layer, LAS unsigned char* lds, int tid, int G) {
    unsigned char* ws = a.ws;
    const int lane = tid & 63, wave = tid >> 6;
    LAS float* F = (LAS float*)lds;
    LAS float* TV = (LAS float*)(lds + 92160);
    const bf16* FR = (const bf16*)(ws + WS_FR); bf16* FXQ = (bf16*)(ws + WS_FXQ); const float* FF = (const float*)(ws + WS_FF);
    const float* mu = a.in[7] + layer * 1440; const float* w0 = a.in[8] + layer * RW; const float* w2 = a.in[9] + (size_t)layer * 64 * RW;
    const float* a0 = a.in[10] + layer * RW; const float* a2 = a.in[11] + (size_t)layer * 64 * RW; const float* g2 = a.in[12] + (size_t)layer * 160 * RW;
    const float* v0 = a.in[13]; const float* v1 = a.in[14]; const float* v2 = a.in[15];
    const float* k_k = a.in[16] + layer * RW; const float* k_a = a.in[17] + layer * RW;
    const float* q_g = a.in[21] + layer * HD; const float* k_g = a.in[22] + layer * HD; const float* f_b = a.in[23] + layer * NH;
    bf16* R = (bf16*)(ws + RP_R); bf16* K = (bf16*)(ws + RP_K); bf16* V = (bf16*)(ws + (layer == 0 ? WS_VF : RP_V)); const bf16* VF = (const bf16*)(ws + WS_VF);
    bf16* KK = (bf16*)(ws + RP_KK); bf16* BB = (bf16*)(ws + RP_BB); float* LW = (float*)(ws + RP_LW); bf16* GG = (bf16*)(ws + RP_G);
    float* LF = (float*)(ws + WS_LF); float* BONUS = (float*)(ws + WS_BONUS); const float* r_k = a.in[18] + layer * RW;
    for (int item = blockIdx.x; item < TT / 16; item += G) {
        const int t0 = item * 16, s0 = t0 % SEQ, bb = t0 / SEQ;
        __syncthreads();
        for (int idx = tid; idx < 16 * 1440; idx += 512) { const int tok = idx / 1440, c = idx % 1440;
            const float cur = bf2f(FR[(size_t)(t0 + tok) * FRP + c]); const float prev = (s0 + tok == 0) ? 0.f : bf2f(FR[(size_t)(t0 + tok - 1) * FRP + c]);
            float f = cur + (prev - cur) * mu[c];
            if (c >= 1152 && c < 1216) f = tanhf(f); else if (c >= 1280) f = sigmoidf_(f);
            F[idx] = f; }
        __syncthreads();
        if (layer > 0) { const int tok = tid >> 5, o = tid & 31; float s = 0.f;
            for (int c = 0; c < RW; ++c) s += F[tok * 1440 + 768 + c] * v1[c * 32 + o];
            TV[tok * 32 + o] = s; }
        __syncthreads();
        if (tid < RW) { const int j = tid;
            float aw[16], aa[16], ag[16];
#pragma unroll
            for (int t = 0; t < 16; ++t) { aw[t] = w0[j]; aa[t] = a0[j]; ag[t] = 0.f; }
            for (int i = 0; i < 64; ++i) { const float ww = w2[i * RW + j], av = a2[i * RW + j];
#pragma unroll
                for (int t = 0; t < 16; ++t) { aw[t] += F[t * 1440 + 1152 + i] * ww; aa[t] += F[t * 1440 + 1216 + i] * av; } }
            for (int i = 0; i < 160; ++i) { const float gv = g2[i * RW + j];
#pragma unroll
                for (int t = 0; t < 16; ++t) ag[t] += F[t * 1440 + 1280 + i] * gv; }
            const float kkj = k_k[j], kaj = k_a[j];
#pragma unroll
            for (int t = 0; t < 16; ++t) { const size_t o = (size_t)(t0 + t) * RW + j;
                const float lw = -0.6065306597126334f * sigmoidf_(aw[t]); const float av = sigmoidf_(aa[t]);
                const float r = F[t * 1440 + j], k = F[t * 1440 + 384 + j]; float v = F[t * 1440 + 768 + j];
                if (layer > 0) { float gs = v0[j];
#pragma unroll 8
                    for (int oo = 0; oo < 32; ++oo) gs += TV[t * 32 + oo] * v2[oo * RW + j];
                    v = v + (bf2f(VF[o]) - v) * sigmoidf_(gs); }
                const float kq = k * kkj; const float ss = wave_sum(kq * kq); const float kkn = kq / fmaxf(sqrtf(ss), 1e-12f);
                { const float bs = wave_sum(r * (k * (1.0f + (av - 1.0f) * kaj)) * r_k[j]); if (lane == 0) BONUS[(size_t)(t0 + t) * NH + wave] = bs; }
                R[o] = (bf16)f2bf(r); K[o] = (bf16)f2bf(k * (1.0f + (av - 1.0f) * kaj)); V[o] = (bf16)f2bf(v); KK[o] = (bf16)f2bf(kkn); BB[o] = (bf16)f2bf(kkn * av);
                LW[o] = lw; GG[o] = (bf16)f2bf(ag[t]); }
        }
        for (int cmb = wave; cmb < 16 * NH * 2; cmb += 8) { const int tok = cmb / (NH * 2), rem = cmb % (NH * 2), hh = rem >> 1, which = rem & 1;
            bf16* p = FXQ + (size_t)(t0 + tok) * FXP + which * RW + hh * HD + lane; const float v = bf2f(*p);
            const float rs = rsqrtf(wave_sum(v * v) * (1.f / HD) + RMS_EPS);
            *p = (bf16)f2bf(which == 0 ? v * rs * q_g[lane] * QSCALE : v * rs * k_g[lane]); }
        if (tid < 16 * NH) { const int tok = tid / NH, hh = tid % NH; const float x = FF[(size_t)(t0 + tok) * 8 + hh] + f_b[hh];
            LF[(size_t)(bb * NH + hh) * SEQ + s0 + tok] = fminf(x, 0.f) - log1pf(__expf(-fabsf(x))); }
    }
}

__device__ __forceinline__ void phase_cumsum(const Args& a, LAS unsigned char* lds, int tid, int G) {
    const float* LF = (const float*)(a.ws + WS_LF); float* CUM = (float*)(a.ws + WS_CUM);
    LAS double* part = (LAS double*)lds;
    for (int ser = blockIdx.x; ser < BATCH * NH; ser += G) {
        const float* src = LF + (size_t)ser * SEQ + tid * 32; float* dst = CUM + (size_t)ser * SEQ + tid * 32;
        float v[32]; double s = 0.0;
#pragma unroll
        for (int i = 0; i < 32; ++i) { v[i] = src[i]; s += (double)v[i]; }
        __syncthreads(); part[tid] = s; __syncthreads();
        if (tid == 0) { double run = 0.0; for (int i = 0; i < 512; ++i) { const double t = part[i]; part[i] = run; run += t; } }
        __syncthreads();
        double run = part[tid];
#pragma unroll
        for (int i = 0; i < 32; ++i) { run += (double)v[i]; dst[i] = (float)run; }
    }
}

__device__ __forceinline__ float rl(float v, int k) { return __uint_as_float(__builtin_amdgcn_readlane(__float_as_uint(v), k)); }
__device__ __forceinline__ void rwkv_scan_naive(const Args& a, int layer, int bh, int lane) {
    unsigned char* ws = a.ws;
    const int b = bh / NH, h = bh % NH;
    const bf16* R = (const bf16*)(ws + RP_R); const bf16* K = (const bf16*)(ws + RP_K); const bf16* V = (const bf16*)(ws + (layer == 0 ? WS_VF : RP_V));
    const bf16* KK = (const bf16*)(ws + RP_KK); const bf16* BB = (const bf16*)(ws + RP_BB); float* LW = (float*)(ws + RP_LW);
    float S[64];
#pragma unroll
    for (int k = 0; k < 64; ++k) S[k] = 0.f;
    size_t o = (size_t)b * SEQ * RW + h * HD + lane;
    float rn = bf2f(R[o]), kn = bf2f(K[o]), vn = bf2f(V[o]), kkn = bf2f(KK[o]), bn = bf2f(BB[o]), wn = LW[o];
    for (int t = 0; t < SEQ; ++t) {
        const float rc = rn, kc = kn, vc = vn, kkc = -kkn, bc = bn, wc = __expf(wn);
        const size_t oc = o;
        if (t + 1 < SEQ) { o += RW; rn = bf2f(R[o]); kn = bf2f(K[o]); vn = bf2f(V[o]); kkn = bf2f(KK[o]); bn = bf2f(BB[o]); wn = LW[o]; }
        float sa0 = 0.f, sa1 = 0.f, sa2 = 0.f, sa3 = 0.f;
#pragma unroll
        for (int k = 0; k < 64; k += 4) { sa0 += S[k] * rl(kkc, k); sa1 += S[k + 1] * rl(kkc, k + 1); sa2 += S[k + 2] * rl(kkc, k + 2); sa3 += S[k + 3] * rl(kkc, k + 3); }
        const float sa = (sa0 + sa1) + (sa2 + sa3);
        float y0 = 0.f, y1 = 0.f, y2 = 0.f, y3 = 0.f;
#pragma unroll
        for (int k = 0; k < 64; k += 4) {
#pragma unroll
            for (int e = 0; e < 4; ++e) { S[k + e] = S[k + e] * rl(wc, k + e) + sa * rl(bc, k + e) + vc * rl(kc, k + e); }
            y0 += S[k] * rl(rc, k); y1 += S[k + 1] * rl(rc, k + 1); y2 += S[k + 2] * rl(rc, k + 2); y3 += S[k + 3] * rl(rc, k + 3); }
        LW[oc] = (y0 + y1) + (y2 + y3);
    }
}

__device__ __forceinline__ int crow(int r, int hi) { return (r & 3) + 8 * (r >> 2) + 4 * hi; }
__device__ __forceinline__ unsigned cvtpk(float lo, float hi) { typedef float f2 __attribute__((ext_vector_type(2))); typedef __bf16 b2 __attribute__((ext_vector_type(2))); f2 v = {lo, hi}; b2 b = __builtin_convertvector(v, b2); return __builtin_bit_cast(unsigned, b); }
__device__ __forceinline__ s16x4 vtr(LAS const unsigned char* p) { typedef short v4i16_t __attribute__((ext_vector_type(4))); return __builtin_bit_cast(s16x4, __builtin_amdgcn_ds_read_tr16_b64_v4i16((LAS v4i16_t*)p)); }

__device__ __forceinline__ int swz(int row, int col) { return row * 128 + ((((col >> 3) ^ (row & 7)) << 4) | ((col & 7) << 1)); }
__device__ __forceinline__ int fragA_off(int m, int n) { const int f = (m >> 5) * 4 + (n >> 4), nn = n & 15, hi = (nn >> 2) & 1, j = (nn & 3) + 4 * (nn >> 3); return ((f * 64 + (m & 31) + 32 * hi) * 8 + j) * 2; }
__device__ __forceinline__ int accC_off(int m, int v) { const int mm = m & 31, hi = (mm >> 2) & 1, reg = (mm & 3) + 4 * (mm >> 3); return ((((v >> 5) * 2 + (m >> 5)) * 64 + (v & 31) + 32 * hi) * 16 + reg) * 2; }
__device__ __forceinline__ unsigned char* slot16(unsigned char* arr, int t0, int h, int o) { return arr + (size_t)(t0 + (o >> 7)) * (RW * 2) + h * 128 + (o & 127); }
__device__ __forceinline__ unsigned char* slot32(unsigned char* arr, int t0, int h, int o) { return arr + (size_t)(t0 + (o >> 8)) * (RW * 4) + h * 256 + (o & 255); }

constexpr int PL_LC = 0, PL_X1 = 16384, PL_Y1 = 32768, PL_VT = 49152, PL_KPT = 57344, PL_A2 = 65536, PL_AAB = 81920, PL_RHS = 98304, PL_BTP = 131072, PL_ARB = 0;

__device__ __forceinline__ void phase_rwkv_pre(const Args& a, int layer, LAS unsigned char* lds, int tid, int G) {
    unsigned char* ws = a.ws;
    unsigned char* Rb = ws + RP_R; unsigned char* Kb = ws + RP_K; unsigned char* KKb = ws + RP_KK; unsigned char* BBb = ws + RP_BB; unsigned char* LWb = ws + RP_LW;
    const bf16* V = (const bf16*)(ws + (layer == 0 ? WS_VF : RP_V));
    LAS float* LC = (LAS float*)(lds + PL_LC); LAS float* AAB = (LAS float*)(lds + PL_AAB); LAS float* RHS = (LAS float*)(lds + PL_RHS);
    for (int item = blockIdx.x; item < BATCH * 256 * NH; item += G) {
        const int h = item % NH, bc = item / NH, t0 = (bc >> 8) * SEQ + (bc & 255) * 64;
        int tid_l = tid; asm volatile("" : "+v"(tid_l));
        const int lane = tid_l & 63, wave = __builtin_amdgcn_readfirstlane(tid_l >> 6), r32 = lane & 31, hi = lane >> 5;
        const int t = tid_l >> 3, kc = tid_l & 7; const size_t oel = (size_t)(t0 + t) * RW + h * HD + kc * 8;
        const u32x4 r8 = *(const u32x4*)((const bf16*)Rb + oel), k8 = *(const u32x4*)((const bf16*)Kb + oel), kk8 = *(const u32x4*)((const bf16*)KKb + oel), b8 = *(const u32x4*)((const bf16*)BBb + oel), v8 = *(const u32x4*)(V + oel);
        const f32x4 lw0 = *(const f32x4*)((const float*)LWb + oel), lw1 = *(const f32x4*)((const float*)LWb + oel + 4);
        __syncthreads();
        *(LAS f32x4*)(LC + t * 64 + kc * 8) = lw0; *(LAS f32x4*)(LC + t * 64 + kc * 8 + 4) = lw1;
        __syncthreads();
        if (tid < 64) { float run = 0.f;
#pragma unroll 8
            for (int tt = 0; tt < 64; ++tt) { run += LC[tt * 64 + tid]; LC[tt * 64 + tid] = run; } }
        __syncthreads();
        {
            float rr[8], kp[8], kn[8], bb[8], vv[8];
#pragma unroll
            for (int e = 0; e < 4; ++e) { rr[2 * e] = __uint_as_float(r8[e] << 16); rr[2 * e + 1] = __uint_as_float(r8[e] & 0xffff0000u); kp[2 * e] = __uint_as_float(k8[e] << 16); kp[2 * e + 1] = __uint_as_float(k8[e] & 0xffff0000u);
                kn[2 * e] = __uint_as_float(kk8[e] << 16); kn[2 * e + 1] = __uint_as_float(kk8[e] & 0xffff0000u); bb[2 * e] = __uint_as_float(b8[e] << 16); bb[2 * e + 1] = __uint_as_float(b8[e] & 0xffff0000u); }
            float at[8], bt[8], kt[8], rt[8], btp[8], ktp[8];
#pragma unroll
            for (int e = 0; e < 8; ++e) { const int k = kc * 8 + e; const float lc = LC[t * 64 + k], lp = t ? LC[(t - 1) * 64 + k] : 0.f, le = LC[63 * 64 + k];
                at[e] = -kn[e] * __expf(lp); const float en = __expf(-lc); bt[e] = bb[e] * en; kt[e] = kp[e] * en; rt[e] = rr[e] * __expf(lc); const float ee = __expf(le - lc); btp[e] = bb[e] * ee; ktp[e] = kp[e] * ee;
                if (t == 63) ((float*)(ws + WS_PC))[(size_t)item * 64 + k] = __expf(le); }
            u32x4 w;
            w.x = cvtpk(at[0], at[1]); w.y = cvtpk(at[2], at[3]); w.z = cvtpk(at[4], at[5]); w.w = cvtpk(at[6], at[7]); *(LAS u32x4*)(lds + PL_X1 + swz(t, kc * 8)) = w;
            const u32x4 wr_ = (u32x4){cvtpk(rt[0], rt[1]), cvtpk(rt[2], rt[3]), cvtpk(rt[4], rt[5]), cvtpk(rt[6], rt[7])}; *(LAS u32x4*)(lds + PL_X1 + swz(64 + t, kc * 8)) = wr_;
            w.x = cvtpk(bt[0], bt[1]); w.y = cvtpk(bt[2], bt[3]); w.z = cvtpk(bt[4], bt[5]); w.w = cvtpk(bt[6], bt[7]); *(LAS u32x4*)(lds + PL_Y1 + swz(t, kc * 8)) = w;
            w.x = cvtpk(kt[0], kt[1]); w.y = cvtpk(kt[2], kt[3]); w.z = cvtpk(kt[4], kt[5]); w.w = cvtpk(kt[6], kt[7]); *(LAS u32x4*)(lds + PL_Y1 + swz(64 + t, kc * 8)) = w;
            *(LAS f32x4*)(RHS + t * 128 + kc * 8) = (f32x4){at[0], at[1], at[2], at[3]}; *(LAS f32x4*)(RHS + t * 128 + kc * 8 + 4) = (f32x4){at[4], at[5], at[6], at[7]};
#pragma unroll
            for (int e = 0; e < 8; ++e) { const int k = kc * 8 + e;
                *(LAS bf16*)(lds + PL_VT + swz(k, t)) = (bf16)((e & 1) ? (v8[e >> 1] >> 16) : (v8[e >> 1] & 0xffffu));
                *(LAS bf16*)(lds + PL_KPT + swz(k, t)) = (bf16)f2bf(ktp[e]);
                *(LAS bf16*)(lds + PL_BTP + k * 128 + t * 2) = (bf16)f2bf(btp[e]); }
            { const int o0 = fragA_off(t, kc * 8), o1 = fragA_off(t, kc * 8 + 4);
              *(u32x2*)slot16(KKb, t0, h, o0) = (u32x2){wr_.x, wr_.y}; *(u32x2*)slot16(KKb, t0, h, o1) = (u32x2){wr_.z, wr_.w}; }
        }
        __syncthreads();
        {
            const int rt4 = wave >> 1;
#pragma unroll
            for (int cc = 0; cc < 2; ++cc) { const int ct = 2 * (wave & 1) + cc;
                f32x16 acc;
#pragma unroll
                for (int r = 0; r < 16; ++r) acc[r] = 0.f;
#pragma unroll
                for (int ks = 0; ks < 4; ++ks) { const bf16x8 af = *(const LAS bf16x8*)(lds + PL_X1 + swz(32 * rt4 + r32, (2 * ks + hi) * 8)); const bf16x8 bf = *(const LAS bf16x8*)(lds + PL_Y1 + swz(32 * ct + r32, (2 * ks + hi) * 8));
                    acc = __builtin_amdgcn_mfma_f32_32x32x16_bf16(af, bf, acc, 0, 0, 0); }
                const int i = 32 * (ct & 1) + r32;
#pragma unroll
                for (int r = 0; r < 16; ++r) { const int tt = 32 * (rt4 & 1) + crow(r, hi);
                    if (rt4 < 2) { const float v = (i < tt) ? acc[r] : 0.f; if (ct < 2) AAB[tt * 64 + i] = v; else *(LAS bf16*)(lds + PL_A2 + swz(tt, i)) = (bf16)f2bf(v); }
                    else { const float v = (i <= tt) ? acc[r] : 0.f; if (ct < 2) *(LAS bf16*)(lds + PL_ARB + tt * 128 + i * 2) = (bf16)f2bf(v); else *(LAS bf16*)(lds + PL_A2 + swz(64 + tt, i)) = (bf16)f2bf(v); } }
            }
        }
        __syncthreads();
        {
            const int rt4 = wave >> 1, ct = wave & 1;
            f32x16 acc;
#pragma unroll
            for (int r = 0; r < 16; ++r) acc[r] = 0.f;
#pragma unroll
            for (int is = 0; is < 4; ++is) { const bf16x8 af = *(const LAS bf16x8*)(lds + PL_A2 + swz(32 * rt4 + r32, (2 * is + hi) * 8)); const bf16x8 bf = *(const LAS bf16x8*)(lds + PL_VT + swz(32 * ct + r32, (2 * is + hi) * 8));
                acc = __builtin_amdgcn_mfma_f32_32x32x16_bf16(af, bf, acc, 0, 0, 0); }
            if (rt4 < 2) {
#pragma unroll
                for (int r = 0; r < 16; ++r) RHS[(32 * rt4 + crow(r, hi)) * 128 + 64 + 32 * ct + r32] = acc[r];
            } else { u32x4 w0, w1; w0.x = cvtpk(acc[0], acc[1]); w0.y = cvtpk(acc[2], acc[3]); w0.z = cvtpk(acc[4], acc[5]); w0.w = cvtpk(acc[6], acc[7]); w1.x = cvtpk(acc[8], acc[9]); w1.y = cvtpk(acc[10], acc[11]); w1.z = cvtpk(acc[12], acc[13]); w1.w = cvtpk(acc[14], acc[15]);
                unsigned char* y0 = ws + WS_Y0 + (size_t)item * 8192 + ((ct * 2 + (rt4 - 2)) * 64 + lane) * 32; *(u32x4*)y0 = w0; *(u32x4*)(y0 + 16) = w1; }
            if (wave < 4) { const int kt2 = wave >> 1, vh = wave & 1;
#pragma unroll
                for (int r = 0; r < 16; ++r) acc[r] = 0.f;
#pragma unroll
                for (int ts = 0; ts < 4; ++ts) { const bf16x8 af = *(const LAS bf16x8*)(lds + PL_KPT + swz(32 * kt2 + r32, (2 * ts + hi) * 8)); const bf16x8 bf = *(const LAS bf16x8*)(lds + PL_VT + swz(32 * vh + r32, (2 * ts + hi) * 8));
                    acc = __builtin_amdgcn_mfma_f32_32x32x16_bf16(af, bf, acc, 0, 0, 0); }
                u32x4 w0, w1; w0.x = cvtpk(acc[0], acc[1]); w0.y = cvtpk(acc[2], acc[3]); w0.z = cvtpk(acc[4], acc[5]); w0.w = cvtpk(acc[6], acc[7]); w1.x = cvtpk(acc[8], acc[9]); w1.y = cvtpk(acc[10], acc[11]); w1.z = cvtpk(acc[12], acc[13]); w1.w = cvtpk(acc[14], acc[15]);
                const int o = 8192 + ((vh * 2 + kt2) * 64 + lane) * 32; *(u32x4*)slot32(LWb, t0, h, o) = w0; *(u32x4*)slot32(LWb, t0, h, o + 16) = w1; }
        }
        __syncthreads();
        if (tid < 128) { const int c = tid; float x[64];
            LAS float* AABp = AAB; asm volatile("" : "+v"(AABp));
            LAS float* RHSc = RHS + c; asm volatile("" : "+v"(RHSc));
#pragma unroll
            for (int tt = 0; tt < 64; ++tt) { float s = RHSc[tt * 128];
#pragma unroll
                for (int i4 = 0; i4 < (tt + 3) / 4; ++i4) { const f32x4 av = *(const LAS f32x4*)(AABp + tt * 64 + i4 * 4);
                    s += av[0] * x[i4 * 4]; if (i4 * 4 + 1 < tt) s += av[1] * x[i4 * 4 + 1]; if (i4 * 4 + 2 < tt) s += av[2] * x[i4 * 4 + 2]; if (i4 * 4 + 3 < tt) s += av[3] * x[i4 * 4 + 3]; }
                x[tt] = s; RHSc[tt * 128] = s; }
        }
        __syncthreads();
        { const int f = tid_l >> 6, l2 = tid_l & 63, m = 32 * (f >> 2) + (l2 & 31), n0 = 16 * (f & 3) + 4 * (l2 >> 5);
          u32x4 w; w.x = cvtpk(RHS[m * 128 + n0], RHS[m * 128 + n0 + 1]); w.y = cvtpk(RHS[m * 128 + n0 + 2], RHS[m * 128 + n0 + 3]); w.z = cvtpk(RHS[m * 128 + n0 + 8], RHS[m * 128 + n0 + 9]); w.w = cvtpk(RHS[m * 128 + n0 + 10], RHS[m * 128 + n0 + 11]);
          *(u32x4*)slot16(Rb, t0, h, tid_l * 16) = w;
          const u32x2 b0 = *(const LAS u32x2*)(lds + PL_BTP + m * 128 + n0 * 2), b1 = *(const LAS u32x2*)(lds + PL_BTP + m * 128 + (n0 + 8) * 2);
          *(u32x4*)slot16(Kb, t0, h, tid_l * 16) = (u32x4){b0.x, b0.y, b1.x, b1.y};
          const u32x2 a0 = *(const LAS u32x2*)(lds + PL_ARB + m * 128 + n0 * 2), a1 = *(const LAS u32x2*)(lds + PL_ARB + m * 128 + (n0 + 8) * 2);
          *(u32x4*)slot16(BBb, t0, h, tid_l * 16) = (u32x4){a0.x, a0.y, a1.x, a1.y};
          const int half = tid_l & 1, l3 = (tid_l >> 1) & 63, tl = tid_l >> 7, mt = tl & 1, vh = tl >> 1, v = 64 + 32 * vh + (l3 & 31), rb = 32 * mt + 16 * half + 4 * (l3 >> 5);
          w.x = cvtpk(RHS[rb * 128 + v], RHS[(rb + 1) * 128 + v]); w.y = cvtpk(RHS[(rb + 2) * 128 + v], RHS[(rb + 3) * 128 + v]); w.z = cvtpk(RHS[(rb + 8) * 128 + v], RHS[(rb + 9) * 128 + v]); w.w = cvtpk(RHS[(rb + 10) * 128 + v], RHS[(rb + 11) * 128 + v]);
          *(u32x4*)slot32(LWb, t0, h, tid_l * 16) = w; }
    }
}

__device__ __forceinline__ bf16x8 pack8(const f32x16& x, int s) { u32x4 w; w.x = cvtpk(x[8 * s], x[8 * s + 1]); w.y = cvtpk(x[8 * s + 2], x[8 * s + 3]); w.z = cvtpk(x[8 * s + 4], x[8 * s + 5]); w.w = cvtpk(x[8 * s + 6], x[8 * s + 7]); return __builtin_bit_cast(bf16x8, w); }
__device__ __forceinline__ f32x16 unpack16(const u32x4 a, const u32x4 b) { f32x16 o;
#pragma unroll
    for (int e = 0; e < 4; ++e) { o[2 * e] = __uint_as_float(a[e] << 16); o[2 * e + 1] = __uint_as_float(a[e] & 0xffff0000u); o[8 + 2 * e] = __uint_as_float(b[e] << 16); o[8 + 2 * e + 1] = __uint_as_float(b[e] & 0xffff0000u); }
    return o; }
__device__ __forceinline__ const unsigned char* cd_group(unsigned char* ws, int b, int h, int c, int g, int off16, int off32, int offl) {
    const int seg = g >> 3, gi = g & 7, t0 = b * SEQ + c * 64; const size_t item = (size_t)(b * 256 + c) * NH + h;
    if (seg < 4) return ws + (seg == 0 ? RP_R : seg == 1 ? RP_K : seg == 2 ? RP_KK : RP_BB) + (size_t)(t0 + gi * 8) * (RW * 2) + h * 128 + off16;
    if (seg < 6) return ws + RP_LW + (size_t)(t0 + (seg - 4) * 32 + gi * 4) * (RW * 4) + h * 256 + off32;
    if (seg == 6) return ws + WS_Y0 + item * 8192 + gi * 1024 + offl;
    return ws + WS_PC + item * 256 + (offl & 255);
}
constexpr int CD_BYTES = 58368, CD_GROUPS = 57;
__device__ __forceinline__ void rwkv_scan_chunked(const Args& a, int layer, int bh, LAS unsigned char* lds, int tid) {
    unsigned char* ws = a.ws; const int b = bh / NH, h = bh % NH, lane = tid & 63, wave = __builtin_amdgcn_readfirstlane(tid >> 6), r32 = lane & 31, hi = lane >> 5, vh = wave;
    bf16* YB = (bf16*)(ws + WS_YB);
    const int lw = wave - 2;
    const int off16 = (lane >> 3) * (RW * 2) + (lane & 7) * 16, off32 = (lane >> 4) * (RW * 4) + (lane & 15) * 16, offl = lane * 16;
    u32x4 stg[10];
    f32x16 sT[2];
#pragma unroll
    for (int r = 0; r < 16; ++r) { sT[0][r] = 0.f; sT[1][r] = 0.f; }
    __syncthreads();
    if (wave >= 2) {
#pragma unroll
        for (int k = 0; k < 10; ++k) { const int g = lw + 6 * k; if (g < CD_GROUPS) stg[k] = *(const u32x4*)cd_group(ws, b, h, 0, g, off16, off32, offl); }
#pragma unroll
        for (int k = 0; k < 10; ++k) { const int g = lw + 6 * k; if (g < CD_GROUPS) *(LAS u32x4*)(lds + g * 1024 + lane * 16) = stg[k]; }
#pragma unroll
        for (int k = 0; k < 10; ++k) { const int g = lw + 6 * k; if (g < CD_GROUPS) stg[k] = *(const u32x4*)cd_group(ws, b, h, 1, g, off16, off32, offl); }
    }
    __syncthreads();
    for (int c = 0; c < 256; ++c) {
        if (wave >= 2) {
            if (c + 1 < 256) { LAS unsigned char* dst = lds + ((c + 1) & 1) * CD_BYTES;
#pragma unroll
                for (int k = 0; k < 10; ++k) { const int g = lw + 6 * k; if (g < CD_GROUPS) *(LAS u32x4*)(dst + g * 1024 + lane * 16) = stg[k]; } }
            if (c + 2 < 256) { int c2 = c + 2; asm volatile("" : "+s"(c2));
#pragma unroll
                for (int k = 0; k < 10; ++k) { const int g = lw + 6 * k; if (g < CD_GROUPS) stg[k] = *(const u32x4*)cd_group(ws, b, h, c2, g, off16, off32, offl); } }
        } else {
            LAS const unsigned char* buf = lds + (c & 1) * CD_BYTES; const int t0 = b * SEQ + c * 64;
#define FRAG(seg, f) (*(const LAS bf16x8*)(buf + (seg) * 8192 + ((f) * 64 + lane) * 16))
#define CTILE(seg, tile) unpack16(*(const LAS u32x4*)(buf + (seg) * 8192 + ((vh * 2 + (tile)) * 64 + lane) * 32), *(const LAS u32x4*)(buf + (seg) * 8192 + ((vh * 2 + (tile)) * 64 + lane) * 32 + 16))
            bf16x8 s0f[4];
#pragma unroll
            for (int ks = 0; ks < 4; ++ks) s0f[ks] = pack8(sT[ks >> 1], ks & 1);
            f32x16 u[2], y[2];
#pragma unroll
            for (int ti = 0; ti < 2; ++ti) { u[ti] = CTILE(4, ti); y[ti] = CTILE(6, ti);
#pragma unroll
                for (int ks = 0; ks < 4; ++ks) { u[ti] = __builtin_amdgcn_mfma_f32_32x32x16_bf16(FRAG(0, ti * 4 + ks), s0f[ks], u[ti], 0, 0, 0); y[ti] = __builtin_amdgcn_mfma_f32_32x32x16_bf16(FRAG(2, ti * 4 + ks), s0f[ks], y[ti], 0, 0, 0); } }
            bf16x8 uf[4];
#pragma unroll
            for (int ts = 0; ts < 4; ++ts) uf[ts] = pack8(u[ts >> 1], ts & 1);
#pragma unroll
            for (int ki = 0; ki < 2; ++ki) { const f32x16 kv = CTILE(5, ki);
#pragma unroll
                for (int g = 0; g < 4; ++g) { const f32x4 p4 = *(const LAS f32x4*)(buf + 57344 + (32 * ki + 8 * g + 4 * hi) * 4);
#pragma unroll
                    for (int e = 0; e < 4; ++e) sT[ki][4 * g + e] = sT[ki][4 * g + e] * p4[e] + kv[4 * g + e]; }
#pragma unroll
                for (int ts = 0; ts < 4; ++ts) sT[ki] = __builtin_amdgcn_mfma_f32_32x32x16_bf16(FRAG(1, ki * 4 + ts), uf[ts], sT[ki], 0, 0, 0); }
#pragma unroll
            for (int ti = 0; ti < 2; ++ti) {
#pragma unroll
                for (int ts = 0; ts < 4; ++ts) y[ti] = __builtin_amdgcn_mfma_f32_32x32x16_bf16(FRAG(3, ti * 4 + ts), uf[ts], y[ti], 0, 0, 0);
#pragma unroll
                for (int r = 0; r < 16; ++r) YB[(size_t)(t0 + 32 * ti + crow(r, hi)) * RW + h * HD + vh * 32 + r32] = (bf16)f2bf(y[ti][r]); }
#undef FRAG
#undef CTILE
        }
        __syncthreads();
    }
}

__device__ __forceinline__ void attn_unit(const Args& a, int b, int h, int qb, float lim, LAS unsigned char* lds, int tid) {
    unsigned char* ws = a.ws;
    const bf16* FXQ = (const bf16*)(ws + WS_FXQ); const float* CUM = (const float*)(ws + WS_CUM) + (size_t)(b * NH + h) * SEQ; bf16* MIX = (bf16*)(ws + WS_MIX);
    const int lane = tid & 63, wid = tid >> 6, r32 = lane & 31, hi = lane >> 5;
    const size_t rowbase = (size_t)b * SEQ; const int q0 = qb * 256, qrow = q0 + wid * 32 + r32;
    bf16x8 qf[4];
    { const bf16* qp = FXQ + (rowbase + qrow) * FXP + h * HD + hi * 8;
#pragma unroll
      for (int ks = 0; ks < 4; ++ks) qf[ks] = *(const bf16x8*)(qp + ks * 16); }
    f32x16 o0, o1;
#pragma unroll
    for (int r = 0; r < 16; ++r) { o0[r] = 0.f; o1[r] = 0.f; }
    float m = -INFINITY, l = 0.f;
    const int NT = (q0 + 256) / 64; const float cref = CUM[q0];
    LAS float* ckf = (LAS float*)(lds + 16384);
    const int jlo = __syncthreads_count((tid < 4 * qb) && (cref - CUM[tid * 64 + 63] < -lim));
    for (int kt = jlo; kt < NT; ++kt) {
        __syncthreads();
        { const int key = tid >> 3, ch = tid & 7; const size_t grow = rowbase + (size_t)kt * 64 + key;
          const u32x4 kv = *(const u32x4*)(FXQ + grow * FXP + RW + h * HD + ch * 8);
          const u32x4 vv = *(const u32x4*)(FXQ + grow * FXP + 2 * RW + h * HD + ch * 8);
          *(LAS u32x4*)(lds + key * 128 + ((ch ^ (key & 7)) * 16)) = kv;
          *(LAS u32x4*)(lds + 8192 + key * 128 + ch * 16) = vv;
          if (tid < 64) ckf[tid] = (CUM[kt * 64 + tid] - cref) * LOG2E; }
        __syncthreads();
        if (kt * 64 > q0 + wid * 32 + 31) continue;
        f32x16 s0, s1;
#pragma unroll
        for (int r = 0; r < 16; ++r) { s0[r] = 0.f; s1[r] = 0.f; }
#pragma unroll
        for (int ks = 0; ks < 4; ++ks) { const int co = ((2 * ks + hi) ^ (r32 & 7)) * 16;
            const bf16x8 a0 = *(const LAS bf16x8*)(lds + r32 * 128 + co); const bf16x8 a1 = *(const LAS bf16x8*)(lds + (32 + r32) * 128 + co);
            s0 = __builtin_amdgcn_mfma_f32_32x32x16_bf16(a0, qf[ks], s0, 0, 0, 0); s1 = __builtin_amdgcn_mfma_f32_32x32x16_bf16(a1, qf[ks], s1, 0, 0, 0); }
        const bool diag = (kt * 64 + 63 > q0 + wid * 32);
        float mx = -INFINITY;
#pragma unroll
        for (int r = 0; r < 16; ++r) { const int k0 = crow(r, hi); float v0 = s0[r] - ckf[k0], v1 = s1[r] - ckf[32 + k0];
            if (diag) { if (kt * 64 + k0 > qrow) v0 = -INFINITY; if (kt * 64 + 32 + k0 > qrow) v1 = -INFINITY; }
            s0[r] = v0; s1[r] = v1; mx = fmaxf(mx, fmaxf(v0, v1)); }
        mx = fmaxf(mx, __shfl_xor(mx, 32));
        const float mnew = fmaxf(m, mx), alpha = exp2f(m - mnew); m = mnew;
        float ps = 0.f;
#pragma unroll
        for (int r = 0; r < 16; ++r) { s0[r] = exp2f(s0[r] - m); s1[r] = exp2f(s1[r] - m); ps += s0[r] + s1[r]; }
        l = l * alpha + ps;
#pragma unroll
        for (int r = 0; r < 16; ++r) { o0[r] *= alpha; o1[r] *= alpha; }
        bf16x8 pf[4];
#pragma unroll
        for (int s = 0; s < 2; ++s) { u32x4 w0, w1;
            w0.x = cvtpk(s0[8 * s], s0[8 * s + 1]); w0.y = cvtpk(s0[8 * s + 2], s0[8 * s + 3]); w0.z = cvtpk(s0[8 * s + 4], s0[8 * s + 5]); w0.w = cvtpk(s0[8 * s + 6], s0[8 * s + 7]);
            w1.x = cvtpk(s1[8 * s], s1[8 * s + 1]); w1.y = cvtpk(s1[8 * s + 2], s1[8 * s + 3]); w1.z = cvtpk(s1[8 * s + 4], s1[8 * s + 5]); w1.w = cvtpk(s1[8 * s + 6], s1[8 * s + 7]);
            pf[s] = __builtin_bit_cast(bf16x8, w0); pf[2 + s] = __builtin_bit_cast(bf16x8, w1); }
        const int q4 = (lane & 15) >> 2, p4 = lane & 3;
        LAS const unsigned char* vb = lds + 8192 + (4 * hi + q4) * 128 + (16 * ((lane >> 4) & 1) + 4 * p4) * 2;
#pragma unroll
        for (int s = 0; s < 4; ++s) {
#pragma unroll
            for (int db = 0; db < 2; ++db) { const s16x4 lo = vtr(vb + s * 16 * 128 + db * 64), hh = vtr(vb + s * 16 * 128 + 8 * 128 + db * 64);
                const bf16x8 vf = (bf16x8){lo[0], lo[1], lo[2], lo[3], hh[0], hh[1], hh[2], hh[3]};
                if (db == 0) o0 = __builtin_amdgcn_mfma_f32_32x32x16_bf16(vf, pf[s], o0, 0, 0, 0); else o1 = __builtin_amdgcn_mfma_f32_32x32x16_bf16(vf, pf[s], o1, 0, 0, 0); } }
    }
    l += __shfl_xor(l, 32);
    const float inv = 1.0f / l;
    const bf16* gp = FXQ + (rowbase + qrow) * FXP + 3 * RW + h * HD; bf16* op = MIX + (rowbase + qrow) * DM + RW + h * HD;
#pragma unroll
    for (int db = 0; db < 2; ++db)
#pragma unroll
        for (int g = 0; g < 4; ++g) { const int d = 32 * db + 8 * g + 4 * hi; const u32x2 gv = *(const u32x2*)(gp + d);
            const float g0 = sigmoidf_(__uint_as_float(gv.x << 16)), g1 = sigmoidf_(__uint_as_float(gv.x & 0xffff0000u)), g2 = sigmoidf_(__uint_as_float(gv.y << 16)), g3 = sigmoidf_(__uint_as_float(gv.y & 0xffff0000u));
            const float x0 = (db == 0 ? o0[4 * g] : o1[4 * g]) * inv * g0, x1 = (db == 0 ? o0[4 * g + 1] : o1[4 * g + 1]) * inv * g1, x2 = (db == 0 ? o0[4 * g + 2] : o1[4 * g + 2]) * inv * g2, x3 = (db == 0 ? o0[4 * g + 3] : o1[4 * g + 3]) * inv * g3;
            u32x2 w; w.x = cvtpk(x0, x1); w.y = cvtpk(x2, x3); *(u32x2*)(op + d) = w; }
}

__device__ __forceinline__ void phase_pool(const Args& a, int layer, int gw, int NGW, int lane) {
    unsigned char* ws = a.ws; const bf16* PL = (const bf16*)(ws + WS_PL); bf16* MIX = (bf16*)(ws + WS_MIX);
    const float* pw = a.in[24] + (size_t)layer * 4 * 64 * 64; const float* psc = a.in[25] + layer * 256;
    for (int it = gw; it < TT * 4; it += NGW) { const int tok = it >> 2, g = it & 3, win = 2 << g, s = tok % SEQ, n = (s + 1 < win) ? s + 1 : win;
        float sum = 0.f, cur = 0.f;
        for (int i = 0; i < n; ++i) { const float v = bf2f(PL[(size_t)(tok - i) * PLP + g * 64 + lane]); if (i == 0) cur = v; sum += v; }
        const float u = sum / (float)n - cur; const float* wg = pw + g * 4096 + lane; float y = 0.f;
#pragma unroll
        for (int c = 0; c < 64; ++c) y += rl(u, c) * wg[c * 64];
        MIX[(size_t)tok * DM + 768 + g * 64 + lane] = (bf16)f2bf(y * psc[g * 64 + lane]); }
}

__device__ __forceinline__ void phase_rwkv_out(const Args& a, int layer, int gw, int NGW, int lane) {
    unsigned char* ws = a.ws;
    const bf16* V = (const bf16*)(ws + (layer == 0 ? WS_VF : RP_V)); const bf16* YB = (const bf16*)(ws + WS_YB); const float* BONUS = (const float*)(ws + WS_BONUS);
    const bf16* GG = (const bf16*)(ws + RP_G); bf16* MIX = (bf16*)(ws + WS_MIX);
    const float* ln_w = a.in[19] + layer * RW; const float* ln_b = a.in[20] + layer * RW;
    for (int it = gw; it < TT * NH; it += NGW) { const int tok = it / NH, h = it % NH, c = h * HD + lane; const size_t o = (size_t)tok * RW + c;
        const float y = bf2f(YB[o]); const float mean = wave_sum(y) * (1.f / HD); const float d = y - mean; const float var = wave_sum(d * d) * (1.f / HD);
        const float yn = d * rsqrtf(var + GN_EPS) * ln_w[c] + ln_b[c];
        const float bonus = BONUS[it] * bf2f(V[o]);
        MIX[(size_t)tok * DM + c] = (bf16)f2bf((yn + bonus) * bf2f(GG[o])); }
}

__device__ __forceinline__ void phase_resnorm(const float* tmp, const float* xin, float* xout, const float* g1, const float* g2, bf16* hn, int gw, int NGW, int lane) {
    for (int m = gw; m < TT; m += NGW) {
        const f32x4* tr = (const f32x4*)(tmp + (size_t)m * DM) + lane; const f32x4* xr = (const f32x4*)(xin + (size_t)m * DM) + lane; f32x4* xo = (f32x4*)(xout + (size_t)m * DM) + lane;
        f32x4 v[4]; float s = 0.f;
#pragma unroll
        for (int j = 0; j < 4; ++j) { v[j] = tr[64 * j]; s += (v[j].x * v[j].x + v[j].y * v[j].y) + (v[j].z * v[j].z + v[j].w * v[j].w); }
        const float rs = rsqrtf(wave_sum(s) * (1.f / DM) + RMS_EPS); float s2 = 0.f;
#pragma unroll
        for (int j = 0; j < 4; ++j) { const f32x4 gg = ((const f32x4*)g1 + lane)[64 * j]; v[j] = xr[64 * j] + v[j] * rs * gg; xo[64 * j] = v[j];
            s2 += (v[j].x * v[j].x + v[j].y * v[j].y) + (v[j].z * v[j].z + v[j].w * v[j].w); }
        if (g2) { const float rs2 = rsqrtf(wave_sum(s2) * (1.f / DM) + RMS_EPS); unsigned long long* o8 = (unsigned long long*)(hn + (size_t)m * DM) + lane;
#pragma unroll
            for (int j = 0; j < 4; ++j) { const f32x4 gg = ((const f32x4*)g2 + lane)[64 * j];
                o8[64 * j] = (unsigned long long)pk2(v[j].x * rs2 * gg.x, v[j].y * rs2 * gg.y) | ((unsigned long long)pk2(v[j].z * rs2 * gg.z, v[j].w * rs2 * gg.w) << 32); } }
    }
}

constexpr int NPHASE = 1 + 10 * DEPTH;
__global__ void __launch_bounds__(512, 2) mega(Args a_unused) {
    extern __shared__ __attribute__((aligned(16))) unsigned char lds_raw[];
    int lo, hi; { const Args a0 = get_args(); lo = a0.lo; hi = a0.hi; }
    for (int ph = lo; ph < hi; ++ph) {
        const Args a = get_args(); unsigned char* ws = a.ws;
        int tid = threadIdx.x; asm volatile("" : "+v"(tid));
        int bid = blockIdx.x, G = gridDim.x; asm volatile("" : "+s"(bid), "+s"(G));
        LAS unsigned char* lds = (LAS unsigned char*)lds_raw; asm volatile("" : "+s"(lds));
        const int lane = tid & 63, wave = __builtin_amdgcn_readfirstlane(tid >> 6), gw = bid * 8 + wave, NGW = G * 8;
        if (ph > lo) {
#if MK_SINGLE
            cg::this_grid().sync();
#endif
        }
        if (ph == 0) { phase_prologue(a, lds, tid, G); continue; }
        const int layer = (ph - 1) / 10, sub = (ph - 1) % 10;
        const float* xin = layer == 0 ? a.in[0] : a.out;
        switch (sub) {
        case 0: { pg8::Gemm g{(const bf16*)(ws + WS_HN), (const bf16*)(ws + WS_WIN) + layer * WIN_L, TT, NIN, DM}; pg8::StaticOrder S; S.init(TT, NIN, G, bid);
                  pg8::EpiInProj E{(bf16*)(ws + WS_FR), (bf16*)(ws + WS_FXQ), (bf16*)(ws + WS_PL), (float*)(ws + WS_FF)};
                  pg8::gemm_phase<pg8::EpiInProj, pg8::StaticOrder, true, true>(lds, g, S, E); } break;
        case 1: phase_prep(a, layer, lds, tid, G); break;
        case 2: phase_cumsum(a, lds, tid, G); phase_rwkv_pre(a, layer, lds, tid, G); break;
        case 3: {
            if (bid < BATCH * NH) { rwkv_scan_chunked(a, layer, bid, lds, tid); }
            else { const int nb = G - BATCH * NH, bi = bid - BATCH * NH;
                float gq = fabsf(a.in[21][layer * HD + lane]), gk = fabsf(a.in[22][layer * HD + lane]);
#pragma unroll
                for (int o = 1; o < 64; o <<= 1) { gq = fmaxf(gq, __shfl_xor(gq, o)); gk = fmaxf(gk, __shfl_xor(gk, o)); }
                const float lim = 30.0f + 2.0f * 8.0f * 1.02f * gq * gk;
                unsigned* ticket = (unsigned*)(ws + WS_CTL) + 64 + layer * 64; LAS int* tk = (LAS int*)(lds + 20480);
                for (;;) { __syncthreads(); if (tid == 0) *tk = (int)atomicAdd(ticket, 1u); __syncthreads(); const int u = *tk; if (u >= BATCH * NH * 64) break;
                    const int qb = 63 - u / (BATCH * NH), bh = u % (BATCH * NH); attn_unit(a, bh / NH, bh % NH, qb, lim, lds, tid); }
                phase_pool(a, layer, bi * 8 + wave, nb * 8, lane); }
        } break;
        case 4: phase_rwkv_out(a, layer, gw, NGW, lane); break;
        case 5: { pg8::Gemm g{(const bf16*)(ws + WS_MIX), (const bf16*)(ws + WS_WOUT) + layer * WOUT_L, TT, DM, DM}; pg8::StaticOrder S; S.init(TT, DM, G, bid);
                  pg8::EpiF32 E{(float*)(ws + WS_TMP), DM};
                  pg8::gemm_phase<pg8::EpiF32, pg8::StaticOrder, true, true>(lds, g, S, E); } break;
        case 6: phase_resnorm((const float*)(ws + WS_TMP), xin, a.out, a.in[2] + layer * DM, a.in[3] + layer * DM, (bf16*)(ws + WS_HN), gw, NGW, lane); break;
        case 7: { pg8::Gemm g{(const bf16*)(ws + WS_HN), (const bf16*)(ws + WS_WGU) + layer * WGU_L, TT, 2 * FFH, DM}; pg8::StaticOrder S; S.init(TT, 2 * FFH, G, bid);
                  pg8::EpiSwiglu E{(bf16*)(ws + WS_H)};
                  pg8::gemm_phase<pg8::EpiSwiglu, pg8::StaticOrder, true, true>(lds, g, S, E); } break;
        case 8: { pg8::Gemm g{(const bf16*)(ws + WS_H), (const bf16*)(ws + WS_WDN) + layer * WDN_L, TT, DM, FFH}; pg8::StaticOrder S; S.init(TT, DM, G, bid);
                  pg8::EpiF32 E{(float*)(ws + WS_TMP), DM};
                  pg8::gemm_phase<pg8::EpiF32, pg8::StaticOrder, true, true>(lds, g, S, E); } break;
        case 9: phase_resnorm((const float*)(ws + WS_TMP), a.out, a.out, a.in[4] + layer * DM, layer + 1 < DEPTH ? a.in[1] + (layer + 1) * DM : nullptr, (bf16*)(ws + WS_HN), gw, NGW, lane); break;
        }
    }
}

extern "C" void kernel_launch(void* const* d_in, const int* in_sizes, int n_in, void* d_out, int out_size, void* d_ws, size_t ws_size, hipStream_t stream) {
    static int grid = 0;
    if (grid == 0) {
        if (n_in != 28 || out_size != TT * DM || ws_size < WS_END) { fprintf(stderr, "kernel_launch: unexpected shapes (n_in %d out %d ws %zu)\n", n_in, out_size, ws_size); grid = -1; return; }
        int dev = 0, cus = 0, per_cu = 0;
        hipGetDevice(&dev); hipDeviceGetAttribute(&cus, hipDeviceAttributeMultiprocessorCount, dev);
        hipFuncSetAttribute((const void*)mega, hipFuncAttributeMaxDynamicSharedMemorySize, LDS_BYTES);
        hipOccupancyMaxActiveBlocksPerMultiprocessor(&per_cu, (const void*)mega, 512, LDS_BYTES);
        if (per_cu < 1) { fprintf(stderr, "kernel_launch: occupancy query says %d blocks per CU\n", per_cu); per_cu = 1; }
        (void)hipGetLastError();
        grid = cus * 1;
    }
    if (grid < 0) return;
    hipMemsetAsync((char*)d_ws + WS_CTL, 0, CTL_BYTES, stream);
    Args a{};
    for (int i = 0; i < 28; ++i) a.in[i] = (const float*)d_in[i];
    a.out = (float*)d_out; a.ws = (unsigned char*)d_ws;
#if MK_SINGLE
    a.lo = 0; a.hi = NPHASE;
    void* args[] = {&a};
    hipError_t e = hipLaunchCooperativeKernel((const void*)mega, dim3(grid), dim3(512), args, LDS_BYTES, stream);
    if (e != hipSuccess) fprintf(stderr, "cooperative launch failed: %s (grid %d)\n", hipGetErrorString(e), grid);
#else
    for (int ph = 0; ph < NPHASE; ++ph) { a.lo = ph; a.hi = ph + 1; hipLaunchKernelGGL(mega, dim3(grid), dim3(512), LDS_BYTES, stream, a); }
#endif
}
```

```cpp
#include <hip/hip_runtime.h>
#include <hip/hip_cooperative_groups.h>
#include <cstdio>
#include <cstdint>
namespace pg8 {
#define PG8_LAS __attribute__((address_space(3)))
typedef unsigned short bf16_t;
typedef short bf16x8 __attribute__((ext_vector_type(8)));
typedef float f32x4 __attribute__((ext_vector_type(4)));
typedef unsigned u32x4 __attribute__((ext_vector_type(4)));
constexpr int BM = 256, BK = 64, HALF = 128, HTB = HALF * BK * 2  , STAGE_BYTES = 8 * HTB, NXCD = 8, WGM = 8;

__host__ __device__ __forceinline__ int lds_byte(int r, int c) { const int st = (r >> 4) * 2 + (c >> 5), rr = r & 15, cc = c & 31, ob = rr * 64 + cc * 2; return st * 1024 + (ob ^ (((ob >> 9) & 1) << 5)); }
__host__ __device__ __forceinline__ void stage_rc(int b, int& R, int& C) { const int st = b / 1024, sb = b % 1024, swz = sb ^ (((sb >> 9) & 1) << 5); R = (st >> 1) * 16 + swz / 64; C = (st & 1) * 32 + (swz % 64) / 2; }
__host__ __device__ __forceinline__ int perm32(int rho) { const int n = rho >> 4, i = rho & 15; return 8 * (i >> 2) + 4 * n + (i & 3); }

struct Unit { int pm, pn; };
struct Gemm { const bf16_t* A; const bf16_t* Bt; int M, N, K; };

struct StaticOrder {
    int nM, nN, nwg, G, c;
    __host__ __device__ void init(int M, int N, int G_, int c_) { nM = M / BM; nN = N / BM; nwg = nM * nN; G = G_; c = c_; }
    __host__ __device__ bool next(int i, Unit& u) const {
        const long L = (long)i * G + c; if (L >= nwg) return false;
        int wgid = (int)L; { const int q = nwg / NXCD, r = nwg % NXCD, xcd = wgid % NXCD, off = wgid / NXCD; wgid = (xcd < r ? xcd * (q + 1) : r * (q + 1) + (xcd - r) * q) + off; }
        const int nig = WGM * nN, gid = wgid / nig, fm = gid * WGM, gsz = (nM - fm) < WGM ? (nM - fm) : WGM;
        u.pm = fm + ((wgid % nig) % gsz); u.pn = (wgid % nig) / gsz; return true;
    }
    __device__ __forceinline__ void a_ready(const Unit&) const {}
    __device__ __forceinline__ void done(const Unit&) const {}
};

__device__ __forceinline__ unsigned cvt_pk_bf16(float lo, float hi) { unsigned r; asm volatile("v_cvt_pk_bf16_f32 %0, %1, %2" : "=v"(r) : "v"(lo), "v"(hi)); return r; }
typedef float f32x2 __attribute__((ext_vector_type(2)));
template <class Epi, class Sched, bool ALIGN_EPI = false, bool SP2 = false>
__device__ __forceinline__ void gemm_phase(PG8_LAS unsigned char* lds, const Gemm g, const Sched& S, const Epi& E) {
    int tid_ = threadIdx.x; asm volatile("" : "+v"(tid_));
    const int tid = tid_, wid = __builtin_amdgcn_readfirstlane(tid >> 6), lane = tid & 63, wr = wid >> 2, wc = wid & 3, fr = lane & 15, fq = lane >> 4;
    const int K = g.K, nt = K / BK;
    unsigned voffA[2], voffB[2];
#pragma unroll
    for (int i = 0; i < 2; ++i) { int R, C; stage_rc(tid * 16 + i * 8192, R, C); const int Rb = Epi::PERM ? ((R & ~31) + perm32(R & 31)) : R;
        voffA[i] = (unsigned)(R * K + C) * 2u; voffB[i] = (unsigned)(Rb * K + C) * 2u; }
    const size_t kstep = (size_t)(BK * 2);
    const size_t hstep = (size_t)HALF * K * 2;
    const size_t tstep = 2 * hstep;
    const unsigned ldsw = (unsigned)wid * 1024u;
    const int aoff = lds_byte(wr * 64 + fr, fq * 8), boff = lds_byte(wc * 32 + fr, fq * 8);
#define PG8_SA(b, h) (((b) * 2 + (h)) * HTB)
#define PG8_SB(b, h) ((4 + (b) * 2 + (h)) * HTB)
#define PG8_STAGE(bufoff, gbase, voff) do { _Pragma("unroll") for (int _i = 0; _i < 2; ++_i) \
        __builtin_amdgcn_global_load_lds((const unsigned*)((const char*)(gbase) + (voff)[_i]), (PG8_LAS unsigned*)(lds + (bufoff) + ldsw + _i * 8192), 16, 0, 0); } while (0)
#define PG8_LDA(dst, b, h) do { _Pragma("unroll") for (int m = 0; m < 4; ++m) _Pragma("unroll") for (int k = 0; k < 2; ++k) dst[m][k] = *(const PG8_LAS bf16x8*)(lds + PG8_SA(b, h) + aoff + m * 2048 + k * 1024); } while (0)
#define PG8_LDB(dst, b, h) do { _Pragma("unroll") for (int n = 0; n < 2; ++n) _Pragma("unroll") for (int k = 0; k < 2; ++k) dst[n][k] = *(const PG8_LAS bf16x8*)(lds + PG8_SB(b, h) + boff + n * 2048 + k * 1024); } while (0)
#define PG8_MMA(ai, bj, At, Bt) do { __builtin_amdgcn_s_setprio(1); _Pragma("unroll") for (int m = 0; m < 4; ++m) _Pragma("unroll") for (int n = 0; n < 2; ++n) _Pragma("unroll") for (int k = 0; k < 2; ++k) \
        acc[ai][bj][m][n] = __builtin_amdgcn_mfma_f32_16x16x32_bf16(Bt[n][k], At[m][k], acc[ai][bj][m][n], 0, 0, 0); __builtin_amdgcn_s_setprio(0); } while (0)
#define PG8_WAIT_V(n) asm volatile("s_waitcnt vmcnt(" #n ")" ::: "memory")
#define PG8_WAIT_L(n) asm volatile("s_waitcnt lgkmcnt(" #n ")" ::: "memory")
#define PG8_BAR __builtin_amdgcn_s_barrier()
#define PG8_SCHED __builtin_amdgcn_sched_barrier(0)
    Unit cur, nxt; int ui = 0;
    if (!S.next(0, cur)) return;
    f32x4 acc[2][2][4][2];
#pragma unroll
    for (int a = 0; a < 2; ++a)
#pragma unroll
        for (int b = 0; b < 2; ++b)
#pragma unroll
            for (int m = 0; m < 4; ++m)
#pragma unroll
                for (int n = 0; n < 2; ++n) acc[a][b][m][n] = (f32x4){0.f, 0.f, 0.f, 0.f};
    bf16x8 At[4][2], B0[2][2], B1[2][2];
    const char* cA = (const char*)g.A + (size_t)cur.pm * tstep; const char* cB = (const char*)g.Bt + (size_t)cur.pn * tstep;
    S.a_ready(cur);
    if constexpr (SP2) {
        PG8_STAGE(PG8_SB(0, 0), cB, voffB); PG8_STAGE(PG8_SB(0, 1), cB + hstep, voffB); PG8_STAGE(PG8_SA(0, 0), cA, voffA); PG8_STAGE(PG8_SA(0, 1), cA + hstep, voffA);
        if (wr == 1) PG8_BAR;
        PG8_WAIT_V(2); PG8_BAR;
        PG8_STAGE(PG8_SB(1, 0), cB + kstep, voffB); PG8_STAGE(PG8_SA(1, 0), cA + kstep, voffA); PG8_STAGE(PG8_SB(1, 1), cB + hstep + kstep, voffB);
        PG8_WAIT_V(6); PG8_BAR;
    } else {
        PG8_STAGE(PG8_SB(0, 0), cB, voffB); PG8_STAGE(PG8_SA(0, 0), cA, voffA); PG8_STAGE(PG8_SB(0, 1), cB + hstep, voffB); PG8_STAGE(PG8_SA(0, 1), cA + hstep, voffA);
        if (wr == 1) PG8_BAR;
        PG8_WAIT_V(4); PG8_BAR;
        PG8_STAGE(PG8_SB(1, 0), cB + kstep, voffB); PG8_STAGE(PG8_SA(1, 0), cA + kstep, voffA); PG8_STAGE(PG8_SB(1, 1), cB + hstep + kstep, voffB);
        PG8_WAIT_V(6); PG8_BAR;
    }
    for (;;) {
        const bool has_next = S.next(ui + 1, nxt);
        const char* nA = has_next ? (const char*)g.A + (size_t)nxt.pm * tstep : cA; const char* nB = has_next ? (const char*)g.Bt + (size_t)nxt.pn * tstep : cB;
        for (int t = 0; t < nt; t += 2) {
            const bool last = (t == nt - 2);
            const char* a1 = cA + (size_t)(t + 1) * kstep;
            const char* a2 = last ? nA : cA + (size_t)(t + 2) * kstep; const char* b2 = last ? nB : cB + (size_t)(t + 2) * kstep;
            const char* a3 = a2 + kstep; const char* b3 = b2 + kstep;
            if (last && has_next) S.a_ready(nxt);
            if constexpr (SP2) {
            PG8_LDB(B0, 0, 0); PG8_LDB(B1, 0, 1); PG8_SCHED; PG8_LDA(At, 0, 0); PG8_STAGE(PG8_SA(1, 1), a1 + hstep, voffA);
            PG8_WAIT_V(8); PG8_WAIT_L(0); PG8_BAR; PG8_MMA(0, 0, At, B0); PG8_MMA(0, 1, At, B1); PG8_BAR; PG8_SCHED;
            PG8_LDA(At, 0, 1); PG8_STAGE(PG8_SB(0, 0), b2, voffB); PG8_STAGE(PG8_SB(0, 1), b2 + hstep, voffB); PG8_STAGE(PG8_SA(0, 0), a2, voffA);
            PG8_WAIT_V(8); PG8_WAIT_L(0); PG8_BAR; PG8_MMA(1, 0, At, B0); PG8_MMA(1, 1, At, B1); PG8_BAR; PG8_SCHED;
            PG8_LDB(B0, 1, 0); PG8_LDB(B1, 1, 1); PG8_SCHED; PG8_LDA(At, 1, 0); PG8_STAGE(PG8_SA(0, 1), a2 + hstep, voffA);
            PG8_WAIT_V(8); PG8_WAIT_L(0); PG8_BAR; PG8_MMA(0, 0, At, B0); PG8_MMA(0, 1, At, B1); PG8_BAR; PG8_SCHED;
            PG8_LDA(At, 1, 1); PG8_STAGE(PG8_SB(1, 0), b3, voffB); PG8_STAGE(PG8_SB(1, 1), b3 + hstep, voffB); PG8_STAGE(PG8_SA(1, 0), a3, voffA);
            PG8_WAIT_V(8); PG8_WAIT_L(0); PG8_BAR; PG8_MMA(1, 0, At, B0); PG8_MMA(1, 1, At, B1); PG8_BAR; PG8_SCHED;
            } else {
            PG8_LDB(B0, 0, 0); PG8_SCHED; PG8_LDA(At, 0, 0); PG8_STAGE(PG8_SA(1, 1), a1 + hstep, voffA);
            PG8_WAIT_L(8); PG8_BAR; PG8_WAIT_L(0); PG8_MMA(0, 0, At, B0); PG8_BAR; PG8_SCHED;
            PG8_LDB(B1, 0, 1); PG8_STAGE(PG8_SB(0, 0), b2, voffB);
            PG8_BAR; PG8_WAIT_L(0); PG8_MMA(0, 1, At, B1); PG8_BAR;
            PG8_LDA(At, 0, 1); PG8_STAGE(PG8_SA(0, 0), a2, voffA);
            PG8_BAR; PG8_WAIT_L(0); PG8_MMA(1, 0, At, B0); PG8_BAR; PG8_SCHED;
            PG8_STAGE(PG8_SB(0, 1), b2 + hstep, voffB);
            PG8_WAIT_V(6); PG8_BAR; PG8_MMA(1, 1, At, B1); PG8_BAR;
            PG8_LDB(B0, 1, 0); PG8_SCHED; PG8_LDA(At, 1, 0); PG8_STAGE(PG8_SA(0, 1), a2 + hstep, voffA);
            PG8_WAIT_L(8); PG8_BAR; PG8_WAIT_L(0); PG8_MMA(0, 0, At, B0); PG8_BAR; PG8_SCHED;
            PG8_LDB(B1, 1, 1); PG8_STAGE(PG8_SB(1, 0), b3, voffB);
            PG8_BAR; PG8_WAIT_L(0); PG8_MMA(0, 1, At, B1); PG8_BAR;
            PG8_LDA(At, 1, 1); PG8_STAGE(PG8_SA(1, 0), a3, voffA);
            PG8_BAR; PG8_WAIT_L(0); PG8_MMA(1, 0, At, B0); PG8_BAR; PG8_SCHED;
            PG8_STAGE(PG8_SB(1, 1), b3 + hstep, voffB);
            PG8_WAIT_V(6); PG8_BAR; PG8_MMA(1, 1, At, B1); PG8_BAR;
            }
        }
        if constexpr (ALIGN_EPI) { if (wr == 0) PG8_BAR; }
        if constexpr (!Epi::AFTER_DRAIN) { E(acc, cur, wr, wc, fr, fq); S.done(cur); }
        if (!has_next) break;
#pragma unroll
        for (int a = 0; a < 2; ++a)
#pragma unroll
            for (int b = 0; b < 2; ++b)
#pragma unroll
                for (int m = 0; m < 4; ++m)
#pragma unroll
                    for (int n = 0; n < 2; ++n) acc[a][b][m][n] = (f32x4){0.f, 0.f, 0.f, 0.f};
        cur = nxt; cA = nA; cB = nB; ++ui;
        if constexpr (ALIGN_EPI) { if (wr == 1) PG8_BAR; }
    }
    PG8_WAIT_V(0);
    if constexpr (!ALIGN_EPI) { if (wr == 0) PG8_BAR; }
    PG8_BAR;
    if constexpr (Epi::AFTER_DRAIN) { E.fused(acc, cur, wr, wc, fr, fq, lds, wid, lane); S.done(cur); }
#undef PG8_SA
#undef PG8_SB
#undef PG8_STAGE
#undef PG8_LDA
#undef PG8_LDB
#undef PG8_MMA
#undef PG8_WAIT_V
#undef PG8_WAIT_L
#undef PG8_BAR
#undef PG8_SCHED
}
}

namespace cg = cooperative_groups;
#ifndef MK_SINGLE
#define MK_SINGLE 1
#endif
constexpr int DM = 1024, BATCH = 2, SEQ = 16384, TT = BATCH * SEQ, DEPTH = 2;
constexpr int NH = 6, HD = 64, RW = 384, DIN = 3238, NIN = 3328, FFH = 2816;
constexpr int FRP = 1536, FXP = 1536, PLP = 256;
constexpr float RMS_EPS = 1e-6f, GN_EPS = 64e-5f, LOG2E = 1.4426950408889634f;
constexpr float QSCALE = 0.125f * 1.4426950408889634f;

constexpr size_t MiB = 1u << 20;
constexpr size_t WS_CTL = 0, CTL_BYTES = 1 * MiB;
constexpr size_t WS_WIN = 1 * MiB, WS_WOUT = 14 * MiB, WS_WGU = 18 * MiB, WS_WDN = 40 * MiB;
constexpr size_t WS_FR = 52 * MiB, WS_MIX = 52 * MiB, WS_H = 52 * MiB;
constexpr size_t WS_FXQ = 148 * MiB, WS_PL = 244 * MiB, WS_FF = 260 * MiB, WS_LF = 261 * MiB, WS_CUM = 262 * MiB;
constexpr size_t WS_VF = 264 * MiB;
constexpr size_t WS_LORA = 506 * MiB;
constexpr size_t WS_RP = 288 * MiB, WS_HN = 288 * MiB, WS_TMP = 352 * MiB;
constexpr size_t RP_R = WS_RP, RP_K = WS_RP + 24 * MiB, RP_V = WS_RP + 48 * MiB, RP_KK = WS_RP + 72 * MiB, RP_BB = WS_RP + 96 * MiB, RP_LW = WS_RP + 120 * MiB, RP_G = WS_RP + 168 * MiB;
constexpr size_t WS_YB = 116 * MiB;
constexpr size_t WS_Y0 = 480 * MiB, WS_PC = 504 * MiB, WS_BONUS = 505 * MiB;
constexpr size_t WS_END = 507 * MiB;
constexpr size_t WIN_L = (size_t)NIN * DM, WOUT_L = (size_t)DM * DM, WGU_L = (size_t)2 * FFH * DM, WDN_L = (size_t)DM * FFH;

constexpr int LDS_BYTES = 147456;

#define LAS __attribute__((address_space(3)))
typedef unsigned short bf16;
typedef float f32x4 __attribute__((ext_vector_type(4)));
typedef float f32x16 __attribute__((ext_vector_type(16)));
typedef short bf16x8 __attribute__((ext_vector_type(8)));
typedef short s16x4 __attribute__((ext_vector_type(4)));
typedef unsigned u32x4 __attribute__((ext_vector_type(4)));
typedef unsigned u32x2 __attribute__((ext_vector_type(2)));

__device__ __forceinline__ float bf2f(bf16 v) { return __uint_as_float((unsigned)v << 16); }
__device__ __forceinline__ unsigned f2bf(float f) { unsigned u = __float_as_uint(f); return (u + 0x7fffu + ((u >> 16) & 1u)) >> 16; }
__device__ __forceinline__ unsigned pk2(float lo, float hi) { return f2bf(lo) | (f2bf(hi) << 16); }
__device__ __forceinline__ float sigmoidf_(float x) { return 1.0f / (1.0f + __expf(-x)); }
__device__ __forceinline__ float wave_sum(float v) {
#pragma unroll
    for (int o = 1; o < 64; o <<= 1) v += __shfl_xor(v, o);
    return v;
}

struct Args { const float* in[28]; float* out; unsigned char* ws; int lo, hi; };
typedef const Args __attribute__((address_space(4)))* ArgsP;
__device__ __forceinline__ Args get_args() {
#if defined(__HIP_DEVICE_COMPILE__)
    ArgsP p = (ArgsP)__builtin_amdgcn_kernarg_segment_ptr(); asm volatile("" : "+s"(p)); return *p;
#else
    return Args{};
#endif
}

namespace pg8 {
struct EpiInProj {
    static constexpr bool PERM = true, AFTER_DRAIN = false;
    bf16_t* FR; bf16_t* FXQ; bf16_t* PL; float* FF;
    __device__ __forceinline__ void operator()(const f32x4 (&acc)[2][2][4][2], const Unit& u, int wr, int wc, int fr, int fq) const {
        bf16_t* base; int ldc, colt;
        if (u.pn < 6) { base = FR; ldc = FRP; colt = u.pn * 256; }
        else if (u.pn < 12) { base = FXQ; ldc = FXP; colt = (u.pn - 6) * 256; }
        else { base = PL; ldc = PLP; colt = 0; }
        const int row0 = u.pm * BM + wr * 64 + fr, col0 = colt + wc * 32 + 8 * fq;
        const bool ffl = (u.pn == 5) && (wc == 1) && (fq == 0);
#pragma unroll
        for (int ai = 0; ai < 2; ++ai)
#pragma unroll
            for (int m = 0; m < 4; ++m) { const int row = row0 + ai * HALF + m * 16; bf16_t* rowp = base + (size_t)row * ldc + col0;
#pragma unroll
                for (int bj = 0; bj < 2; ++bj) { const f32x4 v0 = acc[ai][bj][m][0], v1 = acc[ai][bj][m][1];
                    u32x4 w; w.x = cvt_pk_bf16(v0[0], v0[1]); w.y = cvt_pk_bf16(v0[2], v0[3]); w.z = cvt_pk_bf16(v1[0], v1[1]); w.w = cvt_pk_bf16(v1[2], v1[3]);
                    *(u32x4*)(rowp + bj * HALF) = w;
                    if (bj == 1 && ffl) { *(f32x4*)(FF + (size_t)row * 8) = v0; *(f32x4*)(FF + (size_t)row * 8 + 4) = v1; } } }
    }
};
struct EpiSwiglu {
    static constexpr bool PERM = true, AFTER_DRAIN = false;
    bf16_t* H;
    __device__ __forceinline__ void operator()(const f32x4 (&acc)[2][2][4][2], const Unit& u, int wr, int wc, int fr, int fq) const {
        const int row0 = u.pm * BM + wr * 64 + fr, col0 = u.pn * 128 + wc * 32 + 8 * fq;
#pragma unroll
        for (int ai = 0; ai < 2; ++ai)
#pragma unroll
            for (int m = 0; m < 4; ++m) { bf16_t* rowp = H + (size_t)(row0 + ai * HALF + m * 16) * FFH + col0;
                float h[8];
#pragma unroll
                for (int n = 0; n < 2; ++n)
#pragma unroll
                    for (int e = 0; e < 4; ++e) { const float g = acc[ai][0][m][n][e], up = acc[ai][1][m][n][e]; h[n * 4 + e] = g / (1.0f + __expf(-g)) * up; }
                u32x4 w; w.x = cvt_pk_bf16(h[0], h[1]); w.y = cvt_pk_bf16(h[2], h[3]); w.z = cvt_pk_bf16(h[4], h[5]); w.w = cvt_pk_bf16(h[6], h[7]);
                *(u32x4*)rowp = w; }
    }
};
struct EpiF32 {
    static constexpr bool PERM = false, AFTER_DRAIN = false;
    float* O; int ldc;
    __device__ __forceinline__ void operator()(const f32x4 (&acc)[2][2][4][2], const Unit& u, int wr, int wc, int fr, int fq) const {
        const int row0 = u.pm * BM + wr * 64 + fr, col0 = u.pn * BM + wc * 32 + 4 * fq;
#pragma unroll
        for (int ai = 0; ai < 2; ++ai)
#pragma unroll
            for (int m = 0; m < 4; ++m) { float* rowp = O + (size_t)(row0 + ai * HALF + m * 16) * ldc + col0;
#pragma unroll
                for (int bj = 0; bj < 2; ++bj)
#pragma unroll
                    for (int n = 0; n < 2; ++n) *(f32x4*)(rowp + bj * HALF + n * 16) = acc[ai][bj][m][n]; }
    }
};
}

template <int MODE> __device__ __forceinline__ int wmap(int n) {
    if (MODE == 0) { if (n < 1440) return n; if (n < 2976) return n + 96; if (n < 2982) return n - 1536; return n + 90; }
    if (MODE == 1) { if (n < FFH) return 256 * (n >> 7) + (n & 127); const int j = n - FFH; return 256 * (j >> 7) + 128 + (j & 127); }
    return n;
}
template <int MODE> __device__ __forceinline__ void tr_item(const float* W, int K, int N, bf16* WT, LAS float* scr, int item, int lane) {
    const int nblk = (N + 31) / 32, kb = item / nblk, nb = item % nblk, k0 = 64 * kb, n0 = 32 * nb;
    const int nl = lane & 31, n = n0 + nl;
#pragma unroll 8
    for (int i = 0; i < 32; ++i) { const int kk = 2 * i + (lane >> 5); scr[kk * 33 + nl] = (n < N) ? W[(size_t)(k0 + kk) * N + n] : 0.f; }
    asm volatile("s_waitcnt lgkmcnt(0)" ::: "memory");
    const int c = lane & 7;
#pragma unroll
    for (int j = 0; j < 4; ++j) { const int nn = (lane >> 3) + 8 * j; const LAS float* s = scr + (8 * c) * 33 + nn;
        u32x4 o; o.x = pk2(s[0 * 33], s[1 * 33]); o.y = pk2(s[2 * 33], s[3 * 33]); o.z = pk2(s[4 * 33], s[5 * 33]); o.w = pk2(s[6 * 33], s[7 * 33]);
        if (n0 + nn < N) *(u32x4*)(WT + (size_t)wmap<MODE>(n0 + nn) * K + k0 + 8 * c) = o; }
    asm volatile("s_waitcnt lgkmcnt(0)" ::: "memory");
}
__device__ __forceinline__ void rms_row_bf16(const float* xrow, const float* g, bf16* orow, int lane) {
    const f32x4* xr = (const f32x4*)xrow + lane; const f32x4* gr = (const f32x4*)g + lane;
    f32x4 v[4]; float s = 0.f;
#pragma unroll
    for (int j = 0; j < 4; ++j) { v[j] = xr[64 * j]; s += (v[j].x * v[j].x + v[j].y * v[j].y) + (v[j].z * v[j].z + v[j].w * v[j].w); }
    const float rs = rsqrtf(wave_sum(s) * (1.f / DM) + RMS_EPS);
    unsigned long long* o8 = (unsigned long long*)orow + lane;
#pragma unroll
    for (int j = 0; j < 4; ++j) { const f32x4 gg = gr[64 * j];
        o8[64 * j] = (unsigned long long)pk2(v[j].x * rs * gg.x, v[j].y * rs * gg.y) | ((unsigned long long)pk2(v[j].z * rs * gg.z, v[j].w * rs * gg.w) << 32); }
}
__device__ __forceinline__ void phase_prologue(const Args& a, LAS unsigned char* lds, int tid, int G) {
    const int lane = tid & 63, wave = tid >> 6, gw = blockIdx.x * 8 + wave, NGW = G * 8;
    LAS float* scr = (LAS float*)(lds + wave * 16384);
    unsigned char* ws = a.ws;
    constexpr int I_IN = 16 * 102, I_GU = 16 * 176, I_OUT = 16 * 32, I_DN = 44 * 32, I_L = I_IN + I_GU + I_OUT + I_DN;
    for (int it = gw; it < DEPTH * I_L; it += NGW) {
        const int l = it / I_L; int r = it % I_L;
        if (r < I_IN) { tr_item<0>(a.in[5] + (size_t)l * DM * DIN, DM, DIN, (bf16*)(ws + WS_WIN) + l * WIN_L, scr, r, lane); continue; } r -= I_IN;
        if (r < I_GU) { tr_item<1>(a.in[26] + (size_t)l * DM * 2 * FFH, DM, 2 * FFH, (bf16*)(ws + WS_WGU) + l * WGU_L, scr, r, lane); continue; } r -= I_GU;
        if (r < I_OUT) { tr_item<2>(a.in[6] + (size_t)l * DM * DM, DM, DM, (bf16*)(ws + WS_WOUT) + l * WOUT_L, scr, r, lane); continue; } r -= I_OUT;
        tr_item<2>(a.in[27] + (size_t)l * FFH * DM, FFH, DM, (bf16*)(ws + WS_WDN) + l * WDN_L, scr, r, lane);
    }
    for (int i = blockIdx.x * 512 + tid; i < DEPTH * 90 * (DM / 8); i += G * 512) { const int l = i / (90 * (DM / 8)), r = i % (90 * (DM / 8));
        *(u32x4*)((bf16*)(ws + WS_WIN) + l * WIN_L + (size_t)(1446 + r / (DM / 8)) * DM + (r % (DM / 8)) * 8) = (u32x4){0u, 0u, 0u, 0u}; }
    { bf16* L = (bf16*)(ws + WS_LORA);
      for (int i = blockIdx.x * 512 + tid; i < 245760; i += G * 512) { float v;
          if (i < 98304) { const int m = i / 49152, r = i % 49152, l = r / 24576, n = (r % 24576) / 64, k = r % 64; v = a.in[m == 0 ? 9 : 11][(size_t)l * 64 * RW + k * RW + n]; }
          else if (i < 221184) { const int r = i - 98304, l = r / 61440, n = (r % 61440) / 160, k = r % 160; v = a.in[12][(size_t)l * 160 * RW + k * RW + n]; }
          else if (i < 233472) { const int r = i - 221184, n = r / 384, k = r % 384; v = a.in[14][k * 32 + n]; }
          else { const int r = i - 233472, n = r / 32, k = r % 32; v = a.in[15][k * RW + n]; }
          L[i] = (bf16)f2bf(v); } }
    for (int m = gw; m < TT; m += NGW) rms_row_bf16(a.in[0] + (size_t)m * DM, a.in[1], (bf16*)(ws + WS_HN) + (size_t)m * DM, lane);
}

__device__ __forceinline__ void phase_prep(const Args& a, int layer, LAS unsigned char* lds, int tid, int G) {
    unsigned char* ws = a.ws;
    const int lane = tid & 63, wave = tid >> 6;
    LAS float* F = (LAS float*)lds;
    LAS float* TV = (LAS float*)(lds + 92160);
    const bf16* FR = (const bf16*)(ws + WS_FR); bf16* FXQ = (bf16*)(ws + WS_FXQ); const float* FF = (const float*)(ws + WS_FF);
    const float* mu = a.in[7] + layer * 1440; const float* w0 = a.in[8] + layer * RW; const float* w2 = a.in[9] + (size_t)layer * 64 * RW;
    const float* a0 = a.in[10] + layer * RW; const float* a2 = a.in[11] + (size_t)layer * 64 * RW; const float* g2 = a.in[12] + (size_t)layer * 160 * RW;
    const float* v0 = a.in[13]; const float* v1 = a.in[14]; const float* v2 = a.in[15];
    const float* k_k = a.in[16] + layer * RW; const float* k_a = a.in[17] + layer * RW;
    const float* q_g = a.in[21] + layer * HD; const float* k_g = a.in[22] + layer * HD; const float* f_b = a.in[23] + layer * NH;
    bf16* R = (bf16*)(ws + RP_R); bf16* K = (bf16*)(ws + RP_K); bf16* V = (bf16*)(ws + (layer == 0 ? WS_VF : RP_V)); const bf16* VF = (const bf16*)(ws + WS_VF);
    bf16* KK = (bf16*)(ws + RP_KK); bf16* BB = (bf16*)(ws + RP_BB); float* LW = (float*)(ws + RP_LW); bf16* GG = (bf16*)(ws + RP_G);
    float* LF = (float*)(ws + WS_LF); float* BONUS = (float*)(ws + WS_BONUS); const float* r_k = a.in[18] + layer * RW;
    for (int item = blockIdx.x; item < TT / 16; item += G) {
        const int t0 = item * 16, s0 = t0 % SEQ, bb = t0 / SEQ;
        __syncthreads();
        for (int idx = tid; idx < 16 * 1440; idx += 512) { const int tok = idx / 1440, c = idx % 1440;
            const float cur = bf2f(FR[(size_t)(t0 + tok) * FRP + c]); const float prev = (s0 + tok == 0) ? 0.f : bf2f(FR[(size_t)(t0 + tok - 1) * FRP + c]);
            float f = cur + (prev - cur) * mu[c];
            if (c >= 1152 && c < 1216) f = tanhf(f); else if (c >= 1280) f = sigmoidf_(f);
            F[idx] = f; }
        __syncthreads();
        if (layer > 0) { const int tok = tid >> 5, o = tid & 31; float s = 0.f;
            for (int c = 0; c < RW; ++c) s += F[tok * 1440 + 768 + c] * v1[c * 32 + o];
            TV[tok * 32 + o] = s; }
        __syncthreads();
        if (tid < RW) { const int j = tid;
            float aw[16], aa[16], ag[16];
#pragma unroll
            for (int t = 0; t < 16; ++t) { aw[t] = w0[j]; aa[t] = a0[j]; ag[t] = 0.f; }
            for (int i = 0; i < 64; ++i) { const float ww = w2[i * RW + j], av = a2[i * RW + j];
#pragma unroll
                for (int t = 0; t < 16; ++t) { aw[t] += F[t * 1440 + 1152 + i] * ww; aa[t] += F[t * 1440 + 1216 + i] * av; } }
            for (int i = 0; i < 160; ++i) { const float gv = g2[i * RW + j];
#pragma unroll
                for (int t = 0; t < 16; ++t) ag[t] += F[t * 1440 + 1280 + i] * gv; }
            const float kkj = k_k[j], kaj = k_a[j];
#pragma unroll
            for (int t = 0; t < 16; ++t) { const size_t o = (size_t)(t0 + t) * RW + j;
                const float lw = -0.6065306597126334f * sigmoidf_(aw[t]); const float av = sigmoidf_(aa[t]);
                const float r = F[t * 1440 + j], k = F[t * 1440 + 384 + j]; float v = F[t * 1440 + 768 + j];
                if (layer > 0) { float gs = v0[j];
#pragma unroll 8
                    for (int oo = 0; oo < 32; ++oo) gs += TV[t * 32 + oo] * v2[oo * RW + j];
                    v = v + (bf2f(VF[o]) - v) * sigmoidf_(gs); }
                const float kq = k * kkj; const float ss = wave_sum(kq * kq); const float kkn = kq / fmaxf(sqrtf(ss), 1e-12f);
                { const float bs = wave_sum(r * (k * (1.0f + (av - 1.0f) * kaj)) * r_k[j]); if (lane == 0) BONUS[(size_t)(t0 + t) * NH + wave] = bs; }
                R[o] = (bf16)f2bf(r); K[o] = (bf16)f2bf(k * (1.0f + (av - 1.0f) * kaj)); V[o] = (bf16)f2bf(v); KK[o] = (bf16)f2bf(kkn); BB[o] = (bf16)f2bf(kkn * av);
                LW[o] = lw; GG[o] = (bf16)f2bf(ag[t]); }
        }
        for (int cmb = wave; cmb < 16 * NH * 2; cmb += 8) { const int tok = cmb / (NH * 2), rem = cmb % (NH * 2), hh = rem >> 1, which = rem & 1;
            bf16* p = FXQ + (size_t)(t0 + tok) * FXP + which * RW + hh * HD + lane; const float v = bf2f(*p);
            const float rs = rsqrtf(wave_sum(v * v) * (1.f / HD) + RMS_EPS);
            *p = (bf16)f2bf(which == 0 ? v * rs * q_g[lane] * QSCALE : v * rs * k_g[lane]); }
        if (tid < 16 * NH) { const int tok = tid / NH, hh = tid % NH; const float x = FF[(size_t)(t0 + tok) * 8 + hh] + f_b[hh];
            LF[(size_t)(bb * NH + hh) * SEQ + s0 + tok] = fminf(x, 0.f) - log1pf(__expf(-fabsf(x))); }
    }
}

__device__ __forceinline__ void phase_cumsum(const Args& a, LAS unsigned char* lds, int tid, int G) {
    const float* LF = (const float*)(a.ws + WS_LF); float* CUM = (float*)(a.ws + WS_CUM);
    LAS double* part = (LAS double*)lds;
    for (int ser = blockIdx.x; ser < BATCH * NH; ser += G) {
        const float* src = LF + (size_t)ser * SEQ + tid * 32; float* dst = CUM + (size_t)ser * SEQ + tid * 32;
        float v[32]; double s = 0.0;
#pragma unroll
        for (int i = 0; i < 32; ++i) { v[i] = src[i]; s += (double)v[i]; }
        __syncthreads(); part[tid] = s; __syncthreads();
        if (tid == 0) { double run = 0.0; for (int i = 0; i < 512; ++i) { const double t = part[i]; part[i] = run; run += t; } }
        __syncthreads();
        double run = part[tid];
#pragma unroll
        for (int i = 0; i < 32; ++i) { run += (double)v[i]; dst[i] = (float)run; }
    }
}

__device__ __forceinline__ float rl(float v, int k) { return __uint_as_float(__builtin_amdgcn_readlane(__float_as_uint(v), k)); }
__device__ __forceinline__ void rwkv_scan_naive(const Args& a, int layer, int bh, int lane) {
    unsigned char* ws = a.ws;
    const int b = bh / NH, h = bh % NH;
    const bf16* R = (const bf16*)(ws + RP_R); const bf16* K = (const bf16*)(ws + RP_K); const bf16* V = (const bf16*)(ws + (layer == 0 ? WS_VF : RP_V));
    const bf16* KK = (const bf16*)(ws + RP_KK); const bf16* BB = (const bf16*)(ws + RP_BB); float* LW = (float*)(ws + RP_LW);
    float S[64];
#pragma unroll
    for (int k = 0; k < 64; ++k) S[k] = 0.f;
    size_t o = (size_t)b * SEQ * RW + h * HD + lane;
    float rn = bf2f(R[o]), kn = bf2f(K[o]), vn = bf2f(V[o]), kkn = bf2f(KK[o]), bn = bf2f(BB[o]), wn = LW[o];
    for (int t = 0; t < SEQ; ++t) {
        const float rc = rn, kc = kn, vc = vn, kkc = -kkn, bc = bn, wc = __expf(wn);
        const size_t oc = o;
        if (t + 1 < SEQ) { o += RW; rn = bf2f(R[o]); kn = bf2f(K[o]); vn = bf2f(V[o]); kkn = bf2f(KK[o]); bn = bf2f(BB[o]); wn = LW[o]; }
        float sa0 = 0.f, sa1 = 0.f, sa2 = 0.f, sa3 = 0.f;
#pragma unroll
        for (int k = 0; k < 64; k += 4) { sa0 += S[k] * rl(kkc, k); sa1 += S[k + 1] * rl(kkc, k + 1); sa2 += S[k + 2] * rl(kkc, k + 2); sa3 += S[k + 3] * rl(kkc, k + 3); }
        const float sa = (sa0 + sa1) + (sa2 + sa3);
        float y0 = 0.f, y1 = 0.f, y2 = 0.f, y3 = 0.f;
#pragma unroll
        for (int k = 0; k < 64; k += 4) {
#pragma unroll
            for (int e = 0; e < 4; ++e) { S[k + e] = S[k + e] * rl(wc, k + e) + sa * rl(bc, k + e) + vc * rl(kc, k + e); }
            y0 += S[k] * rl(rc, k); y1 += S[k + 1] * rl(rc, k + 1); y2 += S[k + 2] * rl(rc, k + 2); y3 += S[k + 3] * rl(rc, k + 3); }
        LW[oc] = (y0 + y1) + (y2 + y3);
    }
}

__device__ __forceinline__ int crow(int r, int hi) { return (r & 3) + 8 * (r >> 2) + 4 * hi; }
__device__ __forceinline__ unsigned cvtpk(float lo, float hi) { typedef float f2 __attribute__((ext_vector_type(2))); typedef __bf16 b2 __attribute__((ext_vector_type(2))); f2 v = {lo, hi}; b2 b = __builtin_convertvector(v, b2); return __builtin_bit_cast(unsigned, b); }
__device__ __forceinline__ s16x4 vtr(LAS const unsigned char* p) { typedef short v4i16_t __attribute__((ext_vector_type(4))); return __builtin_bit_cast(s16x4, __builtin_amdgcn_ds_read_tr16_b64_v4i16((LAS v4i16_t*)p)); }

__device__ __forceinline__ int swz(int row, int col) { return row * 128 + ((((col >> 3) ^ (row & 7)) << 4) | ((col & 7) << 1)); }
__device__ __forceinline__ int fragA_off(int m, int n) { const int f = (m >> 5) * 4 + (n >> 4), nn = n & 15, hi = (nn >> 2) & 1, j = (nn & 3) + 4 * (nn >> 3); return ((f * 64 + (m & 31) + 32 * hi) * 8 + j) * 2; }
__device__ __forceinline__ int accC_off(int m, int v) { const int mm = m & 31, hi = (mm >> 2) & 1, reg = (mm & 3) + 4 * (mm >> 3); return ((((v >> 5) * 2 + (m >> 5)) * 64 + (v & 31) + 32 * hi) * 16 + reg) * 2; }
__device__ __forceinline__ unsigned char* slot16(unsigned char* arr, int t0, int h, int o) { return arr + (size_t)(t0 + (o >> 7)) * (RW * 2) + h * 128 + (o & 127); }
__device__ __forceinline__ unsigned char* slot32(unsigned char* arr, int t0, int h, int o) { return arr + (size_t)(t0 + (o >> 8)) * (RW * 4) + h * 256 + (o & 255); }

constexpr int PL_LC = 0, PL_X1 = 16384, PL_Y1 = 32768, PL_VT = 49152, PL_KPT = 57344, PL_A2 = 65536, PL_AAB = 81920, PL_RHS = 98304, PL_BTP = 131072, PL_ARB = 0;

constexpr int FL_V6 = 0, FL_TMP = 49152, FL_XW = 53248, FL_XA = 61440, FL_XG = 69632, FL_GATE = 94208;
__device__ __forceinline__ int swzg(int row, int col) { return row * 384 + ((((col >> 3) ^ (row & 7)) << 4) | ((col & 7) << 1)); }
__device__ __forceinline__ int swzv(int row, int col) { return row * 768 + ((((col >> 3) ^ (row & 7)) << 4) | ((col & 7) << 1)); }
__device__ __forceinline__ void unpk8(const u32x4 p, float* o) {
#pragma unroll
    for (int e = 0; e < 4; ++e) { o[2 * e] = __uint_as_float(p[e] << 16); o[2 * e + 1] = __uint_as_float(p[e] & 0xffff0000u); } }
__device__ __forceinline__ void lerp8(const bf16* FR, const float* mu, int row, int col, bool first, float* o) {
    float c[8], p[8]; unpk8(*(const u32x4*)(FR + (size_t)row * FRP + col), c);
    if (first) {
#pragma unroll
        for (int e = 0; e < 8; ++e) p[e] = 0.f; } else unpk8(*(const u32x4*)(FR + (size_t)(row - 1) * FRP + col), p);
    const f32x4 m0 = *(const f32x4*)(mu + col), m1 = *(const f32x4*)(mu + col + 4);
#pragma unroll
    for (int e = 0; e < 8; ++e) o[e] = c[e] + (p[e] - c[e]) * (e < 4 ? m0[e] : m1[e - 4]);
}
__device__ __forceinline__ void phase_rwkv_pre(const Args& a, int layer, LAS unsigned char* lds, int tid, int G) {
    unsigned char* ws = a.ws;
    unsigned char* Rb = ws + RP_R; unsigned char* Kb = ws + RP_K; unsigned char* KKb = ws + RP_KK; unsigned char* BBb = ws + RP_BB; unsigned char* LWb = ws + RP_LW;
    const bf16* FR = (const bf16*)(ws + WS_FR); bf16* FXQ = (bf16*)(ws + WS_FXQ); const float* FF = (const float*)(ws + WS_FF);
    bf16* V = (bf16*)(ws + (layer == 0 ? WS_VF : RP_V)); const bf16* VF = (const bf16*)(ws + WS_VF); bf16* GG = (bf16*)(ws + RP_G);
    const bf16* LORA = (const bf16*)(ws + WS_LORA);
    const float* mu = a.in[7] + layer * 1440;
    LAS float* LC = (LAS float*)(lds + PL_LC); LAS float* AAB = (LAS float*)(lds + PL_AAB); LAS float* RHS = (LAS float*)(lds + PL_RHS);
    for (int item = blockIdx.x; item < BATCH * 256 * NH; item += G) {
        const int h = item % NH, bc = item / NH, t0 = (bc >> 8) * SEQ + (bc & 255) * 64, s0 = (bc & 255) * 64;
        int tid_l = tid; asm volatile("" : "+v"(tid_l));
        const int lane = tid_l & 63, wave = __builtin_amdgcn_readfirstlane(tid_l >> 6), r32 = lane & 31, hi = lane >> 5;
        const int t = tid_l >> 3, kc = tid_l & 7;
        __syncthreads();
        for (int idx = tid_l; idx < 64 * 36; idx += 512) { const int tok = idx / 36, cg = idx % 36; float f[8]; lerp8(FR, mu, t0 + tok, 1152 + cg * 8, s0 + tok == 0, f);
            if (cg < 8) {
#pragma unroll
                for (int e = 0; e < 8; ++e) f[e] = tanhf(f[e]); }
            else if (cg >= 16) {
#pragma unroll
                for (int e = 0; e < 8; ++e) f[e] = sigmoidf_(f[e]); }
            const u32x4 w = (u32x4){cvtpk(f[0], f[1]), cvtpk(f[2], f[3]), cvtpk(f[4], f[5]), cvtpk(f[6], f[7])};
            if (cg < 8) *(LAS u32x4*)(lds + FL_XW + swz(tok, cg * 8)) = w; else if (cg < 16) *(LAS u32x4*)(lds + FL_XA + swz(tok, (cg - 8) * 8)) = w; else *(LAS u32x4*)(lds + FL_XG + swzg(tok, (cg - 16) * 8)) = w; }
        if (layer > 0) {
            for (int idx = tid_l; idx < 64 * 48; idx += 512) { const int tok = idx / 48, cg = idx % 48; float f[8]; lerp8(FR, mu, t0 + tok, 768 + cg * 8, s0 + tok == 0, f);
                *(LAS u32x4*)(lds + FL_V6 + swzv(tok, cg * 8)) = (u32x4){cvtpk(f[0], f[1]), cvtpk(f[2], f[3]), cvtpk(f[4], f[5]), cvtpk(f[6], f[7])}; }
            __syncthreads();
            if (wave < 2) { f32x16 acc;
#pragma unroll
                for (int r = 0; r < 16; ++r) acc[r] = 0.f;
                const bf16* v1t = LORA + 221184 + (size_t)r32 * 384 + 8 * hi;
#pragma unroll 4
                for (int ks = 0; ks < 24; ++ks) { const bf16x8 af = *(const LAS bf16x8*)(lds + FL_V6 + swzv(32 * wave + r32, (2 * ks + hi) * 8)); const bf16x8 bf = *(const bf16x8*)(v1t + 16 * ks);
                    acc = __builtin_amdgcn_mfma_f32_32x32x16_bf16(af, bf, acc, 0, 0, 0); }
#pragma unroll
                for (int r = 0; r < 16; ++r) *(LAS bf16*)(lds + FL_TMP + (32 * wave + crow(r, hi)) * 64 + r32 * 2) = (bf16)f2bf(acc[r]); }
        }
        __syncthreads();
#pragma unroll
        for (int jj = 0; jj < 2; ++jj) { const int mi = 2 * jj + (wave >> 2), rt = (wave >> 1) & 1, ct = wave & 1;
            if (mi == 3 && layer == 0) continue;
            f32x16 acc;
#pragma unroll
            for (int r = 0; r < 16; ++r) acc[r] = 0.f;
            const int nrow = layer * RW + h * HD + 32 * ct + r32;
            if (mi < 2) { const bf16* bp = LORA + (mi == 0 ? 0 : 49152) + (size_t)nrow * 64 + 8 * hi; const int abase = mi == 0 ? FL_XW : FL_XA;
#pragma unroll
                for (int ks = 0; ks < 4; ++ks) acc = __builtin_amdgcn_mfma_f32_32x32x16_bf16(*(const LAS bf16x8*)(lds + abase + swz(32 * rt + r32, (2 * ks + hi) * 8)), *(const bf16x8*)(bp + 16 * ks), acc, 0, 0, 0);
            } else if (mi == 2) { const bf16* bp = LORA + 98304 + (size_t)nrow * 160 + 8 * hi;
#pragma unroll
                for (int ks = 0; ks < 10; ++ks) acc = __builtin_amdgcn_mfma_f32_32x32x16_bf16(*(const LAS bf16x8*)(lds + FL_XG + swzg(32 * rt + r32, (2 * ks + hi) * 8)), *(const bf16x8*)(bp + 16 * ks), acc, 0, 0, 0);
            } else { const bf16* bp = LORA + 233472 + (size_t)(h * HD + 32 * ct + r32) * 32 + 8 * hi;
#pragma unroll
                for (int ks = 0; ks < 2; ++ks) acc = __builtin_amdgcn_mfma_f32_32x32x16_bf16(*(const LAS bf16x8*)(lds + FL_TMP + (32 * rt + r32) * 64 + (2 * ks + hi) * 16), *(const bf16x8*)(bp + 16 * ks), acc, 0, 0, 0); }
            LAS float* outp = (LAS float*)(lds + (mi == 3 ? FL_GATE : mi * 16384));
#pragma unroll
            for (int r = 0; r < 16; ++r) outp[(32 * rt + crow(r, hi)) * 64 + 32 * ct + r32] = acc[r]; }
        __syncthreads();
        float rr[8], kp[8], kn[8], bb[8]; u32x4 v8;
        { const int j0 = h * HD + kc * 8; const bool first = (s0 + t == 0); float kr[8], vv[8];
          lerp8(FR, mu, t0 + t, j0, first, rr); lerp8(FR, mu, t0 + t, RW + j0, first, kr); lerp8(FR, mu, t0 + t, 2 * RW + j0, first, vv);
          const float* w0 = a.in[8] + layer * RW + j0; const float* a0 = a.in[10] + layer * RW + j0; const float* k_k = a.in[16] + layer * RW + j0; const float* k_a = a.in[17] + layer * RW + j0; const float* r_k = a.in[18] + layer * RW + j0;
          const LAS float* o0 = (const LAS float*)(lds) + t * 64 + kc * 8; const LAS float* o1 = (const LAS float*)(lds + 16384) + t * 64 + kc * 8; const LAS float* o2 = (const LAS float*)(lds + 32768) + t * 64 + kc * 8; const LAS float* o3 = (const LAS float*)(lds + FL_GATE) + t * 64 + kc * 8;
          float lwv[8], av[8], gg[8];
#pragma unroll
          for (int e = 0; e < 8; ++e) { lwv[e] = -0.6065306597126334f * sigmoidf_(w0[e] + o0[e]); av[e] = sigmoidf_(a0[e] + o1[e]); gg[e] = o2[e]; }
          if (layer > 0) { float vf[8]; unpk8(*(const u32x4*)(VF + (size_t)(t0 + t) * RW + j0), vf); const float* v0 = a.in[13] + j0;
#pragma unroll
              for (int e = 0; e < 8; ++e) vv[e] = vv[e] + (vf[e] - vv[e]) * sigmoidf_(v0[e] + o3[e]); }
          float ss = 0.f, bs = 0.f;
#pragma unroll
          for (int e = 0; e < 8; ++e) { kn[e] = kr[e] * k_k[e]; ss += kn[e] * kn[e]; kp[e] = kr[e] * (1.0f + (av[e] - 1.0f) * k_a[e]); bs += rr[e] * kp[e] * r_k[e]; }
          ss += __shfl_xor(ss, 1); ss += __shfl_xor(ss, 2); ss += __shfl_xor(ss, 4); bs += __shfl_xor(bs, 1); bs += __shfl_xor(bs, 2); bs += __shfl_xor(bs, 4);
          const float inv = 1.0f / fmaxf(sqrtf(ss), 1e-12f);
#pragma unroll
          for (int e = 0; e < 8; ++e) { kn[e] *= inv; bb[e] = kn[e] * av[e]; }
          if (kc == 0) ((float*)(ws + WS_BONUS))[(size_t)(t0 + t) * NH + h] = bs;
          v8 = (u32x4){cvtpk(vv[0], vv[1]), cvtpk(vv[2], vv[3]), cvtpk(vv[4], vv[5]), cvtpk(vv[6], vv[7])};
          *(u32x4*)(V + (size_t)(t0 + t) * RW + j0) = v8;
          *(u32x4*)(GG + (size_t)(t0 + t) * RW + j0) = (u32x4){cvtpk(gg[0], gg[1]), cvtpk(gg[2], gg[3]), cvtpk(gg[4], gg[5]), cvtpk(gg[6], gg[7])};
          *(LAS f32x4*)(LC + t * 64 + kc * 8) = (f32x4){lwv[0], lwv[1], lwv[2], lwv[3]}; *(LAS f32x4*)(LC + t * 64 + kc * 8 + 4) = (f32x4){lwv[4], lwv[5], lwv[6], lwv[7]};
        }
        { const float* q_g = a.in[21] + layer * HD; const float* k_g = a.in[22] + layer * HD;
          for (int cmb = wave; cmb < 128; cmb += 8) { const int tok = cmb >> 1, which = cmb & 1;
              bf16* p = FXQ + (size_t)(t0 + tok) * FXP + which * RW + h * HD + lane; const float v = bf2f(*p);
              const float rs = rsqrtf(wave_sum(v * v) * (1.f / HD) + RMS_EPS);
              *p = (bf16)f2bf(which == 0 ? v * rs * q_g[lane] * QSCALE : v * rs * k_g[lane]); }
          if (tid_l < 64) { const float x = FF[(size_t)(t0 + tid_l) * 8 + h] + a.in[23][layer * NH + h];
              ((float*)(ws + WS_LF))[(size_t)((bc >> 8) * NH + h) * SEQ + s0 + tid_l] = fminf(x, 0.f) - log1pf(__expf(-fabsf(x))); } }
        __syncthreads();
        if (tid < 64) { float run = 0.f;
#pragma unroll 8
            for (int tt = 0; tt < 64; ++tt) { run += LC[tt * 64 + tid]; LC[tt * 64 + tid] = run; } }
        __syncthreads();
        {
            float at[8], bt[8], kt[8], rt[8], btp[8], ktp[8];
#pragma unroll
            for (int e = 0; e < 8; ++e) { const int k = kc * 8 + e; const float lc = LC[t * 64 + k], lp = t ? LC[(t - 1) * 64 + k] : 0.f, le = LC[63 * 64 + k];
                at[e] = -kn[e] * __expf(lp); const float en = __expf(-lc); bt[e] = bb[e] * en; kt[e] = kp[e] * en; rt[e] = rr[e] * __expf(lc); const float ee = __expf(le - lc); btp[e] = bb[e] * ee; ktp[e] = kp[e] * ee;
                if (t == 63) ((float*)(ws + WS_PC))[(size_t)item * 64 + k] = __expf(le); }
            u32x4 w;
            w.x = cvtpk(at[0], at[1]); w.y = cvtpk(at[2], at[3]); w.z = cvtpk(at[4], at[5]); w.w = cvtpk(at[6], at[7]); *(LAS u32x4*)(lds + PL_X1 + swz(t, kc * 8)) = w;
            const u32x4 wr_ = (u32x4){cvtpk(rt[0], rt[1]), cvtpk(rt[2], rt[3]), cvtpk(rt[4], rt[5]), cvtpk(rt[6], rt[7])}; *(LAS u32x4*)(lds + PL_X1 + swz(64 + t, kc * 8)) = wr_;
            w.x = cvtpk(bt[0], bt[1]); w.y = cvtpk(bt[2], bt[3]); w.z = cvtpk(bt[4], bt[5]); w.w = cvtpk(bt[6], bt[7]); *(LAS u32x4*)(lds + PL_Y1 + swz(t, kc * 8)) = w;
            w.x = cvtpk(kt[0], kt[1]); w.y = cvtpk(kt[2], kt[3]); w.z = cvtpk(kt[4], kt[5]); w.w = cvtpk(kt[6], kt[7]); *(LAS u32x4*)(lds + PL_Y1 + swz(64 + t, kc * 8)) = w;
            *(LAS f32x4*)(RHS + t * 128 + kc * 8) = (f32x4){at[0], at[1], at[2], at[3]}; *(LAS f32x4*)(RHS + t * 128 + kc * 8 + 4) = (f32x4){at[4], at[5], at[6], at[7]};
#pragma unroll
            for (int e = 0; e < 8; ++e) { const int k = kc * 8 + e;
                *(LAS bf16*)(lds + PL_VT + swz(k, t)) = (bf16)((e & 1) ? (v8[e >> 1] >> 16) : (v8[e >> 1] & 0xffffu));
                *(LAS bf16*)(lds + PL_KPT + swz(k, t)) = (bf16)f2bf(ktp[e]);
                *(LAS bf16*)(lds + PL_BTP + k * 128 + t * 2) = (bf16)f2bf(btp[e]); }
            { const int o0 = fragA_off(t, kc * 8), o1 = fragA_off(t, kc * 8 + 4);
              *(u32x2*)slot16(KKb, t0, h, o0) = (u32x2){wr_.x, wr_.y}; *(u32x2*)slot16(KKb, t0, h, o1) = (u32x2){wr_.z, wr_.w}; }
        }
        __syncthreads();
        {
            const int rt4 = wave >> 1;
#pragma unroll
            for (int cc = 0; cc < 2; ++cc) { const int ct = 2 * (wave & 1) + cc;
                f32x16 acc;
#pragma unroll
                for (int r = 0; r < 16; ++r) acc[r] = 0.f;
#pragma unroll
                for (int ks = 0; ks < 4; ++ks) { const bf16x8 af = *(const LAS bf16x8*)(lds + PL_X1 + swz(32 * rt4 + r32, (2 * ks + hi) * 8)); const bf16x8 bf = *(const LAS bf16x8*)(lds + PL_Y1 + swz(32 * ct + r32, (2 * ks + hi) * 8));
                    acc = __builtin_amdgcn_mfma_f32_32x32x16_bf16(af, bf, acc, 0, 0, 0); }
                const int i = 32 * (ct & 1) + r32;
#pragma unroll
                for (int r = 0; r < 16; ++r) { const int tt = 32 * (rt4 & 1) + crow(r, hi);
                    if (rt4 < 2) { const float v = (i < tt) ? acc[r] : 0.f; if (ct < 2) AAB[tt * 64 + i] = v; else *(LAS bf16*)(lds + PL_A2 + swz(tt, i)) = (bf16)f2bf(v); }
                    else { const float v = (i <= tt) ? acc[r] : 0.f; if (ct < 2) *(LAS bf16*)(lds + PL_ARB + tt * 128 + i * 2) = (bf16)f2bf(v); else *(LAS bf16*)(lds + PL_A2 + swz(64 + tt, i)) = (bf16)f2bf(v); } }
            }
        }
        __syncthreads();
        {
            const int rt4 = wave >> 1, ct = wave & 1;
            f32x16 acc;
#pragma unroll
            for (int r = 0; r < 16; ++r) acc[r] = 0.f;
#pragma unroll
            for (int is = 0; is < 4; ++is) { const bf16x8 af = *(const LAS bf16x8*)(lds + PL_A2 + swz(32 * rt4 + r32, (2 * is + hi) * 8)); const bf16x8 bf = *(const LAS bf16x8*)(lds + PL_VT + swz(32 * ct + r32, (2 * is + hi) * 8));
                acc = __builtin_amdgcn_mfma_f32_32x32x16_bf16(af, bf, acc, 0, 0, 0); }
            if (rt4 < 2) {
#pragma unroll
                for (int r = 0; r < 16; ++r) RHS[(32 * rt4 + crow(r, hi)) * 128 + 64 + 32 * ct + r32] = acc[r];
            } else { u32x4 w0, w1; w0.x = cvtpk(acc[0], acc[1]); w0.y = cvtpk(acc[2], acc[3]); w0.z = cvtpk(acc[4], acc[5]); w0.w = cvtpk(acc[6], acc[7]); w1.x = cvtpk(acc[8], acc[9]); w1.y = cvtpk(acc[10], acc[11]); w1.z = cvtpk(acc[12], acc[13]); w1.w = cvtpk(acc[14], acc[15]);
                unsigned char* y0 = ws + WS_Y0 + (size_t)item * 8192 + ((ct * 2 + (rt4 - 2)) * 64 + lane) * 32; *(u32x4*)y0 = w0; *(u32x4*)(y0 + 16) = w1; }
            if (wave < 4) { const int kt2 = wave >> 1, vh = wave & 1;
#pragma unroll
                for (int r = 0; r < 16; ++r) acc[r] = 0.f;
#pragma unroll
                for (int ts = 0; ts < 4; ++ts) { const bf16x8 af = *(const LAS bf16x8*)(lds + PL_KPT + swz(32 * kt2 + r32, (2 * ts + hi) * 8)); const bf16x8 bf = *(const LAS bf16x8*)(lds + PL_VT + swz(32 * vh + r32, (2 * ts + hi) * 8));
                    acc = __builtin_amdgcn_mfma_f32_32x32x16_bf16(af, bf, acc, 0, 0, 0); }
                u32x4 w0, w1; w0.x = cvtpk(acc[0], acc[1]); w0.y = cvtpk(acc[2], acc[3]); w0.z = cvtpk(acc[4], acc[5]); w0.w = cvtpk(acc[6], acc[7]); w1.x = cvtpk(acc[8], acc[9]); w1.y = cvtpk(acc[10], acc[11]); w1.z = cvtpk(acc[12], acc[13]); w1.w = cvtpk(acc[14], acc[15]);
                const int o = 8192 + ((vh * 2 + kt2) * 64 + lane) * 32; *(u32x4*)slot32(LWb, t0, h, o) = w0; *(u32x4*)slot32(LWb, t0, h, o + 16) = w1; }
        }
        __syncthreads();
        if (tid < 128) { const int c = tid; float x[64];
            LAS float* AABp = AAB; asm volatile("" : "+v"(AABp));
            LAS float* RHSc = RHS + c; asm volatile("" : "+v"(RHSc));
#pragma unroll
            for (int tt = 0; tt < 64; ++tt) { float s = RHSc[tt * 128];
#pragma unroll
                for (int i4 = 0; i4 < (tt + 3) / 4; ++i4) { const f32x4 av = *(const LAS f32x4*)(AABp + tt * 64 + i4 * 4);
                    s += av[0] * x[i4 * 4]; if (i4 * 4 + 1 < tt) s += av[1] * x[i4 * 4 + 1]; if (i4 * 4 + 2 < tt) s += av[2] * x[i4 * 4 + 2]; if (i4 * 4 + 3 < tt) s += av[3] * x[i4 * 4 + 3]; }
                x[tt] = s; RHSc[tt * 128] = s; }
        }
        __syncthreads();
        { const int f = tid_l >> 6, l2 = tid_l & 63, m = 32 * (f >> 2) + (l2 & 31), n0 = 16 * (f & 3) + 4 * (l2 >> 5);
          u32x4 w; w.x = cvtpk(RHS[m * 128 + n0], RHS[m * 128 + n0 + 1]); w.y = cvtpk(RHS[m * 128 + n0 + 2], RHS[m * 128 + n0 + 3]); w.z = cvtpk(RHS[m * 128 + n0 + 8], RHS[m * 128 + n0 + 9]); w.w = cvtpk(RHS[m * 128 + n0 + 10], RHS[m * 128 + n0 + 11]);
          *(u32x4*)slot16(Rb, t0, h, tid_l * 16) = w;
          const u32x2 b0 = *(const LAS u32x2*)(lds + PL_BTP + m * 128 + n0 * 2), b1 = *(const LAS u32x2*)(lds + PL_BTP + m * 128 + (n0 + 8) * 2);
          *(u32x4*)slot16(Kb, t0, h, tid_l * 16) = (u32x4){b0.x, b0.y, b1.x, b1.y};
          const u32x2 a0 = *(const LAS u32x2*)(lds + PL_ARB + m * 128 + n0 * 2), a1 = *(const LAS u32x2*)(lds + PL_ARB + m * 128 + (n0 + 8) * 2);
          *(u32x4*)slot16(BBb, t0, h, tid_l * 16) = (u32x4){a0.x, a0.y, a1.x, a1.y};
          const int half = tid_l & 1, l3 = (tid_l >> 1) & 63, tl = tid_l >> 7, mt = tl & 1, vh = tl >> 1, v = 64 + 32 * vh + (l3 & 31), rb = 32 * mt + 16 * half + 4 * (l3 >> 5);
          w.x = cvtpk(RHS[rb * 128 + v], RHS[(rb + 1) * 128 + v]); w.y = cvtpk(RHS[(rb + 2) * 128 + v], RHS[(rb + 3) * 128 + v]); w.z = cvtpk(RHS[(rb + 8) * 128 + v], RHS[(rb + 9) * 128 + v]); w.w = cvtpk(RHS[(rb + 10) * 128 + v], RHS[(rb + 11) * 128 + v]);
          *(u32x4*)slot32(LWb, t0, h, tid_l * 16) = w; }
    }
}

__device__ __forceinline__ bf16x8 pack8(const f32x16& x, int s) { u32x4 w; w.x = cvtpk(x[8 * s], x[8 * s + 1]); w.y = cvtpk(x[8 * s + 2], x[8 * s + 3]); w.z = cvtpk(x[8 * s + 4], x[8 * s + 5]); w.w = cvtpk(x[8 * s + 6], x[8 * s + 7]); return __builtin_bit_cast(bf16x8, w); }
__device__ __forceinline__ f32x16 unpack16(const u32x4 a, const u32x4 b) { f32x16 o;
#pragma unroll
    for (int e = 0; e < 4; ++e) { o[2 * e] = __uint_as_float(a[e] << 16); o[2 * e + 1] = __uint_as_float(a[e] & 0xffff0000u); o[8 + 2 * e] = __uint_as_float(b[e] << 16); o[8 + 2 * e + 1] = __uint_as_float(b[e] & 0xffff0000u); }
    return o; }
__device__ __forceinline__ const unsigned char* cd_group(unsigned char* ws, int b, int h, int c, int g, int off16, int off32, int offl) {
    const int seg = g >> 3, gi = g & 7, t0 = b * SEQ + c * 64; const size_t item = (size_t)(b * 256 + c) * NH + h;
    if (seg < 4) return ws + (seg == 0 ? RP_R : seg == 1 ? RP_K : seg == 2 ? RP_KK : RP_BB) + (size_t)(t0 + gi * 8) * (RW * 2) + h * 128 + off16;
    if (seg < 6) return ws + RP_LW + (size_t)(t0 + (seg - 4) * 32 + gi * 4) * (RW * 4) + h * 256 + off32;
    if (seg == 6) return ws + WS_Y0 + item * 8192 + gi * 1024 + offl;
    return ws + WS_PC + item * 256 + (offl & 255);
}
constexpr int CD_BYTES = 58368, CD_GROUPS = 57;
__device__ __forceinline__ void rwkv_scan_chunked(const Args& a, int layer, int bh, LAS unsigned char* lds, int tid) {
    unsigned char* ws = a.ws; const int b = bh / NH, h = bh % NH, lane = tid & 63, wave = __builtin_amdgcn_readfirstlane(tid >> 6), r32 = lane & 31, hi = lane >> 5, vh = wave;
    bf16* YB = (bf16*)(ws + WS_YB);
    const int lw = wave - 2;
    const int off16 = (lane >> 3) * (RW * 2) + (lane & 7) * 16, off32 = (lane >> 4) * (RW * 4) + (lane & 15) * 16, offl = lane * 16;
    u32x4 stg[10];
    f32x16 sT[2];
#pragma unroll
    for (int r = 0; r < 16; ++r) { sT[0][r] = 0.f; sT[1][r] = 0.f; }
    __syncthreads();
    if (wave >= 2) {
#pragma unroll
        for (int k = 0; k < 10; ++k) { const int g = lw + 6 * k; if (g < CD_GROUPS) stg[k] = *(const u32x4*)cd_group(ws, b, h, 0, g, off16, off32, offl); }
#pragma unroll
        for (int k = 0; k < 10; ++k) { const int g = lw + 6 * k; if (g < CD_GROUPS) *(LAS u32x4*)(lds + g * 1024 + lane * 16) = stg[k]; }
#pragma unroll
        for (int k = 0; k < 10; ++k) { const int g = lw + 6 * k; if (g < CD_GROUPS) stg[k] = *(const u32x4*)cd_group(ws, b, h, 1, g, off16, off32, offl); }
    }
    __syncthreads();
    for (int c = 0; c < 256; ++c) {
        if (wave >= 2) {
            if (c + 1 < 256) { LAS unsigned char* dst = lds + ((c + 1) & 1) * CD_BYTES;
#pragma unroll
                for (int k = 0; k < 10; ++k) { const int g = lw + 6 * k; if (g < CD_GROUPS) *(LAS u32x4*)(dst + g * 1024 + lane * 16) = stg[k]; } }
            if (c + 2 < 256) { int c2 = c + 2; asm volatile("" : "+s"(c2));
#pragma unroll
                for (int k = 0; k < 10; ++k) { const int g = lw + 6 * k; if (g < CD_GROUPS) stg[k] = *(const u32x4*)cd_group(ws, b, h, c2, g, off16, off32, offl); } }
        } else {
            LAS const unsigned char* buf = lds + (c & 1) * CD_BYTES; const int t0 = b * SEQ + c * 64;
#define FRAG(seg, f) (*(const LAS bf16x8*)(buf + (seg) * 8192 + ((f) * 64 + lane) * 16))
#define CTILE(seg, tile) unpack16(*(const LAS u32x4*)(buf + (seg) * 8192 + ((vh * 2 + (tile)) * 64 + lane) * 32), *(const LAS u32x4*)(buf + (seg) * 8192 + ((vh * 2 + (tile)) * 64 + lane) * 32 + 16))
            bf16x8 s0f[4];
#pragma unroll
            for (int ks = 0; ks < 4; ++ks) s0f[ks] = pack8(sT[ks >> 1], ks & 1);
            f32x16 u[2], y[2];
#pragma unroll
            for (int ti = 0; ti < 2; ++ti) { u[ti] = CTILE(4, ti); y[ti] = CTILE(6, ti);
#pragma unroll
                for (int ks = 0; ks < 4; ++ks) { u[ti] = __builtin_amdgcn_mfma_f32_32x32x16_bf16(FRAG(0, ti * 4 + ks), s0f[ks], u[ti], 0, 0, 0); y[ti] = __builtin_amdgcn_mfma_f32_32x32x16_bf16(FRAG(2, ti * 4 + ks), s0f[ks], y[ti], 0, 0, 0); } }
            bf16x8 uf[4];
#pragma unroll
            for (int ts = 0; ts < 4; ++ts) uf[ts] = pack8(u[ts >> 1], ts & 1);
#pragma unroll
            for (int ki = 0; ki < 2; ++ki) { const f32x16 kv = CTILE(5, ki);
#pragma unroll
                for (int g = 0; g < 4; ++g) { const f32x4 p4 = *(const LAS f32x4*)(buf + 57344 + (32 * ki + 8 * g + 4 * hi) * 4);
#pragma unroll
                    for (int e = 0; e < 4; ++e) sT[ki][4 * g + e] = sT[ki][4 * g + e] * p4[e] + kv[4 * g + e]; }
#pragma unroll
                for (int ts = 0; ts < 4; ++ts) sT[ki] = __builtin_amdgcn_mfma_f32_32x32x16_bf16(FRAG(1, ki * 4 + ts), uf[ts], sT[ki], 0, 0, 0); }
#pragma unroll
            for (int ti = 0; ti < 2; ++ti) {
#pragma unroll
                for (int ts = 0; ts < 4; ++ts) y[ti] = __builtin_amdgcn_mfma_f32_32x32x16_bf16(FRAG(3, ti * 4 + ts), uf[ts], y[ti], 0, 0, 0);
#pragma unroll
                for (int r = 0; r < 16; ++r) YB[(size_t)(t0 + 32 * ti + crow(r, hi)) * RW + h * HD + vh * 32 + r32] = (bf16)f2bf(y[ti][r]); }
#undef FRAG
#undef CTILE
        }
        __syncthreads();
    }
}

__device__ __forceinline__ void attn_unit(const Args& a, int b, int h, int qb, float lim, LAS unsigned char* lds, int tid) {
    unsigned char* ws = a.ws;
    const bf16* FXQ = (const bf16*)(ws + WS_FXQ); const float* CUM = (const float*)(ws + WS_CUM) + (size_t)(b * NH + h) * SEQ; bf16* MIX = (bf16*)(ws + WS_MIX);
    const int lane = tid & 63, wid = tid >> 6, r32 = lane & 31, hi = lane >> 5;
    const size_t rowbase = (size_t)b * SEQ; const int q0 = qb * 256, qrow = q0 + wid * 32 + r32;
    bf16x8 qf[4];
    { const bf16* qp = FXQ + (rowbase + qrow) * FXP + h * HD + hi * 8;
#pragma unroll
      for (int ks = 0; ks < 4; ++ks) qf[ks] = *(const bf16x8*)(qp + ks * 16); }
    f32x16 o0, o1;
#pragma unroll
    for (int r = 0; r < 16; ++r) { o0[r] = 0.f; o1[r] = 0.f; }
    float m = -INFINITY, l = 0.f;
    const int NT = (q0 + 256) / 64; const float cref = CUM[q0];
    LAS float* ckf = (LAS float*)(lds + 16384);
    const int jlo = __syncthreads_count((tid < 4 * qb) && (cref - CUM[tid * 64 + 63] < -lim));
    for (int kt = jlo; kt < NT; ++kt) {
        __syncthreads();
        { const int key = tid >> 3, ch = tid & 7; const size_t grow = rowbase + (size_t)kt * 64 + key;
          const u32x4 kv = *(const u32x4*)(FXQ + grow * FXP + RW + h * HD + ch * 8);
          const u32x4 vv = *(const u32x4*)(FXQ + grow * FXP + 2 * RW + h * HD + ch * 8);
          *(LAS u32x4*)(lds + key * 128 + ((ch ^ (key & 7)) * 16)) = kv;
          *(LAS u32x4*)(lds + 8192 + key * 128 + ch * 16) = vv;
          if (tid < 64) ckf[tid] = (CUM[kt * 64 + tid] - cref) * LOG2E; }
        __syncthreads();
        if (kt * 64 > q0 + wid * 32 + 31) continue;
        f32x16 s0, s1;
#pragma unroll
        for (int r = 0; r < 16; ++r) { s0[r] = 0.f; s1[r] = 0.f; }
#pragma unroll
        for (int ks = 0; ks < 4; ++ks) { const int co = ((2 * ks + hi) ^ (r32 & 7)) * 16;
            const bf16x8 a0 = *(const LAS bf16x8*)(lds + r32 * 128 + co); const bf16x8 a1 = *(const LAS bf16x8*)(lds + (32 + r32) * 128 + co);
            s0 = __builtin_amdgcn_mfma_f32_32x32x16_bf16(a0, qf[ks], s0, 0, 0, 0); s1 = __builtin_amdgcn_mfma_f32_32x32x16_bf16(a1, qf[ks], s1, 0, 0, 0); }
        const bool diag = (kt * 64 + 63 > q0 + wid * 32);
        float mx = -INFINITY;
#pragma unroll
        for (int r = 0; r < 16; ++r) { const int k0 = crow(r, hi); float v0 = s0[r] - ckf[k0], v1 = s1[r] - ckf[32 + k0];
            if (diag) { if (kt * 64 + k0 > qrow) v0 = -INFINITY; if (kt * 64 + 32 + k0 > qrow) v1 = -INFINITY; }
            s0[r] = v0; s1[r] = v1; mx = fmaxf(mx, fmaxf(v0, v1)); }
        mx = fmaxf(mx, __shfl_xor(mx, 32));
        const float mnew = fmaxf(m, mx), alpha = exp2f(m - mnew); m = mnew;
        float ps = 0.f;
#pragma unroll
        for (int r = 0; r < 16; ++r) { s0[r] = exp2f(s0[r] - m); s1[r] = exp2f(s1[r] - m); ps += s0[r] + s1[r]; }
        l = l * alpha + ps;
#pragma unroll
        for (int r = 0; r < 16; ++r) { o0[r] *= alpha; o1[r] *= alpha; }
        bf16x8 pf[4];
#pragma unroll
        for (int s = 0; s < 2; ++s) { u32x4 w0, w1;
            w0.x = cvtpk(s0[8 * s], s0[8 * s + 1]); w0.y = cvtpk(s0[8 * s + 2], s0[8 * s + 3]); w0.z = cvtpk(s0[8 * s + 4], s0[8 * s + 5]); w0.w = cvtpk(s0[8 * s + 6], s0[8 * s + 7]);
            w1.x = cvtpk(s1[8 * s], s1[8 * s + 1]); w1.y = cvtpk(s1[8 * s + 2], s1[8 * s + 3]); w1.z = cvtpk(s1[8 * s + 4], s1[8 * s + 5]); w1.w = cvtpk(s1[8 * s + 6], s1[8 * s + 7]);
            pf[s] = __builtin_bit_cast(bf16x8, w0); pf[2 + s] = __builtin_bit_cast(bf16x8, w1); }
        const int q4 = (lane & 15) >> 2, p4 = lane & 3;
        LAS const unsigned char* vb = lds + 8192 + (4 * hi + q4) * 128 + (16 * ((lane >> 4) & 1) + 4 * p4) * 2;
#pragma unroll
        for (int s = 0; s < 4; ++s) {
#pragma unroll
            for (int db = 0; db < 2; ++db) { const s16x4 lo = vtr(vb + s * 16 * 128 + db * 64), hh = vtr(vb + s * 16 * 128 + 8 * 128 + db * 64);
                const bf16x8 vf = (bf16x8){lo[0], lo[1], lo[2], lo[3], hh[0], hh[1], hh[2], hh[3]};
                if (db == 0) o0 = __builtin_amdgcn_mfma_f32_32x32x16_bf16(vf, pf[s], o0, 0, 0, 0); else o1 = __builtin_amdgcn_mfma_f32_32x32x16_bf16(vf, pf[s], o1, 0, 0, 0); } }
    }
    l += __shfl_xor(l, 32);
    const float inv = 1.0f / l;
    const bf16* gp = FXQ + (rowbase + qrow) * FXP + 3 * RW + h * HD; bf16* op = MIX + (rowbase + qrow) * DM + RW + h * HD;
#pragma unroll
    for (int db = 0; db < 2; ++db)
#pragma unroll
        for (int g = 0; g < 4; ++g) { const int d = 32 * db + 8 * g + 4 * hi; const u32x2 gv = *(const u32x2*)(gp + d);
            const float g0 = sigmoidf_(__uint_as_float(gv.x << 16)), g1 = sigmoidf_(__uint_as_float(gv.x & 0xffff0000u)), g2 = sigmoidf_(__uint_as_float(gv.y << 16)), g3 = sigmoidf_(__uint_as_float(gv.y & 0xffff0000u));
            const float x0 = (db == 0 ? o0[4 * g] : o1[4 * g]) * inv * g0, x1 = (db == 0 ? o0[4 * g + 1] : o1[4 * g + 1]) * inv * g1, x2 = (db == 0 ? o0[4 * g + 2] : o1[4 * g + 2]) * inv * g2, x3 = (db == 0 ? o0[4 * g + 3] : o1[4 * g + 3]) * inv * g3;
            u32x2 w; w.x = cvtpk(x0, x1); w.y = cvtpk(x2, x3); *(u32x2*)(op + d) = w; }
}

__device__ __forceinline__ void phase_pool(const Args& a, int layer, int gw, int NGW, int lane) {
    unsigned char* ws = a.ws; const bf16* PL = (const bf16*)(ws + WS_PL); bf16* MIX = (bf16*)(ws + WS_MIX);
    const float* pw = a.in[24] + (size_t)layer * 4 * 64 * 64; const float* psc = a.in[25] + layer * 256;
    for (int it = gw; it < TT * 4; it += NGW) { const int tok = it >> 2, g = it & 3, win = 2 << g, s = tok % SEQ, n = (s + 1 < win) ? s + 1 : win;
        float sum = 0.f, cur = 0.f;
        for (int i = 0; i < n; ++i) { const float v = bf2f(PL[(size_t)(tok - i) * PLP + g * 64 + lane]); if (i == 0) cur = v; sum += v; }
        const float u = sum / (float)n - cur; const float* wg = pw + g * 4096 + lane; float y = 0.f;
#pragma unroll
        for (int c = 0; c < 64; ++c) y += rl(u, c) * wg[c * 64];
        MIX[(size_t)tok * DM + 768 + g * 64 + lane] = (bf16)f2bf(y * psc[g * 64 + lane]); }
}

__device__ __forceinline__ void phase_rwkv_out(const Args& a, int layer, int gw, int NGW, int lane) {
    unsigned char* ws = a.ws;
    const bf16* V = (const bf16*)(ws + (layer == 0 ? WS_VF : RP_V)); const bf16* YB = (const bf16*)(ws + WS_YB); const float* BONUS = (const float*)(ws + WS_BONUS);
    const bf16* GG = (const bf16*)(ws + RP_G); bf16* MIX = (bf16*)(ws + WS_MIX);
    const float* ln_w = a.in[19] + layer * RW; const float* ln_b = a.in[20] + layer * RW;
    for (int it = gw; it < TT * NH; it += NGW) { const int tok = it / NH, h = it % NH, c = h * HD + lane; const size_t o = (size_t)tok * RW + c;
        const float y = bf2f(YB[o]); const float mean = wave_sum(y) * (1.f / HD); const float d = y - mean; const float var = wave_sum(d * d) * (1.f / HD);
        const float yn = d * rsqrtf(var + GN_EPS) * ln_w[c] + ln_b[c];
        const float bonus = BONUS[it] * bf2f(V[o]);
        MIX[(size_t)tok * DM + c] = (bf16)f2bf((yn + bonus) * bf2f(GG[o])); }
}

__device__ __forceinline__ void phase_resnorm(const float* tmp, const float* xin, float* xout, const float* g1, const float* g2, bf16* hn, int gw, int NGW, int lane) {
    for (int m = gw; m < TT; m += NGW) {
        const f32x4* tr = (const f32x4*)(tmp + (size_t)m * DM) + lane; const f32x4* xr = (const f32x4*)(xin + (size_t)m * DM) + lane; f32x4* xo = (f32x4*)(xout + (size_t)m * DM) + lane;
        f32x4 v[4]; float s = 0.f;
#pragma unroll
        for (int j = 0; j < 4; ++j) { v[j] = tr[64 * j]; s += (v[j].x * v[j].x + v[j].y * v[j].y) + (v[j].z * v[j].z + v[j].w * v[j].w); }
        const float rs = rsqrtf(wave_sum(s) * (1.f / DM) + RMS_EPS); float s2 = 0.f;
#pragma unroll
        for (int j = 0; j < 4; ++j) { const f32x4 gg = ((const f32x4*)g1 + lane)[64 * j]; v[j] = xr[64 * j] + v[j] * rs * gg; xo[64 * j] = v[j];
            s2 += (v[j].x * v[j].x + v[j].y * v[j].y) + (v[j].z * v[j].z + v[j].w * v[j].w); }
        if (g2) { const float rs2 = rsqrtf(wave_sum(s2) * (1.f / DM) + RMS_EPS); unsigned long long* o8 = (unsigned long long*)(hn + (size_t)m * DM) + lane;
#pragma unroll
            for (int j = 0; j < 4; ++j) { const f32x4 gg = ((const f32x4*)g2 + lane)[64 * j];
                o8[64 * j] = (unsigned long long)pk2(v[j].x * rs2 * gg.x, v[j].y * rs2 * gg.y) | ((unsigned long long)pk2(v[j].z * rs2 * gg.z, v[j].w * rs2 * gg.w) << 32); } }
    }
}

constexpr int NPHASE = 1 + 10 * DEPTH;
__global__ void __launch_bounds__(512, 2) mega(Args a_unused) {
    extern __shared__ __attribute__((aligned(16))) unsigned char lds_raw[];
    int lo, hi; { const Args a0 = get_args(); lo = a0.lo; hi = a0.hi; }
    for (int ph = lo; ph < hi; ++ph) {
        const Args a = get_args(); unsigned char* ws = a.ws;
        int tid = threadIdx.x; asm volatile("" : "+v"(tid));
        int bid = blockIdx.x, G = gridDim.x; asm volatile("" : "+s"(bid), "+s"(G));
        LAS unsigned char* lds = (LAS unsigned char*)lds_raw; asm volatile("" : "+s"(lds));
        const int lane = tid & 63, wave = __builtin_amdgcn_readfirstlane(tid >> 6), gw = bid * 8 + wave, NGW = G * 8;
        if (ph > lo) {
#if MK_SINGLE
            cg::this_grid().sync();
#endif
        }
        if (ph == 0) { phase_prologue(a, lds, tid, G); continue; }
        const int layer = (ph - 1) / 10, sub = (ph - 1) % 10;
        const float* xin = layer == 0 ? a.in[0] : a.out;
        switch (sub) {
        case 0: { pg8::Gemm g{(const bf16*)(ws + WS_HN), (const bf16*)(ws + WS_WIN) + layer * WIN_L, TT, NIN, DM}; pg8::StaticOrder S; S.init(TT, NIN, G, bid);
                  pg8::EpiInProj E{(bf16*)(ws + WS_FR), (bf16*)(ws + WS_FXQ), (bf16*)(ws + WS_PL), (float*)(ws + WS_FF)};
                  pg8::gemm_phase<pg8::EpiInProj, pg8::StaticOrder, true, true>(lds, g, S, E); } break;
        case 1: phase_rwkv_pre(a, layer, lds, tid, G); break;
        case 2: phase_cumsum(a, lds, tid, G); break;
        case 3: {
            if (bid < BATCH * NH) { rwkv_scan_chunked(a, layer, bid, lds, tid); }
            else { const int nb = G - BATCH * NH, bi = bid - BATCH * NH;
                float gq = fabsf(a.in[21][layer * HD + lane]), gk = fabsf(a.in[22][layer * HD + lane]);
#pragma unroll
                for (int o = 1; o < 64; o <<= 1) { gq = fmaxf(gq, __shfl_xor(gq, o)); gk = fmaxf(gk, __shfl_xor(gk, o)); }
                const float lim = 30.0f + 2.0f * 8.0f * 1.02f * gq * gk;
                unsigned* ticket = (unsigned*)(ws + WS_CTL) + 64 + layer * 64; LAS int* tk = (LAS int*)(lds + 20480);
                for (;;) { __syncthreads(); if (tid == 0) *tk = (int)atomicAdd(ticket, 1u); __syncthreads(); const int u = *tk; if (u >= BATCH * NH * 64) break;
                    const int qb = 63 - u / (BATCH * NH), bh = u % (BATCH * NH); attn_unit(a, bh / NH, bh % NH, qb, lim, lds, tid); }
                phase_pool(a, layer, bi * 8 + wave, nb * 8, lane); }
        } break;
        case 4: phase_rwkv_out(a, layer, gw, NGW, lane); break;
        case 5: { pg8::Gemm g{(const bf16*)(ws + WS_MIX), (const bf16*)(ws + WS_WOUT) + layer * WOUT_L, TT, DM, DM}; pg8::StaticOrder S; S.init(TT, DM, G, bid);
                  pg8::EpiF32 E{(float*)(ws + WS_TMP), DM};
                  pg8::gemm_phase<pg8::EpiF32, pg8::StaticOrder, true, true>(lds, g, S, E); } break;
        case 6: phase_resnorm((const float*)(ws + WS_TMP), xin, a.out, a.in[2] + layer * DM, a.in[3] + layer * DM, (bf16*)(ws + WS_HN), gw, NGW, lane); break;
        case 7: { pg8::Gemm g{(const bf16*)(ws + WS_HN), (const bf16*)(ws + WS_WGU) + layer * WGU_L, TT, 2 * FFH, DM}; pg8::StaticOrder S; S.init(TT, 2 * FFH, G, bid);
                  pg8::EpiSwiglu E{(bf16*)(ws + WS_H)};
                  pg8::gemm_phase<pg8::EpiSwiglu, pg8::StaticOrder, true, true>(lds, g, S, E); } break;
        case 8: { pg8::Gemm g{(const bf16*)(ws + WS_H), (const bf16*)(ws + WS_WDN) + layer * WDN_L, TT, DM, FFH}; pg8::StaticOrder S; S.init(TT, DM, G, bid);
                  pg8::EpiF32 E{(float*)(ws + WS_TMP), DM};
                  pg8::gemm_phase<pg8::EpiF32, pg8::StaticOrder, true, true>(lds, g, S, E); } break;
        case 9: phase_resnorm((const float*)(ws + WS_TMP), a.out, a.out, a.in[4] + layer * DM, layer + 1 < DEPTH ? a.in[1] + (layer + 1) * DM : nullptr, (bf16*)(ws + WS_HN), gw, NGW, lane); break;
        }
    }
}

extern "C" void kernel_launch(void* const* d_in, const int* in_sizes, int n_in, void* d_out, int out_size, void* d_ws, size_t ws_size, hipStream_t stream) {
    static int grid = 0;
    if (grid == 0) {
        if (n_in != 28 || out_size != TT * DM || ws_size < WS_END) { fprintf(stderr, "kernel_launch: unexpected shapes (n_in %d out %d ws %zu)\n", n_in, out_size, ws_size); grid = -1; return; }
        int dev = 0, cus = 0, per_cu = 0;
        hipGetDevice(&dev); hipDeviceGetAttribute(&cus, hipDeviceAttributeMultiprocessorCount, dev);
        hipFuncSetAttribute((const void*)mega, hipFuncAttributeMaxDynamicSharedMemorySize, LDS_BYTES);
        hipOccupancyMaxActiveBlocksPerMultiprocessor(&per_cu, (const void*)mega, 512, LDS_BYTES);
        if (per_cu < 1) { fprintf(stderr, "kernel_launch: occupancy query says %d blocks per CU\n", per_cu); per_cu = 1; }
        (void)hipGetLastError();
        grid = cus * 1;
    }
    if (grid < 0) return;
    hipMemsetAsync((char*)d_ws + WS_CTL, 0, CTL_BYTES, stream);
    Args a{};
    for (int i = 0; i < 28; ++i) a.in[i] = (const float*)d_in[i];
    a.out = (float*)d_out; a.ws = (unsigned char*)d_ws;
#if MK_SINGLE
    a.lo = 0; a.hi = NPHASE;
    void* args[] = {&a};
    hipError_t e = hipLaunchCooperativeKernel((const void*)mega, dim3(grid), dim3(512), args, LDS_BYTES, stream);
    if (e != hipSuccess) fprintf(stderr, "cooperative launch failed: %s (grid %d)\n", hipGetErrorString(e), grid);
#else
    for (int ph = 0; ph < NPHASE; ++ph) { a.lo = ph; a.hi = ph + 1; hipLaunchKernelGGL(mega, dim3(grid), dim3(512), LDS_BYTES, stream, a); }
#endif
}
```

```cpp
#include <hip/hip_runtime.h>
#include <hip/hip_cooperative_groups.h>
#include <cstdio>
#include <cstdint>
namespace pg8 {
#define PG8_LAS __attribute__((address_space(3)))
typedef unsigned short bf16_t;
typedef short bf16x8 __attribute__((ext_vector_type(8)));
typedef float f32x4 __attribute__((ext_vector_type(4)));
typedef unsigned u32x4 __attribute__((ext_vector_type(4)));
constexpr int BM = 256, BK = 64, HALF = 128, HTB = HALF * BK * 2  , STAGE_BYTES = 8 * HTB, NXCD = 8, WGM = 8;

__host__ __device__ __forceinline__ int lds_byte(int r, int c) { const int st = (r >> 4) * 2 + (c >> 5), rr = r & 15, cc = c & 31, ob = rr * 64 + cc * 2; return st * 1024 + (ob ^ (((ob >> 9) & 1) << 5)); }
__host__ __device__ __forceinline__ void stage_rc(int b, int& R, int& C) { const int st = b / 1024, sb = b % 1024, swz = sb ^ (((sb >> 9) & 1) << 5); R = (st >> 1) * 16 + swz / 64; C = (st & 1) * 32 + (swz % 64) / 2; }
__host__ __device__ __forceinline__ int perm32(int rho) { const int n = rho >> 4, i = rho & 15; return 8 * (i >> 2) + 4 * n + (i & 3); }

struct Unit { int pm, pn; };
struct Gemm { const bf16_t* A; const bf16_t* Bt; int M, N, K; };

struct StaticOrder {
    int nM, nN, nwg, G, c;
    __host__ __device__ void init(int M, int N, int G_, int c_) { nM = M / BM; nN = N / BM; nwg = nM * nN; G = G_; c = c_; }
    __host__ __device__ bool next(int i, Unit& u) const {
        const long L = (long)i * G + c; if (L >= nwg) return false;
        int wgid = (int)L; { const int q = nwg / NXCD, r = nwg % NXCD, xcd = wgid % NXCD, off = wgid / NXCD; wgid = (xcd < r ? xcd * (q + 1) : r * (q + 1) + (xcd - r) * q) + off; }
        const int nig = WGM * nN, gid = wgid / nig, fm = gid * WGM, gsz = (nM - fm) < WGM ? (nM - fm) : WGM;
        u.pm = fm + ((wgid % nig) % gsz); u.pn = (wgid % nig) / gsz; return true;
    }
    __device__ __forceinline__ void a_ready(const Unit&) const {}
    __device__ __forceinline__ void done(const Unit&) const {}
};

__device__ __forceinline__ unsigned cvt_pk_bf16(float lo, float hi) { unsigned r; asm volatile("v_cvt_pk_bf16_f32 %0, %1, %2" : "=v"(r) : "v"(lo), "v"(hi)); return r; }
typedef float f32x2 __attribute__((ext_vector_type(2)));
template <class Epi, class Sched, bool ALIGN_EPI = false, bool SP2 = false>
__device__ __forceinline__ void gemm_phase(PG8_LAS unsigned char* lds, const Gemm g, const Sched& S, const Epi& E) {
    int tid_ = threadIdx.x; asm volatile("" : "+v"(tid_));
    const int tid = tid_, wid = __builtin_amdgcn_readfirstlane(tid >> 6), lane = tid & 63, wr = wid >> 2, wc = wid & 3, fr = lane & 15, fq = lane >> 4;
    const int K = g.K, nt = K / BK;
    unsigned voffA[2], voffB[2];
#pragma unroll
    for (int i = 0; i < 2; ++i) { int R, C; stage_rc(tid * 16 + i * 8192, R, C); const int Rb = Epi::PERM ? ((R & ~31) + perm32(R & 31)) : R;
        voffA[i] = (unsigned)(R * K + C) * 2u; voffB[i] = (unsigned)(Rb * K + C) * 2u; }
    const size_t kstep = (size_t)(BK * 2);
    const size_t hstep = (size_t)HALF * K * 2;
    const size_t tstep = 2 * hstep;
    const unsigned ldsw = (unsigned)wid * 1024u;
    const int aoff = lds_byte(wr * 64 + fr, fq * 8), boff = lds_byte(wc * 32 + fr, fq * 8);
#define PG8_SA(b, h) (((b) * 2 + (h)) * HTB)
#define PG8_SB(b, h) ((4 + (b) * 2 + (h)) * HTB)
#define PG8_STAGE(bufoff, gbase, voff) do { _Pragma("unroll") for (int _i = 0; _i < 2; ++_i) \
        __builtin_amdgcn_global_load_lds((const unsigned*)((const char*)(gbase) + (voff)[_i]), (PG8_LAS unsigned*)(lds + (bufoff) + ldsw + _i * 8192), 16, 0, 0); } while (0)
#define PG8_LDA(dst, b, h) do { _Pragma("unroll") for (int m = 0; m < 4; ++m) _Pragma("unroll") for (int k = 0; k < 2; ++k) dst[m][k] = *(const PG8_LAS bf16x8*)(lds + PG8_SA(b, h) + aoff + m * 2048 + k * 1024); } while (0)
#define PG8_LDB(dst, b, h) do { _Pragma("unroll") for (int n = 0; n < 2; ++n) _Pragma("unroll") for (int k = 0; k < 2; ++k) dst[n][k] = *(const PG8_LAS bf16x8*)(lds + PG8_SB(b, h) + boff + n * 2048 + k * 1024); } while (0)
#define PG8_MMA(ai, bj, At, Bt) do { __builtin_amdgcn_s_setprio(1); _Pragma("unroll") for (int m = 0; m < 4; ++m) _Pragma("unroll") for (int n = 0; n < 2; ++n) _Pragma("unroll") for (int k = 0; k < 2; ++k) \
        acc[ai][bj][m][n] = __builtin_amdgcn_mfma_f32_16x16x32_bf16(Bt[n][k], At[m][k], acc[ai][bj][m][n], 0, 0, 0); __builtin_amdgcn_s_setprio(0); } while (0)
#define PG8_WAIT_V(n) asm volatile("s_waitcnt vmcnt(" #n ")" ::: "memory")
#define PG8_WAIT_L(n) asm volatile("s_waitcnt lgkmcnt(" #n ")" ::: "memory")
#define PG8_BAR __builtin_amdgcn_s_barrier()
#define PG8_SCHED __builtin_amdgcn_sched_barrier(0)
    Unit cur, nxt; int ui = 0;
    if (!S.next(0, cur)) return;
    f32x4 acc[2][2][4][2];
#pragma unroll
    for (int a = 0; a < 2; ++a)
#pragma unroll
        for (int b = 0; b < 2; ++b)
#pragma unroll
            for (int m = 0; m < 4; ++m)
#pragma unroll
                for (int n = 0; n < 2; ++n) acc[a][b][m][n] = (f32x4){0.f, 0.f, 0.f, 0.f};
    bf16x8 At[4][2], B0[2][2], B1[2][2];
    const char* cA = (const char*)g.A + (size_t)cur.pm * tstep; const char* cB = (const char*)g.Bt + (size_t)cur.pn * tstep;
    S.a_ready(cur);
    if constexpr (SP2) {
        PG8_STAGE(PG8_SB(0, 0), cB, voffB); PG8_STAGE(PG8_SB(0, 1), cB + hstep, voffB); PG8_STAGE(PG8_SA(0, 0), cA, voffA); PG8_STAGE(PG8_SA(0, 1), cA + hstep, voffA);
        if (wr == 1) PG8_BAR;
        PG8_WAIT_V(2); PG8_BAR;
        PG8_STAGE(PG8_SB(1, 0), cB + kstep, voffB); PG8_STAGE(PG8_SA(1, 0), cA + kstep, voffA); PG8_STAGE(PG8_SB(1, 1), cB + hstep + kstep, voffB);
        PG8_WAIT_V(6); PG8_BAR;
    } else {
        PG8_STAGE(PG8_SB(0, 0), cB, voffB); PG8_STAGE(PG8_SA(0, 0), cA, voffA); PG8_STAGE(PG8_SB(0, 1), cB + hstep, voffB); PG8_STAGE(PG8_SA(0, 1), cA + hstep, voffA);
        if (wr == 1) PG8_BAR;
        PG8_WAIT_V(4); PG8_BAR;
        PG8_STAGE(PG8_SB(1, 0), cB + kstep, voffB); PG8_STAGE(PG8_SA(1, 0), cA + kstep, voffA); PG8_STAGE(PG8_SB(1, 1), cB + hstep + kstep, voffB);
        PG8_WAIT_V(6); PG8_BAR;
    }
    for (;;) {
        const bool has_next = S.next(ui + 1, nxt);
        const char* nA = has_next ? (const char*)g.A + (size_t)nxt.pm * tstep : cA; const char* nB = has_next ? (const char*)g.Bt + (size_t)nxt.pn * tstep : cB;
        for (int t = 0; t < nt; t += 2) {
            const bool last = (t == nt - 2);
            const char* a1 = cA + (size_t)(t + 1) * kstep;
            const char* a2 = last ? nA : cA + (size_t)(t + 2) * kstep; const char* b2 = last ? nB : cB + (size_t)(t + 2) * kstep;
            const char* a3 = a2 + kstep; const char* b3 = b2 + kstep;
            if (last && has_next) S.a_ready(nxt);
            if constexpr (SP2) {
            PG8_LDB(B0, 0, 0); PG8_LDB(B1, 0, 1); PG8_SCHED; PG8_LDA(At, 0, 0); PG8_STAGE(PG8_SA(1, 1), a1 + hstep, voffA);
            PG8_WAIT_V(8); PG8_WAIT_L(0); PG8_BAR; PG8_MMA(0, 0, At, B0); PG8_MMA(0, 1, At, B1); PG8_BAR; PG8_SCHED;
            PG8_LDA(At, 0, 1); PG8_STAGE(PG8_SB(0, 0), b2, voffB); PG8_STAGE(PG8_SB(0, 1), b2 + hstep, voffB); PG8_STAGE(PG8_SA(0, 0), a2, voffA);
            PG8_WAIT_V(8); PG8_WAIT_L(0); PG8_BAR; PG8_MMA(1, 0, At, B0); PG8_MMA(1, 1, At, B1); PG8_BAR; PG8_SCHED;
            PG8_LDB(B0, 1, 0); PG8_LDB(B1, 1, 1); PG8_SCHED; PG8_LDA(At, 1, 0); PG8_STAGE(PG8_SA(0, 1), a2 + hstep, voffA);
            PG8_WAIT_V(8); PG8_WAIT_L(0); PG8_BAR; PG8_MMA(0, 0, At, B0); PG8_MMA(0, 1, At, B1); PG8_BAR; PG8_SCHED;
            PG8_LDA(At, 1, 1); PG8_STAGE(PG8_SB(1, 0), b3, voffB); PG8_STAGE(PG8_SB(1, 1), b3 + hstep, voffB); PG8_STAGE(PG8_SA(1, 0), a3, voffA);
            PG8_WAIT_V(8); PG8_WAIT_L(0); PG8_BAR; PG8_MMA(1, 0, At, B0); PG8_MMA(1, 1, At, B1); PG8_BAR; PG8_SCHED;
            } else {
            PG8_LDB(B0, 0, 0); PG8_SCHED; PG8_LDA(At, 0, 0); PG8_STAGE(PG8_SA(1, 1), a1 + hstep, voffA);
            PG8_WAIT_L(8); PG8_BAR; PG8_WAIT_L(0); PG8_MMA(0, 0, At, B0); PG8_BAR; PG8_SCHED;
            PG8_LDB(B1, 0, 1); PG8_STAGE(PG8_SB(0, 0), b2, voffB);
            PG8_BAR; PG8_WAIT_L(0); PG8_MMA(0, 1, At, B1); PG8_BAR;
            PG8_LDA(At, 0, 1); PG8_STAGE(PG8_SA(0, 0), a2, voffA);
            PG8_BAR; PG8_WAIT_L(0); PG8_MMA(1, 0, At, B0); PG8_BAR; PG8_SCHED;
            PG8_STAGE(PG8_SB(0, 1), b2 + hstep, voffB);
            PG8_WAIT_V(6); PG8_BAR; PG8_MMA(1, 1, At, B1); PG8_BAR;
            PG8_LDB(B0, 1, 0); PG8_SCHED; PG8_LDA(At, 1, 0); PG8_STAGE(PG8_SA(0, 1), a2 + hstep, voffA);
            PG8_WAIT_L(8); PG8_BAR; PG8_WAIT_L(0); PG8_MMA(0, 0, At, B0); PG8_BAR; PG8_SCHED;
            PG8_LDB(B1, 1, 1); PG8_STAGE(PG8_SB(1, 0), b3, voffB);
            PG8_BAR; PG8_WAIT_L(0); PG8_MMA(0, 1, At, B1); PG8_BAR;
            PG8_LDA(At, 1, 1); PG8_STAGE(PG8_SA(1, 0), a3, voffA);
            PG8_BAR; PG8_WAIT_L(0); PG8_MMA(1, 0, At, B0); PG8_BAR; PG8_SCHED;
            PG8_STAGE(PG8_SB(1, 1), b3 + hstep, voffB);
            PG8_WAIT_V(6); PG8_BAR; PG8_MMA(1, 1, At, B1); PG8_BAR;
            }
        }
        if constexpr (ALIGN_EPI) { if (wr == 0) PG8_BAR; }
        if constexpr (!Epi::AFTER_DRAIN) { E(acc, cur, wr, wc, fr, fq); S.done(cur); }
        if (!has_next) break;
#pragma unroll
        for (int a = 0; a < 2; ++a)
#pragma unroll
            for (int b = 0; b < 2; ++b)
#pragma unroll
                for (int m = 0; m < 4; ++m)
#pragma unroll
                    for (int n = 0; n < 2; ++n) acc[a][b][m][n] = (f32x4){0.f, 0.f, 0.f, 0.f};
        cur = nxt; cA = nA; cB = nB; ++ui;
        if constexpr (ALIGN_EPI) { if (wr == 1) PG8_BAR; }
    }
    PG8_WAIT_V(0);
    if constexpr (!ALIGN_EPI) { if (wr == 0) PG8_BAR; }
    PG8_BAR;
    if constexpr (Epi::AFTER_DRAIN) { E.fused(acc, cur, wr, wc, fr, fq, lds, wid, lane); S.done(cur); }
#undef PG8_SA
#undef PG8_SB
#undef PG8_STAGE
#undef PG8_LDA
#undef PG8_LDB
#undef PG8_MMA
#undef PG8_WAIT_V
#undef PG8_WAIT_L
#undef PG8_BAR
#undef PG8_SCHED
}
}

namespace cg = cooperative_groups;
#ifndef MK_SINGLE
#define MK_SINGLE 1
#endif
constexpr int DM = 1024, BATCH = 2, SEQ = 16384, TT = BATCH * SEQ, DEPTH = 2;
constexpr int NH = 6, HD = 64, RW = 384, DIN = 3238, NIN = 3328, FFH = 2816;
constexpr int FRP = 1536, FXP = 1536, PLP = 256;
constexpr float RMS_EPS = 1e-6f, GN_EPS = 64e-5f, LOG2E = 1.4426950408889634f;
constexpr float QSCALE = 0.125f * 1.4426950408889634f;

constexpr size_t MiB = 1u << 20;
constexpr size_t WS_CTL = 0, CTL_BYTES = 1 * MiB;
constexpr size_t WS_WIN = 1 * MiB, WS_WOUT = 14 * MiB, WS_WGU = 18 * MiB, WS_WDN = 40 * MiB;
constexpr size_t WS_FR = 52 * MiB, WS_MIX = 52 * MiB, WS_H = 52 * MiB;
constexpr size_t WS_FXQ = 148 * MiB, WS_PL = 244 * MiB, WS_FF = 260 * MiB, WS_LF = 261 * MiB, WS_CUM = 262 * MiB;
constexpr size_t WS_VF = 264 * MiB;
constexpr size_t WS_LORA = 506 * MiB;
constexpr size_t WS_RP = 288 * MiB, WS_HN = 288 * MiB, WS_TMP = 352 * MiB;
constexpr size_t RP_R = WS_RP, RP_K = WS_RP + 24 * MiB, RP_V = WS_RP + 48 * MiB, RP_KK = WS_RP + 72 * MiB, RP_BB = WS_RP + 96 * MiB, RP_LW = WS_RP + 120 * MiB, RP_G = WS_RP + 168 * MiB;
constexpr size_t WS_YB = 116 * MiB;
constexpr size_t WS_Y0 = 480 * MiB, WS_PC = 504 * MiB, WS_BONUS = 505 * MiB;
constexpr size_t WS_END = 507 * MiB;
constexpr size_t WIN_L = (size_t)NIN * DM, WOUT_L = (size_t)DM * DM, WGU_L = (size_t)2 * FFH * DM, WDN_L = (size_t)DM * FFH;

constexpr int LDS_BYTES = 147456;

#define LAS __attribute__((address_space(3)))
typedef unsigned short bf16;
typedef float f32x4 __attribute__((ext_vector_type(4)));
typedef float f32x16 __attribute__((ext_vector_type(16)));
typedef short bf16x8 __attribute__((ext_vector_type(8)));
typedef short s16x4 __attribute__((ext_vector_type(4)));
typedef unsigned u32x4 __attribute__((ext_vector_type(4)));
typedef unsigned u32x2 __attribute__((ext_vector_type(2)));

__device__ __forceinline__ float bf2f(bf16 v) { return __uint_as_float((unsigned)v << 16); }
__device__ __forceinline__ unsigned f2bf(float f) { unsigned u = __float_as_uint(f); return (u + 0x7fffu + ((u >> 16) & 1u)) >> 16; }
__device__ __forceinline__ unsigned pk2(float lo, float hi) { return f2bf(lo) | (f2bf(hi) << 16); }
__device__ __forceinline__ float sigmoidf_(float x) { return 1.0f / (1.0f + __expf(-x)); }
__device__ __forceinline__ float wave_sum(float v) {
#pragma unroll
    for (int o = 1; o < 64; o <<= 1) v += __shfl_xor(v, o);
    return v;
}

#define RLX_AGENT __ATOMIC_RELAXED, __HIP_MEMORY_SCOPE_AGENT
#define XB_TMO      128
#define XB_XCNT(j)  (256  + 64 * (j))
#define XB_XSUB(j)  (1280 + 64 * (j))
#define XB_XGEN(j)  (2304 + 64 * (j))
#define XB_TOP      3328
#define XB_TOPGEN   3392
#define XCD_BAR_WORDS 3456
#define XB_SPIN_CAP (1u << 18)

__device__ __forceinline__ unsigned xb_ld(unsigned* p)              { return __hip_atomic_load(p, __ATOMIC_RELAXED, __HIP_MEMORY_SCOPE_AGENT); }
__device__ __forceinline__ unsigned xb_add(unsigned* p, unsigned v) { return __hip_atomic_fetch_add(p, v, __ATOMIC_RELAXED, __HIP_MEMORY_SCOPE_AGENT); }
__device__ __forceinline__ unsigned xb_xcc_id() { return (unsigned)__builtin_amdgcn_s_getreg((3 << 11) | 20) & 0xFu; }
#define XB_SPIN(cond, bar) do { unsigned _sp = 0; while (cond) { __builtin_amdgcn_s_sleep(1); \
    if ((++_sp & 255u) == 0u) { if (xb_ld(&(bar)[XB_TMO])) break; if (_sp > XB_SPIN_CAP) { atomicAdd(&(bar)[XB_TMO], 1u); break; } } } } while (0)

struct XcdBarrier {
    unsigned* bar; unsigned x;
    volatile LAS unsigned* st;
};

__device__ __forceinline__ XcdBarrier xcd_barrier_post(unsigned* bar, volatile LAS unsigned* st) {
    XcdBarrier b; b.bar = bar; b.x = xb_xcc_id(); b.st = st;
    if (threadIdx.x == 0) (void)xb_add(&bar[XB_XCNT(b.x)], 1u);
    return b;
}
__device__ __forceinline__ void xcd_barrier_complete(unsigned* bar, unsigned x, unsigned& nloc, unsigned& nx) {
    const unsigned G = gridDim.x * gridDim.y * gridDim.z;
    unsigned sum, cnt, mine, sp = 0u;
    for (;;) {
        sum = 0u; cnt = 0u; mine = 0u;
#pragma unroll
        for (unsigned j = 0; j < 16; ++j) { const unsigned c = xb_ld(&bar[XB_XCNT(j)]); sum += c; cnt += (c > 0u) ? 1u : 0u; mine = (j == x) ? c : mine; }
        if (sum == G) break;
        __builtin_amdgcn_s_sleep(1);
        if ((++sp & 255u) == 0u) { if (xb_ld(&bar[XB_TMO])) break; if (sp > XB_SPIN_CAP) { atomicAdd(&bar[XB_TMO], 1u); break; } }
    }
    nloc = mine > 0u ? mine : 1u; nx = cnt > 0u ? cnt : 1u;
}

__device__ __forceinline__ void xcd_barrier(const XcdBarrier& b) {
    asm volatile("s_waitcnt vmcnt(0)" ::: "memory");
    __syncthreads();
    if (threadIdx.x == 0) {
        unsigned* bar = b.bar;
        __builtin_amdgcn_s_waitcnt(0);
        unsigned nloc = b.st[0], nx = b.st[1];
        if (nloc == 0u) { xcd_barrier_complete(bar, b.x, nloc, nx); b.st[0] = nloc; b.st[1] = nx; }
        const unsigned old = xb_add(&bar[XB_XSUB(b.x)], 1u);
        const unsigned gen = old / nloc;
        if (old + 1u == (gen + 1u) * nloc) {
            __builtin_amdgcn_fence(__ATOMIC_RELEASE, "agent");
            asm volatile("s_waitcnt vmcnt(0)" ::: "memory");
            const unsigned og = xb_add(&bar[XB_TOP], 1u);
            const unsigned tg = og / nx;
            if (og + 1u == (tg + 1u) * nx) xb_add(&bar[XB_TOPGEN], 1u);
            else XB_SPIN(xb_ld(&bar[XB_TOPGEN]) == tg, bar);
            __builtin_amdgcn_fence(__ATOMIC_ACQUIRE, "agent");
            xb_add(&bar[XB_XGEN(b.x)], 1u);
            asm volatile("s_waitcnt vmcnt(0)" ::: "memory");
        } else {
            XB_SPIN(xb_ld(&bar[XB_XGEN(b.x)]) == gen, bar);
            __builtin_amdgcn_fence(__ATOMIC_ACQUIRE, "agent");
            asm volatile("s_waitcnt vmcnt(0)" ::: "memory");
        }
    }
    __syncthreads();
}

struct Args { const float* in[28]; float* out; unsigned char* ws; int lo, hi; };
typedef const Args __attribute__((address_space(4)))* ArgsP;
__device__ __forceinline__ Args get_args() {
#if defined(__HIP_DEVICE_COMPILE__)
    ArgsP p = (ArgsP)__builtin_amdgcn_kernarg_segment_ptr(); asm volatile("" : "+s"(p)); return *p;
#else
    return Args{};
#endif
}

namespace pg8 {
struct EpiInProj {
    static constexpr bool PERM = true, AFTER_DRAIN = false;
    bf16_t* FR; bf16_t* FXQ; bf16_t* PL; float* FF;
    __device__ __forceinline__ void operator()(const f32x4 (&acc)[2][2][4][2], const Unit& u, int wr, int wc, int fr, int fq) const {
        bf16_t* base; int ldc, colt;
        if (u.pn < 6) { base = FR; ldc = FRP; colt = u.pn * 256; }
        else if (u.pn < 12) { base = FXQ; ldc = FXP; colt = (u.pn - 6) * 256; }
        else { base = PL; ldc = PLP; colt = 0; }
        const int row0 = u.pm * BM + wr * 64 + fr, col0 = colt + wc * 32 + 8 * fq;
        const bool ffl = (u.pn == 5) && (wc == 1) && (fq == 0);
#pragma unroll
        for (int ai = 0; ai < 2; ++ai)
#pragma unroll
            for (int m = 0; m < 4; ++m) { const int row = row0 + ai * HALF + m * 16; bf16_t* rowp = base + (size_t)row * ldc + col0;
#pragma unroll
                for (int bj = 0; bj < 2; ++bj) { const f32x4 v0 = acc[ai][bj][m][0], v1 = acc[ai][bj][m][1];
                    u32x4 w; w.x = cvt_pk_bf16(v0[0], v0[1]); w.y = cvt_pk_bf16(v0[2], v0[3]); w.z = cvt_pk_bf16(v1[0], v1[1]); w.w = cvt_pk_bf16(v1[2], v1[3]);
                    *(u32x4*)(rowp + bj * HALF) = w;
                    if (bj == 1 && ffl) { *(f32x4*)(FF + (size_t)row * 8) = v0; *(f32x4*)(FF + (size_t)row * 8 + 4) = v1; } } }
    }
};
struct EpiSwiglu {
    static constexpr bool PERM = true, AFTER_DRAIN = false;
    bf16_t* H;
    __device__ __forceinline__ void operator()(const f32x4 (&acc)[2][2][4][2], const Unit& u, int wr, int wc, int fr, int fq) const {
        const int row0 = u.pm * BM + wr * 64 + fr, col0 = u.pn * 128 + wc * 32 + 8 * fq;
#pragma unroll
        for (int ai = 0; ai < 2; ++ai)
#pragma unroll
            for (int m = 0; m < 4; ++m) { bf16_t* rowp = H + (size_t)(row0 + ai * HALF + m * 16) * FFH + col0;
                float h[8];
#pragma unroll
                for (int n = 0; n < 2; ++n)
#pragma unroll
                    for (int e = 0; e < 4; ++e) { const float g = acc[ai][0][m][n][e], up = acc[ai][1][m][n][e]; h[n * 4 + e] = g / (1.0f + __expf(-g)) * up; }
                u32x4 w; w.x = cvt_pk_bf16(h[0], h[1]); w.y = cvt_pk_bf16(h[2], h[3]); w.z = cvt_pk_bf16(h[4], h[5]); w.w = cvt_pk_bf16(h[6], h[7]);
                *(u32x4*)rowp = w; }
    }
};
struct EpiF32 {
    static constexpr bool PERM = false, AFTER_DRAIN = false;
    float* O; int ldc;
    __device__ __forceinline__ void operator()(const f32x4 (&acc)[2][2][4][2], const Unit& u, int wr, int wc, int fr, int fq) const {
        const int row0 = u.pm * BM + wr * 64 + fr, col0 = u.pn * BM + wc * 32 + 4 * fq;
#pragma unroll
        for (int ai = 0; ai < 2; ++ai)
#pragma unroll
            for (int m = 0; m < 4; ++m) { float* rowp = O + (size_t)(row0 + ai * HALF + m * 16) * ldc + col0;
#pragma unroll
                for (int bj = 0; bj < 2; ++bj)
#pragma unroll
                    for (int n = 0; n < 2; ++n) *(f32x4*)(rowp + bj * HALF + n * 16) = acc[ai][bj][m][n]; }
    }
};
}

template <int MODE> __device__ __forceinline__ int wmap(int n) {
    if (MODE == 0) { if (n < 1440) return n; if (n < 2976) return n + 96; if (n < 2982) return n - 1536; return n + 90; }
    if (MODE == 1) { if (n < FFH) return 256 * (n >> 7) + (n & 127); const int j = n - FFH; return 256 * (j >> 7) + 128 + (j & 127); }
    return n;
}
template <int MODE> __device__ __forceinline__ void tr_item(const float* W, int K, int N, bf16* WT, LAS float* scr, int item, int lane) {
    const int nblk = (N + 31) / 32, kb = item / nblk, nb = item % nblk, k0 = 64 * kb, n0 = 32 * nb;
    const int nl = lane & 31, n = n0 + nl;
#pragma unroll 8
    for (int i = 0; i < 32; ++i) { const int kk = 2 * i + (lane >> 5); scr[kk * 33 + nl] = (n < N) ? W[(size_t)(k0 + kk) * N + n] : 0.f; }
    asm volatile("s_waitcnt lgkmcnt(0)" ::: "memory");
    const int c = lane & 7;
#pragma unroll
    for (int j = 0; j < 4; ++j) { const int nn = (lane >> 3) + 8 * j; const LAS float* s = scr + (8 * c) * 33 + nn;
        u32x4 o; o.x = pk2(s[0 * 33], s[1 * 33]); o.y = pk2(s[2 * 33], s[3 * 33]); o.z = pk2(s[4 * 33], s[5 * 33]); o.w = pk2(s[6 * 33], s[7 * 33]);
        if (n0 + nn < N) *(u32x4*)(WT + (size_t)wmap<MODE>(n0 + nn) * K + k0 + 8 * c) = o; }
    asm volatile("s_waitcnt lgkmcnt(0)" ::: "memory");
}
__device__ __forceinline__ void rms_row_bf16(const float* xrow, const float* g, bf16* orow, int lane) {
    const f32x4* xr = (const f32x4*)xrow + lane; const f32x4* gr = (const f32x4*)g + lane;
    f32x4 v[4]; float s = 0.f;
#pragma unroll
    for (int j = 0; j < 4; ++j) { v[j] = xr[64 * j]; s += (v[j].x * v[j].x + v[j].y * v[j].y) + (v[j].z * v[j].z + v[j].w * v[j].w); }
    const float rs = rsqrtf(wave_sum(s) * (1.f / DM) + RMS_EPS);
    unsigned long long* o8 = (unsigned long long*)orow + lane;
#pragma unroll
    for (int j = 0; j < 4; ++j) { const f32x4 gg = gr[64 * j];
        o8[64 * j] = (unsigned long long)pk2(v[j].x * rs * gg.x, v[j].y * rs * gg.y) | ((unsigned long long)pk2(v[j].z * rs * gg.z, v[j].w * rs * gg.w) << 32); }
}
__device__ __forceinline__ void phase_prologue(const Args& a, LAS unsigned char* lds, int tid, int G) {
    const int lane = tid & 63, wave = tid >> 6, gw = blockIdx.x * 8 + wave, NGW = G * 8;
    LAS float* scr = (LAS float*)(lds + wave * 16384);
    unsigned char* ws = a.ws;
    constexpr int I_IN = 16 * 102, I_GU = 16 * 176, I_OUT = 16 * 32, I_DN = 44 * 32, I_L = I_IN + I_GU + I_OUT + I_DN;
    for (int it = gw; it < DEPTH * I_L; it += NGW) {
        const int l = it / I_L; int r = it % I_L;
        if (r < I_IN) { tr_item<0>(a.in[5] + (size_t)l * DM * DIN, DM, DIN, (bf16*)(ws + WS_WIN) + l * WIN_L, scr, r, lane); continue; } r -= I_IN;
        if (r < I_GU) { tr_item<1>(a.in[26] + (size_t)l * DM * 2 * FFH, DM, 2 * FFH, (bf16*)(ws + WS_WGU) + l * WGU_L, scr, r, lane); continue; } r -= I_GU;
        if (r < I_OUT) { tr_item<2>(a.in[6] + (size_t)l * DM * DM, DM, DM, (bf16*)(ws + WS_WOUT) + l * WOUT_L, scr, r, lane); continue; } r -= I_OUT;
        tr_item<2>(a.in[27] + (size_t)l * FFH * DM, FFH, DM, (bf16*)(ws + WS_WDN) + l * WDN_L, scr, r, lane);
    }
    for (int i = blockIdx.x * 512 + tid; i < DEPTH * 90 * (DM / 8); i += G * 512) { const int l = i / (90 * (DM / 8)), r = i % (90 * (DM / 8));
        *(u32x4*)((bf16*)(ws + WS_WIN) + l * WIN_L + (size_t)(1446 + r / (DM / 8)) * DM + (r % (DM / 8)) * 8) = (u32x4){0u, 0u, 0u, 0u}; }
    { bf16* L = (bf16*)(ws + WS_LORA);
      for (int i = blockIdx.x * 512 + tid; i < 245760; i += G * 512) { float v;
          if (i < 98304) { const int m = i / 49152, r = i % 49152, l = r / 24576, n = (r % 24576) / 64, k = r % 64; v = a.in[m == 0 ? 9 : 11][(size_t)l * 64 * RW + k * RW + n]; }
          else if (i < 221184) { const int r = i - 98304, l = r / 61440, n = (r % 61440) / 160, k = r % 160; v = a.in[12][(size_t)l * 160 * RW + k * RW + n]; }
          else if (i < 233472) { const int r = i - 221184, n = r / 384, k = r % 384; v = a.in[14][k * 32 + n]; }
          else { const int r = i - 233472, n = r / 32, k = r % 32; v = a.in[15][k * RW + n]; }
          L[i] = (bf16)f2bf(v); } }
    for (int m = gw; m < TT; m += NGW) rms_row_bf16(a.in[0] + (size_t)m * DM, a.in[1], (bf16*)(ws + WS_HN) + (size_t)m * DM, lane);
}

__device__ __forceinline__ void phase_prep(const Args& a, int layer, LAS unsigned char* lds, int tid, int G) {
    unsigned char* ws = a.ws;
    const int lane = tid & 63, wave = tid >> 6;
    LAS float* F = (LAS float*)lds;
    LAS float* TV = (LAS float*)(lds + 92160);
    const bf16* FR = (const bf16*)(ws + WS_FR); bf16* FXQ = (bf16*)(ws + WS_FXQ); const float* FF = (const float*)(ws + WS_FF);
    const float* mu = a.in[7] + layer * 1440; const float* w0 = a.in[8] + layer * RW; const float* w2 = a.in[9] + (size_t)layer * 64 * RW;
    const float* a0 = a.in[10] + layer * RW; const float* a2 = a.in[11] + (size_t)layer * 64 * RW; const float* g2 = a.in[12] + (size_t)layer * 160 * RW;
    const float* v0 = a.in[13]; const float* v1 = a.in[14]; const float* v2 = a.in[15];
    const float* k_k = a.in[16] + layer * RW; const float* k_a = a.in[17] + layer * RW;
    const float* q_g = a.in[21] + layer * HD; const float* k_g = a.in[22] + layer * HD; const float* f_b = a.in[23] + layer * NH;
    bf16* R = (bf16*)(ws + RP_R); bf16* K = (bf16*)(ws + RP_K); bf16* V = (bf16*)(ws + (layer == 0 ? WS_VF : RP_V)); const bf16* VF = (const bf16*)(ws + WS_VF);
    bf16* KK = (bf16*)(ws + RP_KK); bf16* BB = (bf16*)(ws + RP_BB); float* LW = (float*)(ws + RP_LW); bf16* GG = (bf16*)(ws + RP_G);
    float* LF = (float*)(ws + WS_LF); float* BONUS = (float*)(ws + WS_BONUS); const float* r_k = a.in[18] + layer * RW;
    for (int item = blockIdx.x; item < TT / 16; item += G) {
        const int t0 = item * 16, s0 = t0 % SEQ, bb = t0 / SEQ;
        __syncthreads();
        for (int idx = tid; idx < 16 * 1440; idx += 512) { const int tok = idx / 1440, c = idx % 1440;
            const float cur = bf2f(FR[(size_t)(t0 + tok) * FRP + c]); const float prev = (s0 + tok == 0) ? 0.f : bf2f(FR[(size_t)(t0 + tok - 1) * FRP + c]);
            float f = cur + (prev - cur) * mu[c];
            if (c >= 1152 && c < 1216) f = tanhf(f); else if (c >= 1280) f = sigmoidf_(f);
            F[idx] = f; }
        __syncthreads();
        if (layer > 0) { const int tok = tid >> 5, o = tid & 31; float s = 0.f;
            for (int c = 0; c < RW; ++c) s += F[tok * 1440 + 768 + c] * v1[c * 32 + o];
            TV[tok * 32 + o] = s; }
        __syncthreads();
        if (tid < RW) { const int j = tid;
            float aw[16], aa[16], ag[16];
#pragma unroll
            for (int t = 0; t < 16; ++t) { aw[t] = w0[j]; aa[t] = a0[j]; ag[t] = 0.f; }
            for (int i = 0; i < 64; ++i) { const float ww = w2[i * RW + j], av = a2[i * RW + j];
#pragma unroll
                for (int t = 0; t < 16; ++t) { aw[t] += F[t * 1440 + 1152 + i] * ww; aa[t] += F[t * 1440 + 1216 + i] * av; } }
            for (int i = 0; i < 160; ++i) { const float gv = g2[i * RW + j];
#pragma unroll
                for (int t = 0; t < 16; ++t) ag[t] += F[t * 1440 + 1280 + i] * gv; }
            const float kkj = k_k[j], kaj = k_a[j];
#pragma unroll
            for (int t = 0; t < 16; ++t) { const size_t o = (size_t)(t0 + t) * RW + j;
                const float lw = -0.6065306597126334f * sigmoidf_(aw[t]); const float av = sigmoidf_(aa[t]);
                const float r = F[t * 1440 + j], k = F[t * 1440 + 384 + j]; float v = F[t * 1440 + 768 + j];
                if (layer > 0) { float gs = v0[j];
#pragma unroll 8
                    for (int oo = 0; oo < 32; ++oo) gs += TV[t * 32 + oo] * v2[oo * RW + j];
                    v = v + (bf2f(VF[o]) - v) * sigmoidf_(gs); }
                const float kq = k * kkj; const float ss = wave_sum(kq * kq); const float kkn = kq / fmaxf(sqrtf(ss), 1e-12f);
                { const float bs = wave_sum(r * (k * (1.0f + (av - 1.0f) * kaj)) * r_k[j]); if (lane == 0) BONUS[(size_t)(t0 + t) * NH + wave] = bs; }
                R[o] = (bf16)f2bf(r); K[o] = (bf16)f2bf(k * (1.0f + (av - 1.0f) * kaj)); V[o] = (bf16)f2bf(v); KK[o] = (bf16)f2bf(kkn); BB[o] = (bf16)f2bf(kkn * av);
                LW[o] = lw; GG[o] = (bf16)f2bf(ag[t]); }
        }
        for (int cmb = wave; cmb < 16 * NH * 2; cmb += 8) { const int tok = cmb / (NH * 2), rem = cmb % (NH * 2), hh = rem >> 1, which = rem & 1;
            bf16* p = FXQ + (size_t)(t0 + tok) * FXP + which * RW + hh * HD + lane; const float v = bf2f(*p);
            const float rs = rsqrtf(wave_sum(v * v) * (1.f / HD) + RMS_EPS);
            *p = (bf16)f2bf(which == 0 ? v * rs * q_g[lane] * QSCALE : v * rs * k_g[lane]); }
        if (tid < 16 * NH) { const int tok = tid / NH, hh = tid % NH; const float x = FF[(size_t)(t0 + tok) * 8 + hh] + f_b[hh];
            LF[(size_t)(bb * NH + hh) * SEQ + s0 + tok] = fminf(x, 0.f) - log1pf(__expf(-fabsf(x))); }
    }
}

__device__ __forceinline__ void phase_cumsum(const Args& a, LAS unsigned char* lds, int tid, int G) {
    const float* LF = (const float*)(a.ws + WS_LF); float* CUM = (float*)(a.ws + WS_CUM);
    LAS double* part = (LAS double*)lds;
    for (int ser = blockIdx.x; ser < BATCH * NH; ser += G) {
        const float* src = LF + (size_t)ser * SEQ + tid * 32; float* dst = CUM + (size_t)ser * SEQ + tid * 32;
        float v[32]; double s = 0.0;
#pragma unroll
        for (int i = 0; i < 32; ++i) { v[i] = src[i]; s += (double)v[i]; }
        __syncthreads(); part[tid] = s; __syncthreads();
        if (tid == 0) { double run = 0.0; for (int i = 0; i < 512; ++i) { const double t = part[i]; part[i] = run; run += t; } }
        __syncthreads();
        double run = part[tid];
#pragma unroll
        for (int i = 0; i < 32; ++i) { run += (double)v[i]; dst[i] = (float)run; }
    }
}

__device__ __forceinline__ float rl(float v, int k) { return __uint_as_float(__builtin_amdgcn_readlane(__float_as_uint(v), k)); }
__device__ __forceinline__ void rwkv_scan_naive(const Args& a, int layer, int bh, int lane) {
    unsigned char* ws = a.ws;
    const int b = bh / NH, h = bh % NH;
    const bf16* R = (const bf16*)(ws + RP_R); const bf16* K = (const bf16*)(ws + RP_K); const bf16* V = (const bf16*)(ws + (layer == 0 ? WS_VF : RP_V));
    const bf16* KK = (const bf16*)(ws + RP_KK); const bf16* BB = (const bf16*)(ws + RP_BB); float* LW = (float*)(ws + RP_LW);
    float S[64];
#pragma unroll
    for (int k = 0; k < 64; ++k) S[k] = 0.f;
    size_t o = (size_t)b * SEQ * RW + h * HD + lane;
    float rn = bf2f(R[o]), kn = bf2f(K[o]), vn = bf2f(V[o]), kkn = bf2f(KK[o]), bn = bf2f(BB[o]), wn = LW[o];
    for (int t = 0; t < SEQ; ++t) {
        const float rc = rn, kc = kn, vc = vn, kkc = -kkn, bc = bn, wc = __expf(wn);
        const size_t oc = o;
        if (t + 1 < SEQ) { o += RW; rn = bf2f(R[o]); kn = bf2f(K[o]); vn = bf2f(V[o]); kkn = bf2f(KK[o]); bn = bf2f(BB[o]); wn = LW[o]; }
        float sa0 = 0.f, sa1 = 0.f, sa2 = 0.f, sa3 = 0.f;
#pragma unroll
        for (int k = 0; k < 64; k += 4) { sa0 += S[k] * rl(kkc, k); sa1 += S[k + 1] * rl(kkc, k + 1); sa2 += S[k + 2] * rl(kkc, k + 2); sa3 += S[k + 3] * rl(kkc, k + 3); }
        const float sa = (sa0 + sa1) + (sa2 + sa3);
        float y0 = 0.f, y1 = 0.f, y2 = 0.f, y3 = 0.f;
#pragma unroll
        for (int k = 0; k < 64; k += 4) {
#pragma unroll
            for (int e = 0; e < 4; ++e) { S[k + e] = S[k + e] * rl(wc, k + e) + sa * rl(bc, k + e) + vc * rl(kc, k + e); }
            y0 += S[k] * rl(rc, k); y1 += S[k + 1] * rl(rc, k + 1); y2 += S[k + 2] * rl(rc, k + 2); y3 += S[k + 3] * rl(rc, k + 3); }
        LW[oc] = (y0 + y1) + (y2 + y3);
    }
}

__device__ __forceinline__ int crow(int r, int hi) { return (r & 3) + 8 * (r >> 2) + 4 * hi; }
__device__ __forceinline__ unsigned cvtpk(float lo, float hi) { typedef float f2 __attribute__((ext_vector_type(2))); typedef __bf16 b2 __attribute__((ext_vector_type(2))); f2 v = {lo, hi}; b2 b = __builtin_convertvector(v, b2); return __builtin_bit_cast(unsigned, b); }
__device__ __forceinline__ s16x4 vtr(LAS const unsigned char* p) { typedef short v4i16_t __attribute__((ext_vector_type(4))); return __builtin_bit_cast(s16x4, __builtin_amdgcn_ds_read_tr16_b64_v4i16((LAS v4i16_t*)p)); }

__device__ __forceinline__ int swz(int row, int col) { return row * 128 + ((((col >> 3) ^ (row & 7)) << 4) | ((col & 7) << 1)); }
__device__ __forceinline__ int fragA_off(int m, int n) { const int f = (m >> 5) * 4 + (n >> 4), nn = n & 15, hi = (nn >> 2) & 1, j = (nn & 3) + 4 * (nn >> 3); return ((f * 64 + (m & 31) + 32 * hi) * 8 + j) * 2; }
__device__ __forceinline__ int accC_off(int m, int v) { const int mm = m & 31, hi = (mm >> 2) & 1, reg = (mm & 3) + 4 * (mm >> 3); return ((((v >> 5) * 2 + (m >> 5)) * 64 + (v & 31) + 32 * hi) * 16 + reg) * 2; }
__device__ __forceinline__ unsigned char* slot16(unsigned char* arr, int t0, int h, int o) { return arr + (size_t)(t0 + (o >> 7)) * (RW * 2) + h * 128 + (o & 127); }
__device__ __forceinline__ unsigned char* slot32(unsigned char* arr, int t0, int h, int o) { return arr + (size_t)(t0 + (o >> 8)) * (RW * 4) + h * 256 + (o & 255); }

constexpr int PL_LC = 0, PL_X1 = 16384, PL_Y1 = 32768, PL_VT = 49152, PL_KPT = 57344, PL_A2 = 65536, PL_AAB = 81920, PL_RHS = 98304, PL_BTP = 131072, PL_ARB = 0;

constexpr int FL_V6 = 0, FL_TMP = 49152, FL_XW = 53248, FL_XA = 61440, FL_XG = 69632, FL_GATE = 94208;
__device__ __forceinline__ int swzg(int row, int col) { return row * 384 + ((((col >> 3) ^ (row & 7)) << 4) | ((col & 7) << 1)); }
__device__ __forceinline__ int swzv(int row, int col) { return row * 768 + ((((col >> 3) ^ (row & 7)) << 4) | ((col & 7) << 1)); }
__device__ __forceinline__ void unpk8(const u32x4 p, float* o) {
#pragma unroll
    for (int e = 0; e < 4; ++e) { o[2 * e] = __uint_as_float(p[e] << 16); o[2 * e + 1] = __uint_as_float(p[e] & 0xffff0000u); } }
__device__ __forceinline__ void lerp8(const bf16* FR, const float* mu, int row, int col, bool first, float* o) {
    float c[8], p[8]; unpk8(*(const u32x4*)(FR + (size_t)row * FRP + col), c);
    if (first) {
#pragma unroll
        for (int e = 0; e < 8; ++e) p[e] = 0.f; } else unpk8(*(const u32x4*)(FR + (size_t)(row - 1) * FRP + col), p);
    const f32x4 m0 = *(const f32x4*)(mu + col), m1 = *(const f32x4*)(mu + col + 4);
#pragma unroll
    for (int e = 0; e < 8; ++e) o[e] = c[e] + (p[e] - c[e]) * (e < 4 ? m0[e] : m1[e - 4]);
}
__device__ __forceinline__ void phase_rwkv_pre(const Args& a, int layer, LAS unsigned char* lds, int tid, int G) {
    unsigned char* ws = a.ws;
    unsigned char* Rb = ws + RP_R; unsigned char* Kb = ws + RP_K; unsigned char* KKb = ws + RP_KK; unsigned char* BBb = ws + RP_BB; unsigned char* LWb = ws + RP_LW;
    const bf16* FR = (const bf16*)(ws + WS_FR); bf16* FXQ = (bf16*)(ws + WS_FXQ); const float* FF = (const float*)(ws + WS_FF);
    bf16* V = (bf16*)(ws + (layer == 0 ? WS_VF : RP_V)); const bf16* VF = (const bf16*)(ws + WS_VF); bf16* GG = (bf16*)(ws + RP_G);
    const bf16* LORA = (const bf16*)(ws + WS_LORA);
    const float* mu = a.in[7] + layer * 1440;
    LAS float* LC = (LAS float*)(lds + PL_LC); LAS float* AAB = (LAS float*)(lds + PL_AAB); LAS float* RHS = (LAS float*)(lds + PL_RHS);
    for (int item = blockIdx.x; item < BATCH * 256 * NH; item += G) {
        const int h = item % NH, bc = item / NH, t0 = (bc >> 8) * SEQ + (bc & 255) * 64, s0 = (bc & 255) * 64;
        int tid_l = tid; asm volatile("" : "+v"(tid_l));
        const int lane = tid_l & 63, wave = __builtin_amdgcn_readfirstlane(tid_l >> 6), r32 = lane & 31, hi = lane >> 5;
        const int t = tid_l >> 3, kc = tid_l & 7;
        __syncthreads();
#pragma unroll
        for (int it0 = 0; it0 < 5; ++it0) { const int idx = tid_l + 512 * it0; if (idx >= 64 * 36) break; const int tok = idx / 36, cg = idx % 36; float f[8]; lerp8(FR, mu, t0 + tok, 1152 + cg * 8, s0 + tok == 0, f);
            if (cg < 8) {
#pragma unroll
                for (int e = 0; e < 8; ++e) f[e] = tanhf(f[e]); }
            else if (cg >= 16) {
#pragma unroll
                for (int e = 0; e < 8; ++e) f[e] = sigmoidf_(f[e]); }
            const u32x4 w = (u32x4){cvtpk(f[0], f[1]), cvtpk(f[2], f[3]), cvtpk(f[4], f[5]), cvtpk(f[6], f[7])};
            if (cg < 8) *(LAS u32x4*)(lds + FL_XW + swz(tok, cg * 8)) = w; else if (cg < 16) *(LAS u32x4*)(lds + FL_XA + swz(tok, (cg - 8) * 8)) = w; else *(LAS u32x4*)(lds + FL_XG + swzg(tok, (cg - 16) * 8)) = w; }
        if (layer > 0) {
#pragma unroll
            for (int it0 = 0; it0 < 6; ++it0) { const int idx = tid_l + 512 * it0; const int tok = idx / 48, cg = idx % 48; float f[8]; lerp8(FR, mu, t0 + tok, 768 + cg * 8, s0 + tok == 0, f);
                *(LAS u32x4*)(lds + FL_V6 + swzv(tok, cg * 8)) = (u32x4){cvtpk(f[0], f[1]), cvtpk(f[2], f[3]), cvtpk(f[4], f[5]), cvtpk(f[6], f[7])}; }
            __syncthreads();
            if (wave < 2) { f32x16 acc;
#pragma unroll
                for (int r = 0; r < 16; ++r) acc[r] = 0.f;
                const bf16* v1t = LORA + 221184 + (size_t)r32 * 384 + 8 * hi;
#pragma unroll 4
                for (int ks = 0; ks < 24; ++ks) { const bf16x8 af = *(const LAS bf16x8*)(lds + FL_V6 + swzv(32 * wave + r32, (2 * ks + hi) * 8)); const bf16x8 bf = *(const bf16x8*)(v1t + 16 * ks);
                    acc = __builtin_amdgcn_mfma_f32_32x32x16_bf16(af, bf, acc, 0, 0, 0); }
#pragma unroll
                for (int r = 0; r < 16; ++r) *(LAS bf16*)(lds + FL_TMP + (32 * wave + crow(r, hi)) * 64 + r32 * 2) = (bf16)f2bf(acc[r]); }
        }
        __syncthreads();
#pragma unroll
        for (int jj = 0; jj < 2; ++jj) { const int mi = 2 * jj + (wave >> 2), rt = (wave >> 1) & 1, ct = wave & 1;
            if (mi == 3 && layer == 0) continue;
            f32x16 acc;
#pragma unroll
            for (int r = 0; r < 16; ++r) acc[r] = 0.f;
            const int nrow = layer * RW + h * HD + 32 * ct + r32;
            if (mi < 2) { const bf16* bp = LORA + (mi == 0 ? 0 : 49152) + (size_t)nrow * 64 + 8 * hi; const int abase = mi == 0 ? FL_XW : FL_XA;
#pragma unroll
                for (int ks = 0; ks < 4; ++ks) acc = __builtin_amdgcn_mfma_f32_32x32x16_bf16(*(const LAS bf16x8*)(lds + abase + swz(32 * rt + r32, (2 * ks + hi) * 8)), *(const bf16x8*)(bp + 16 * ks), acc, 0, 0, 0);
            } else if (mi == 2) { const bf16* bp = LORA + 98304 + (size_t)nrow * 160 + 8 * hi;
#pragma unroll
                for (int ks = 0; ks < 10; ++ks) acc = __builtin_amdgcn_mfma_f32_32x32x16_bf16(*(const LAS bf16x8*)(lds + FL_XG + swzg(32 * rt + r32, (2 * ks + hi) * 8)), *(const bf16x8*)(bp + 16 * ks), acc, 0, 0, 0);
            } else { const bf16* bp = LORA + 233472 + (size_t)(h * HD + 32 * ct + r32) * 32 + 8 * hi;
#pragma unroll
                for (int ks = 0; ks < 2; ++ks) acc = __builtin_amdgcn_mfma_f32_32x32x16_bf16(*(const LAS bf16x8*)(lds + FL_TMP + (32 * rt + r32) * 64 + (2 * ks + hi) * 16), *(const bf16x8*)(bp + 16 * ks), acc, 0, 0, 0); }
            LAS float* outp = (LAS float*)(lds + (mi == 3 ? FL_GATE : mi * 16384));
#pragma unroll
            for (int r = 0; r < 16; ++r) outp[(32 * rt + crow(r, hi)) * 64 + 32 * ct + r32] = acc[r]; }
        __syncthreads();
        float rr[8], kp[8], kn[8], bb[8]; u32x4 v8;
        { const int j0 = h * HD + kc * 8; const bool first = (s0 + t == 0); float kr[8], vv[8];
          lerp8(FR, mu, t0 + t, j0, first, rr); lerp8(FR, mu, t0 + t, RW + j0, first, kr); lerp8(FR, mu, t0 + t, 2 * RW + j0, first, vv);
          const float* w0 = a.in[8] + layer * RW + j0; const float* a0 = a.in[10] + layer * RW + j0; const float* k_k = a.in[16] + layer * RW + j0; const float* k_a = a.in[17] + layer * RW + j0; const float* r_k = a.in[18] + layer * RW + j0;
          const LAS float* o0 = (const LAS float*)(lds) + t * 64 + kc * 8; const LAS float* o1 = (const LAS float*)(lds + 16384) + t * 64 + kc * 8; const LAS float* o2 = (const LAS float*)(lds + 32768) + t * 64 + kc * 8; const LAS float* o3 = (const LAS float*)(lds + FL_GATE) + t * 64 + kc * 8;
          float lwv[8], av[8], gg[8];
#pragma unroll
          for (int e = 0; e < 8; ++e) { lwv[e] = -0.6065306597126334f * sigmoidf_(w0[e] + o0[e]); av[e] = sigmoidf_(a0[e] + o1[e]); gg[e] = o2[e]; }
          if (layer > 0) { float vf[8]; unpk8(*(const u32x4*)(VF + (size_t)(t0 + t) * RW + j0), vf); const float* v0 = a.in[13] + j0;
#pragma unroll
              for (int e = 0; e < 8; ++e) vv[e] = vv[e] + (vf[e] - vv[e]) * sigmoidf_(v0[e] + o3[e]); }
          float ss = 0.f, bs = 0.f;
#pragma unroll
          for (int e = 0; e < 8; ++e) { kn[e] = kr[e] * k_k[e]; ss += kn[e] * kn[e]; kp[e] = kr[e] * (1.0f + (av[e] - 1.0f) * k_a[e]); bs += rr[e] * kp[e] * r_k[e]; }
          ss += __shfl_xor(ss, 1); ss += __shfl_xor(ss, 2); ss += __shfl_xor(ss, 4); bs += __shfl_xor(bs, 1); bs += __shfl_xor(bs, 2); bs += __shfl_xor(bs, 4);
          const float inv = 1.0f / fmaxf(sqrtf(ss), 1e-12f);
#pragma unroll
          for (int e = 0; e < 8; ++e) { kn[e] *= inv; bb[e] = kn[e] * av[e]; }
          if (kc == 0) ((float*)(ws + WS_BONUS))[(size_t)(t0 + t) * NH + h] = bs;
          v8 = (u32x4){cvtpk(vv[0], vv[1]), cvtpk(vv[2], vv[3]), cvtpk(vv[4], vv[5]), cvtpk(vv[6], vv[7])};
          *(u32x4*)(V + (size_t)(t0 + t) * RW + j0) = v8;
          *(u32x4*)(GG + (size_t)(t0 + t) * RW + j0) = (u32x4){cvtpk(gg[0], gg[1]), cvtpk(gg[2], gg[3]), cvtpk(gg[4], gg[5]), cvtpk(gg[6], gg[7])};
          *(LAS f32x4*)(LC + t * 64 + kc * 8) = (f32x4){lwv[0], lwv[1], lwv[2], lwv[3]}; *(LAS f32x4*)(LC + t * 64 + kc * 8 + 4) = (f32x4){lwv[4], lwv[5], lwv[6], lwv[7]};
        }
        { const float* q_g = a.in[21] + layer * HD + kc * 8; const float* k_g = a.in[22] + layer * HD + kc * 8;
          bf16* qp = FXQ + (size_t)(t0 + t) * FXP + h * HD + kc * 8; float q8[8], k8f[8]; unpk8(*(const u32x4*)qp, q8); unpk8(*(const u32x4*)(qp + RW), k8f);
          float sq = 0.f, sk = 0.f;
#pragma unroll
          for (int e = 0; e < 8; ++e) { sq += q8[e] * q8[e]; sk += k8f[e] * k8f[e]; }
          sq += __shfl_xor(sq, 1); sq += __shfl_xor(sq, 2); sq += __shfl_xor(sq, 4); sk += __shfl_xor(sk, 1); sk += __shfl_xor(sk, 2); sk += __shfl_xor(sk, 4);
          const float rq = rsqrtf(sq * (1.f / HD) + RMS_EPS) * QSCALE, rk = rsqrtf(sk * (1.f / HD) + RMS_EPS);
#pragma unroll
          for (int e = 0; e < 8; ++e) { q8[e] *= rq * q_g[e]; k8f[e] *= rk * k_g[e]; }
          *(u32x4*)qp = (u32x4){cvtpk(q8[0], q8[1]), cvtpk(q8[2], q8[3]), cvtpk(q8[4], q8[5]), cvtpk(q8[6], q8[7])};
          *(u32x4*)(qp + RW) = (u32x4){cvtpk(k8f[0], k8f[1]), cvtpk(k8f[2], k8f[3]), cvtpk(k8f[4], k8f[5]), cvtpk(k8f[6], k8f[7])};
          if (tid_l < 64) { const float x = FF[(size_t)(t0 + tid_l) * 8 + h] + a.in[23][layer * NH + h];
              ((float*)(ws + WS_LF))[(size_t)((bc >> 8) * NH + h) * SEQ + s0 + tid_l] = fminf(x, 0.f) - log1pf(__expf(-fabsf(x))); } }
        __syncthreads();
        { const int k2 = tid_l & 63, tg = tid_l >> 6; float pv[8]; float run = 0.f; LAS float* GT = (LAS float*)(lds + PL_AAB);
#pragma unroll
          for (int i = 0; i < 8; ++i) { run += LC[(tg * 8 + i) * 64 + k2]; pv[i] = run; }
          GT[tg * 64 + k2] = run;
          __syncthreads();
          float base = 0.f;
#pragma unroll
          for (int g2 = 0; g2 < 7; ++g2) base += (g2 < tg) ? GT[g2 * 64 + k2] : 0.f;
#pragma unroll
          for (int i = 0; i < 8; ++i) LC[(tg * 8 + i) * 64 + k2] = pv[i] + base; }
        __syncthreads();
        {
            float at[8], bt[8], kt[8], rt[8], btp[8], ktp[8];
#pragma unroll
            for (int e = 0; e < 8; ++e) { const int k = kc * 8 + e; const float lc = LC[t * 64 + k], lp = t ? LC[(t - 1) * 64 + k] : 0.f, le = LC[63 * 64 + k];
                at[e] = -kn[e] * __expf(lp); const float en = __expf(-lc); bt[e] = bb[e] * en; kt[e] = kp[e] * en; rt[e] = rr[e] * __expf(lc); const float ee = __expf(le - lc); btp[e] = bb[e] * ee; ktp[e] = kp[e] * ee;
                if (t == 63) ((float*)(ws + WS_PC))[(size_t)item * 64 + k] = __expf(le); }
            u32x4 w;
            w.x = cvtpk(at[0], at[1]); w.y = cvtpk(at[2], at[3]); w.z = cvtpk(at[4], at[5]); w.w = cvtpk(at[6], at[7]); *(LAS u32x4*)(lds + PL_X1 + swz(t, kc * 8)) = w;
            const u32x4 wr_ = (u32x4){cvtpk(rt[0], rt[1]), cvtpk(rt[2], rt[3]), cvtpk(rt[4], rt[5]), cvtpk(rt[6], rt[7])}; *(LAS u32x4*)(lds + PL_X1 + swz(64 + t, kc * 8)) = wr_;
            w.x = cvtpk(bt[0], bt[1]); w.y = cvtpk(bt[2], bt[3]); w.z = cvtpk(bt[4], bt[5]); w.w = cvtpk(bt[6], bt[7]); *(LAS u32x4*)(lds + PL_Y1 + swz(t, kc * 8)) = w;
            w.x = cvtpk(kt[0], kt[1]); w.y = cvtpk(kt[2], kt[3]); w.z = cvtpk(kt[4], kt[5]); w.w = cvtpk(kt[6], kt[7]); *(LAS u32x4*)(lds + PL_Y1 + swz(64 + t, kc * 8)) = w;
            *(LAS f32x4*)(RHS + t * 128 + kc * 8) = (f32x4){at[0], at[1], at[2], at[3]}; *(LAS f32x4*)(RHS + t * 128 + kc * 8 + 4) = (f32x4){at[4], at[5], at[6], at[7]};
#pragma unroll
            for (int e = 0; e < 8; ++e) { const int k = kc * 8 + e;
                *(LAS bf16*)(lds + PL_VT + swz(k, t)) = (bf16)((e & 1) ? (v8[e >> 1] >> 16) : (v8[e >> 1] & 0xffffu));
                *(LAS bf16*)(lds + PL_KPT + swz(k, t)) = (bf16)f2bf(ktp[e]);
                *(LAS bf16*)(lds + PL_BTP + k * 128 + t * 2) = (bf16)f2bf(btp[e]); }
            { const int o0 = fragA_off(t, kc * 8), o1 = fragA_off(t, kc * 8 + 4);
              *(u32x2*)slot16(KKb, t0, h, o0) = (u32x2){wr_.x, wr_.y}; *(u32x2*)slot16(KKb, t0, h, o1) = (u32x2){wr_.z, wr_.w}; }
        }
        __syncthreads();
        {
            const int rt4 = wave >> 1;
#pragma unroll
            for (int cc = 0; cc < 2; ++cc) { const int ct = 2 * (wave & 1) + cc;
                f32x16 acc;
#pragma unroll
                for (int r = 0; r < 16; ++r) acc[r] = 0.f;
#pragma unroll
                for (int ks = 0; ks < 4; ++ks) { const bf16x8 af = *(const LAS bf16x8*)(lds + PL_X1 + swz(32 * rt4 + r32, (2 * ks + hi) * 8)); const bf16x8 bf = *(const LAS bf16x8*)(lds + PL_Y1 + swz(32 * ct + r32, (2 * ks + hi) * 8));
                    acc = __builtin_amdgcn_mfma_f32_32x32x16_bf16(af, bf, acc, 0, 0, 0); }
                const int i = 32 * (ct & 1) + r32;
#pragma unroll
                for (int r = 0; r < 16; ++r) { const int tt = 32 * (rt4 & 1) + crow(r, hi);
                    if (rt4 < 2) { const float v = (i < tt) ? acc[r] : 0.f; if (ct < 2) AAB[tt * 64 + i] = v; else *(LAS bf16*)(lds + PL_A2 + swz(tt, i)) = (bf16)f2bf(v); }
                    else { const float v = (i <= tt) ? acc[r] : 0.f; if (ct < 2) *(LAS bf16*)(lds + PL_ARB + tt * 128 + i * 2) = (bf16)f2bf(v); else *(LAS bf16*)(lds + PL_A2 + swz(64 + tt, i)) = (bf16)f2bf(v); } }
            }
        }
        __syncthreads();
        {
            const int rt4 = wave >> 1, ct = wave & 1;
            f32x16 acc;
#pragma unroll
            for (int r = 0; r < 16; ++r) acc[r] = 0.f;
#pragma unroll
            for (int is = 0; is < 4; ++is) { const bf16x8 af = *(const LAS bf16x8*)(lds + PL_A2 + swz(32 * rt4 + r32, (2 * is + hi) * 8)); const bf16x8 bf = *(const LAS bf16x8*)(lds + PL_VT + swz(32 * ct + r32, (2 * is + hi) * 8));
                acc = __builtin_amdgcn_mfma_f32_32x32x16_bf16(af, bf, acc, 0, 0, 0); }
            if (rt4 < 2) {
#pragma unroll
                for (int r = 0; r < 16; ++r) RHS[(32 * rt4 + crow(r, hi)) * 128 + 64 + 32 * ct + r32] = acc[r];
            } else { u32x4 w0, w1; w0.x = cvtpk(acc[0], acc[1]); w0.y = cvtpk(acc[2], acc[3]); w0.z = cvtpk(acc[4], acc[5]); w0.w = cvtpk(acc[6], acc[7]); w1.x = cvtpk(acc[8], acc[9]); w1.y = cvtpk(acc[10], acc[11]); w1.z = cvtpk(acc[12], acc[13]); w1.w = cvtpk(acc[14], acc[15]);
                unsigned char* y0 = ws + WS_Y0 + (size_t)item * 8192 + ((ct * 2 + (rt4 - 2)) * 64 + lane) * 32; *(u32x4*)y0 = w0; *(u32x4*)(y0 + 16) = w1; }
            if (wave < 4) { const int kt2 = wave >> 1, vh = wave & 1;
#pragma unroll
                for (int r = 0; r < 16; ++r) acc[r] = 0.f;
#pragma unroll
                for (int ts = 0; ts < 4; ++ts) { const bf16x8 af = *(const LAS bf16x8*)(lds + PL_KPT + swz(32 * kt2 + r32, (2 * ts + hi) * 8)); const bf16x8 bf = *(const LAS bf16x8*)(lds + PL_VT + swz(32 * vh + r32, (2 * ts + hi) * 8));
                    acc = __builtin_amdgcn_mfma_f32_32x32x16_bf16(af, bf, acc, 0, 0, 0); }
                u32x4 w0, w1; w0.x = cvtpk(acc[0], acc[1]); w0.y = cvtpk(acc[2], acc[3]); w0.z = cvtpk(acc[4], acc[5]); w0.w = cvtpk(acc[6], acc[7]); w1.x = cvtpk(acc[8], acc[9]); w1.y = cvtpk(acc[10], acc[11]); w1.z = cvtpk(acc[12], acc[13]); w1.w = cvtpk(acc[14], acc[15]);
                const int o = 8192 + ((vh * 2 + kt2) * 64 + lane) * 32; *(u32x4*)slot32(LWb, t0, h, o) = w0; *(u32x4*)slot32(LWb, t0, h, o + 16) = w1; }
        }
        __syncthreads();
        if (tid < 128) { const int c = tid; float x[64];
            LAS float* AABp = AAB; asm volatile("" : "+v"(AABp));
            LAS float* RHSc = RHS + c; asm volatile("" : "+v"(RHSc));
#pragma unroll
            for (int tt = 0; tt < 64; ++tt) { float s = RHSc[tt * 128];
#pragma unroll
                for (int i4 = 0; i4 < (tt + 3) / 4; ++i4) { const f32x4 av = *(const LAS f32x4*)(AABp + tt * 64 + i4 * 4);
                    s += av[0] * x[i4 * 4]; if (i4 * 4 + 1 < tt) s += av[1] * x[i4 * 4 + 1]; if (i4 * 4 + 2 < tt) s += av[2] * x[i4 * 4 + 2]; if (i4 * 4 + 3 < tt) s += av[3] * x[i4 * 4 + 3]; }
                x[tt] = s; RHSc[tt * 128] = s; }
        }
        __syncthreads();
        { const int f = tid_l >> 6, l2 = tid_l & 63, m = 32 * (f >> 2) + (l2 & 31), n0 = 16 * (f & 3) + 4 * (l2 >> 5);
          u32x4 w; w.x = cvtpk(RHS[m * 128 + n0], RHS[m * 128 + n0 + 1]); w.y = cvtpk(RHS[m * 128 + n0 + 2], RHS[m * 128 + n0 + 3]); w.z = cvtpk(RHS[m * 128 + n0 + 8], RHS[m * 128 + n0 + 9]); w.w = cvtpk(RHS[m * 128 + n0 + 10], RHS[m * 128 + n0 + 11]);
          *(u32x4*)slot16(Rb, t0, h, tid_l * 16) = w;
          const u32x2 b0 = *(const LAS u32x2*)(lds + PL_BTP + m * 128 + n0 * 2), b1 = *(const LAS u32x2*)(lds + PL_BTP + m * 128 + (n0 + 8) * 2);
          *(u32x4*)slot16(Kb, t0, h, tid_l * 16) = (u32x4){b0.x, b0.y, b1.x, b1.y};
          const u32x2 a0 = *(const LAS u32x2*)(lds + PL_ARB + m * 128 + n0 * 2), a1 = *(const LAS u32x2*)(lds + PL_ARB + m * 128 + (n0 + 8) * 2);
          *(u32x4*)slot16(BBb, t0, h, tid_l * 16) = (u32x4){a0.x, a0.y, a1.x, a1.y};
          const int half = tid_l & 1, l3 = (tid_l >> 1) & 63, tl = tid_l >> 7, mt = tl & 1, vh = tl >> 1, v = 64 + 32 * vh + (l3 & 31), rb = 32 * mt + 16 * half + 4 * (l3 >> 5);
          w.x = cvtpk(RHS[rb * 128 + v], RHS[(rb + 1) * 128 + v]); w.y = cvtpk(RHS[(rb + 2) * 128 + v], RHS[(rb + 3) * 128 + v]); w.z = cvtpk(RHS[(rb + 8) * 128 + v], RHS[(rb + 9) * 128 + v]); w.w = cvtpk(RHS[(rb + 10) * 128 + v], RHS[(rb + 11) * 128 + v]);
          *(u32x4*)slot32(LWb, t0, h, tid_l * 16) = w; }
    }
}

__device__ __forceinline__ bf16x8 pack8(const f32x16& x, int s) { u32x4 w; w.x = cvtpk(x[8 * s], x[8 * s + 1]); w.y = cvtpk(x[8 * s + 2], x[8 * s + 3]); w.z = cvtpk(x[8 * s + 4], x[8 * s + 5]); w.w = cvtpk(x[8 * s + 6], x[8 * s + 7]); return __builtin_bit_cast(bf16x8, w); }
__device__ __forceinline__ f32x16 unpack16(const u32x4 a, const u32x4 b) { f32x16 o;
#pragma unroll
    for (int e = 0; e < 4; ++e) { o[2 * e] = __uint_as_float(a[e] << 16); o[2 * e + 1] = __uint_as_float(a[e] & 0xffff0000u); o[8 + 2 * e] = __uint_as_float(b[e] << 16); o[8 + 2 * e + 1] = __uint_as_float(b[e] & 0xffff0000u); }
    return o; }
__device__ __forceinline__ const unsigned char* cd_group(unsigned char* ws, int b, int h, int c, int g, int off16, int off32, int offl) {
    const int seg = g >> 3, gi = g & 7, t0 = b * SEQ + c * 64; const size_t item = (size_t)(b * 256 + c) * NH + h;
    if (seg < 4) return ws + (seg == 0 ? RP_R : seg == 1 ? RP_K : seg == 2 ? RP_KK : RP_BB) + (size_t)(t0 + gi * 8) * (RW * 2) + h * 128 + off16;
    if (seg < 6) return ws + RP_LW + (size_t)(t0 + (seg - 4) * 32 + gi * 4) * (RW * 4) + h * 256 + off32;
    if (seg == 6) return ws + WS_Y0 + item * 8192 + gi * 1024 + offl;
    return ws + WS_PC + item * 256 + (offl & 255);
}
constexpr int CD_BYTES = 58368, CD_GROUPS = 57;
__device__ __forceinline__ void rwkv_scan_chunked(const Args& a, int layer, int bh, LAS unsigned char* lds, int tid) {
    unsigned char* ws = a.ws; const int b = bh / NH, h = bh % NH, lane = tid & 63, wave = __builtin_amdgcn_readfirstlane(tid >> 6), r32 = lane & 31, hi = lane >> 5, vh = wave;
    bf16* YB = (bf16*)(ws + WS_YB);
    const int lw = wave - 2;
    const int off16 = (lane >> 3) * (RW * 2) + (lane & 7) * 16, off32 = (lane >> 4) * (RW * 4) + (lane & 15) * 16, offl = lane * 16;
    u32x4 stg[10];
    f32x16 sT[2];
#pragma unroll
    for (int r = 0; r < 16; ++r) { sT[0][r] = 0.f; sT[1][r] = 0.f; }
    __syncthreads();
    if (wave >= 2) {
#pragma unroll
        for (int k = 0; k < 10; ++k) { const int g = lw + 6 * k; if (g < CD_GROUPS) stg[k] = *(const u32x4*)cd_group(ws, b, h, 0, g, off16, off32, offl); }
#pragma unroll
        for (int k = 0; k < 10; ++k) { const int g = lw + 6 * k; if (g < CD_GROUPS) *(LAS u32x4*)(lds + g * 1024 + lane * 16) = stg[k]; }
#pragma unroll
        for (int k = 0; k < 10; ++k) { const int g = lw + 6 * k; if (g < CD_GROUPS) stg[k] = *(const u32x4*)cd_group(ws, b, h, 1, g, off16, off32, offl); }
    }
    __syncthreads();
    for (int c = 0; c < 256; ++c) {
        if (wave >= 2) {
            if (c + 1 < 256) { LAS unsigned char* dst = lds + ((c + 1) & 1) * CD_BYTES;
#pragma unroll
                for (int k = 0; k < 10; ++k) { const int g = lw + 6 * k; if (g < CD_GROUPS) *(LAS u32x4*)(dst + g * 1024 + lane * 16) = stg[k]; } }
            if (c + 2 < 256) { int c2 = c + 2; asm volatile("" : "+s"(c2));
#pragma unroll
                for (int k = 0; k < 10; ++k) { const int g = lw + 6 * k; if (g < CD_GROUPS) stg[k] = *(const u32x4*)cd_group(ws, b, h, c2, g, off16, off32, offl); } }
        } else {
            LAS const unsigned char* buf = lds + (c & 1) * CD_BYTES; const int t0 = b * SEQ + c * 64;
#define FRAG(seg, f) (*(const LAS bf16x8*)(buf + (seg) * 8192 + ((f) * 64 + lane) * 16))
#define CTILE(seg, tile) unpack16(*(const LAS u32x4*)(buf + (seg) * 8192 + ((vh * 2 + (tile)) * 64 + lane) * 32), *(const LAS u32x4*)(buf + (seg) * 8192 + ((vh * 2 + (tile)) * 64 + lane) * 32 + 16))
            bf16x8 s0f[4];
#pragma unroll
            for (int ks = 0; ks < 4; ++ks) s0f[ks] = pack8(sT[ks >> 1], ks & 1);
            f32x16 u[2], y[2];
#pragma unroll
            for (int ti = 0; ti < 2; ++ti) { u[ti] = CTILE(4, ti); y[ti] = CTILE(6, ti);
#pragma unroll
                for (int ks = 0; ks < 4; ++ks) { u[ti] = __builtin_amdgcn_mfma_f32_32x32x16_bf16(FRAG(0, ti * 4 + ks), s0f[ks], u[ti], 0, 0, 0); y[ti] = __builtin_amdgcn_mfma_f32_32x32x16_bf16(FRAG(2, ti * 4 + ks), s0f[ks], y[ti], 0, 0, 0); } }
            bf16x8 uf[4];
#pragma unroll
            for (int ts = 0; ts < 4; ++ts) uf[ts] = pack8(u[ts >> 1], ts & 1);
#pragma unroll
            for (int ki = 0; ki < 2; ++ki) { const f32x16 kv = CTILE(5, ki);
#pragma unroll
                for (int g = 0; g < 4; ++g) { const f32x4 p4 = *(const LAS f32x4*)(buf + 57344 + (32 * ki + 8 * g + 4 * hi) * 4);
#pragma unroll
                    for (int e = 0; e < 4; ++e) sT[ki][4 * g + e] = sT[ki][4 * g + e] * p4[e] + kv[4 * g + e]; }
#pragma unroll
                for (int ts = 0; ts < 4; ++ts) sT[ki] = __builtin_amdgcn_mfma_f32_32x32x16_bf16(FRAG(1, ki * 4 + ts), uf[ts], sT[ki], 0, 0, 0); }
#pragma unroll
            for (int ti = 0; ti < 2; ++ti) {
#pragma unroll
                for (int ts = 0; ts < 4; ++ts) y[ti] = __builtin_amdgcn_mfma_f32_32x32x16_bf16(FRAG(3, ti * 4 + ts), uf[ts], y[ti], 0, 0, 0);
#pragma unroll
                for (int r = 0; r < 16; ++r) YB[(size_t)(t0 + 32 * ti + crow(r, hi)) * RW + h * HD + vh * 32 + r32] = (bf16)f2bf(y[ti][r]); }
#undef FRAG
#undef CTILE
        }
        __syncthreads();
    }
}

__device__ __forceinline__ void attn_unit(const Args& a, int b, int h, int qb, float lim, LAS unsigned char* lds, int tid) {
    unsigned char* ws = a.ws;
    const bf16* FXQ = (const bf16*)(ws + WS_FXQ); const float* CUM = (const float*)(ws + WS_CUM) + (size_t)(b * NH + h) * SEQ; bf16* MIX = (bf16*)(ws + WS_MIX);
    const int lane = tid & 63, wid = tid >> 6, r32 = lane & 31, hi = lane >> 5;
    const size_t rowbase = (size_t)b * SEQ; const int q0 = qb * 256, qrow = q0 + wid * 32 + r32;
    bf16x8 qf[4];
    { const bf16* qp = FXQ + (rowbase + qrow) * FXP + h * HD + hi * 8;
#pragma unroll
      for (int ks = 0; ks < 4; ++ks) qf[ks] = *(const bf16x8*)(qp + ks * 16); }
    f32x16 o0, o1;
#pragma unroll
    for (int r = 0; r < 16; ++r) { o0[r] = 0.f; o1[r] = 0.f; }
    float m = -INFINITY, l = 0.f;
    const int NT = (q0 + 256) / 64; const float cref = CUM[q0];
    LAS float* ckf = (LAS float*)(lds + 16384);
    const int jlo = __syncthreads_count((tid < 4 * qb) && (cref - CUM[tid * 64 + 63] < -lim));
    for (int kt = jlo; kt < NT; ++kt) {
        __syncthreads();
        { const int key = tid >> 3, ch = tid & 7; const size_t grow = rowbase + (size_t)kt * 64 + key;
          const u32x4 kv = *(const u32x4*)(FXQ + grow * FXP + RW + h * HD + ch * 8);
          const u32x4 vv = *(const u32x4*)(FXQ + grow * FXP + 2 * RW + h * HD + ch * 8);
          *(LAS u32x4*)(lds + key * 128 + ((ch ^ (key & 7)) * 16)) = kv;
          *(LAS u32x4*)(lds + 8192 + key * 128 + ch * 16) = vv;
          if (tid < 64) ckf[tid] = (CUM[kt * 64 + tid] - cref) * LOG2E; }
        __syncthreads();
        if (kt * 64 > q0 + wid * 32 + 31) continue;
        f32x16 s0, s1;
#pragma unroll
        for (int r = 0; r < 16; ++r) { s0[r] = 0.f; s1[r] = 0.f; }
#pragma unroll
        for (int ks = 0; ks < 4; ++ks) { const int co = ((2 * ks + hi) ^ (r32 & 7)) * 16;
            const bf16x8 a0 = *(const LAS bf16x8*)(lds + r32 * 128 + co); const bf16x8 a1 = *(const LAS bf16x8*)(lds + (32 + r32) * 128 + co);
            s0 = __builtin_amdgcn_mfma_f32_32x32x16_bf16(a0, qf[ks], s0, 0, 0, 0); s1 = __builtin_amdgcn_mfma_f32_32x32x16_bf16(a1, qf[ks], s1, 0, 0, 0); }
        const bool diag = (kt * 64 + 63 > q0 + wid * 32);
        float mx = -INFINITY;
#pragma unroll
        for (int r = 0; r < 16; ++r) { const int k0 = crow(r, hi); float v0 = s0[r] - ckf[k0], v1 = s1[r] - ckf[32 + k0];
            if (diag) { if (kt * 64 + k0 > qrow) v0 = -INFINITY; if (kt * 64 + 32 + k0 > qrow) v1 = -INFINITY; }
            s0[r] = v0; s1[r] = v1; mx = fmaxf(mx, fmaxf(v0, v1)); }
        mx = fmaxf(mx, __shfl_xor(mx, 32));
        const float mnew = fmaxf(m, mx), alpha = exp2f(m - mnew); m = mnew;
        float ps = 0.f;
#pragma unroll
        for (int r = 0; r < 16; ++r) { s0[r] = exp2f(s0[r] - m); s1[r] = exp2f(s1[r] - m); ps += s0[r] + s1[r]; }
        l = l * alpha + ps;
#pragma unroll
        for (int r = 0; r < 16; ++r) { o0[r] *= alpha; o1[r] *= alpha; }
        bf16x8 pf[4];
#pragma unroll
        for (int s = 0; s < 2; ++s) { u32x4 w0, w1;
            w0.x = cvtpk(s0[8 * s], s0[8 * s + 1]); w0.y = cvtpk(s0[8 * s + 2], s0[8 * s + 3]); w0.z = cvtpk(s0[8 * s + 4], s0[8 * s + 5]); w0.w = cvtpk(s0[8 * s + 6], s0[8 * s + 7]);
            w1.x = cvtpk(s1[8 * s], s1[8 * s + 1]); w1.y = cvtpk(s1[8 * s + 2], s1[8 * s + 3]); w1.z = cvtpk(s1[8 * s + 4], s1[8 * s + 5]); w1.w = cvtpk(s1[8 * s + 6], s1[8 * s + 7]);
            pf[s] = __builtin_bit_cast(bf16x8, w0); pf[2 + s] = __builtin_bit_cast(bf16x8, w1); }
        const int q4 = (lane & 15) >> 2, p4 = lane & 3;
        LAS const unsigned char* vb = lds + 8192 + (4 * hi + q4) * 128 + (16 * ((lane >> 4) & 1) + 4 * p4) * 2;
#pragma unroll
        for (int s = 0; s < 4; ++s) {
#pragma unroll
            for (int db = 0; db < 2; ++db) { const s16x4 lo = vtr(vb + s * 16 * 128 + db * 64), hh = vtr(vb + s * 16 * 128 + 8 * 128 + db * 64);
                const bf16x8 vf = (bf16x8){lo[0], lo[1], lo[2], lo[3], hh[0], hh[1], hh[2], hh[3]};
                if (db == 0) o0 = __builtin_amdgcn_mfma_f32_32x32x16_bf16(vf, pf[s], o0, 0, 0, 0); else o1 = __builtin_amdgcn_mfma_f32_32x32x16_bf16(vf, pf[s], o1, 0, 0, 0); } }
    }
    l += __shfl_xor(l, 32);
    const float inv = 1.0f / l;
    const bf16* gp = FXQ + (rowbase + qrow) * FXP + 3 * RW + h * HD; bf16* op = MIX + (rowbase + qrow) * DM + RW + h * HD;
#pragma unroll
    for (int db = 0; db < 2; ++db)
#pragma unroll
        for (int g = 0; g < 4; ++g) { const int d = 32 * db + 8 * g + 4 * hi; const u32x2 gv = *(const u32x2*)(gp + d);
            const float g0 = sigmoidf_(__uint_as_float(gv.x << 16)), g1 = sigmoidf_(__uint_as_float(gv.x & 0xffff0000u)), g2 = sigmoidf_(__uint_as_float(gv.y << 16)), g3 = sigmoidf_(__uint_as_float(gv.y & 0xffff0000u));
            const float x0 = (db == 0 ? o0[4 * g] : o1[4 * g]) * inv * g0, x1 = (db == 0 ? o0[4 * g + 1] : o1[4 * g + 1]) * inv * g1, x2 = (db == 0 ? o0[4 * g + 2] : o1[4 * g + 2]) * inv * g2, x3 = (db == 0 ? o0[4 * g + 3] : o1[4 * g + 3]) * inv * g3;
            u32x2 w; w.x = cvtpk(x0, x1); w.y = cvtpk(x2, x3); *(u32x2*)(op + d) = w; }
}

__device__ __forceinline__ void phase_pool(const Args& a, int layer, int gw, int NGW, int lane) {
    unsigned char* ws = a.ws; const bf16* PL = (const bf16*)(ws + WS_PL); bf16* MIX = (bf16*)(ws + WS_MIX);
    const float* pw = a.in[24] + (size_t)layer * 4 * 64 * 64; const float* psc = a.in[25] + layer * 256;
    for (int it = gw; it < TT * 4; it += NGW) { const int tok = it >> 2, g = it & 3, win = 2 << g, s = tok % SEQ, n = (s + 1 < win) ? s + 1 : win;
        float sum = 0.f, cur = 0.f;
        for (int i = 0; i < n; ++i) { const float v = bf2f(PL[(size_t)(tok - i) * PLP + g * 64 + lane]); if (i == 0) cur = v; sum += v; }
        const float u = sum / (float)n - cur; const float* wg = pw + g * 4096 + lane; float y = 0.f;
#pragma unroll
        for (int c = 0; c < 64; ++c) y += rl(u, c) * wg[c * 64];
        MIX[(size_t)tok * DM + 768 + g * 64 + lane] = (bf16)f2bf(y * psc[g * 64 + lane]); }
}

__device__ __forceinline__ void phase_rwkv_out(const Args& a, int layer, int gw, int NGW, int lane) {
    unsigned char* ws = a.ws;
    const bf16* V = (const bf16*)(ws + (layer == 0 ? WS_VF : RP_V)); const bf16* YB = (const bf16*)(ws + WS_YB); const float* BONUS = (const float*)(ws + WS_BONUS);
    const bf16* GG = (const bf16*)(ws + RP_G); bf16* MIX = (bf16*)(ws + WS_MIX);
    const float* ln_w = a.in[19] + layer * RW; const float* ln_b = a.in[20] + layer * RW;
    for (int it = gw; it < TT * NH; it += NGW) { const int tok = it / NH, h = it % NH, c = h * HD + lane; const size_t o = (size_t)tok * RW + c;
        const float y = bf2f(YB[o]); const float mean = wave_sum(y) * (1.f / HD); const float d = y - mean; const float var = wave_sum(d * d) * (1.f / HD);
        const float yn = d * rsqrtf(var + GN_EPS) * ln_w[c] + ln_b[c];
        const float bonus = BONUS[it] * bf2f(V[o]);
        MIX[(size_t)tok * DM + c] = (bf16)f2bf((yn + bonus) * bf2f(GG[o])); }
}

__device__ __forceinline__ void phase_resnorm(const float* tmp, const float* xin, float* xout, const float* g1, const float* g2, bf16* hn, int gw, int NGW, int lane) {
    for (int m = gw; m < TT; m += NGW) {
        const f32x4* tr = (const f32x4*)(tmp + (size_t)m * DM) + lane; const f32x4* xr = (const f32x4*)(xin + (size_t)m * DM) + lane; f32x4* xo = (f32x4*)(xout + (size_t)m * DM) + lane;
        f32x4 v[4]; float s = 0.f;
#pragma unroll
        for (int j = 0; j < 4; ++j) { v[j] = tr[64 * j]; s += (v[j].x * v[j].x + v[j].y * v[j].y) + (v[j].z * v[j].z + v[j].w * v[j].w); }
        const float rs = rsqrtf(wave_sum(s) * (1.f / DM) + RMS_EPS); float s2 = 0.f;
#pragma unroll
        for (int j = 0; j < 4; ++j) { const f32x4 gg = ((const f32x4*)g1 + lane)[64 * j]; v[j] = xr[64 * j] + v[j] * rs * gg; xo[64 * j] = v[j];
            s2 += (v[j].x * v[j].x + v[j].y * v[j].y) + (v[j].z * v[j].z + v[j].w * v[j].w); }
        if (g2) { const float rs2 = rsqrtf(wave_sum(s2) * (1.f / DM) + RMS_EPS); unsigned long long* o8 = (unsigned long long*)(hn + (size_t)m * DM) + lane;
#pragma unroll
            for (int j = 0; j < 4; ++j) { const f32x4 gg = ((const f32x4*)g2 + lane)[64 * j];
                o8[64 * j] = (unsigned long long)pk2(v[j].x * rs2 * gg.x, v[j].y * rs2 * gg.y) | ((unsigned long long)pk2(v[j].z * rs2 * gg.z, v[j].w * rs2 * gg.w) << 32); } }
    }
}

constexpr int NPHASE = 1 + 10 * DEPTH;
__global__ void __launch_bounds__(512, 2) mega(Args a_unused) {
    extern __shared__ __attribute__((aligned(16))) unsigned char lds_raw[];
    int lo, hi; unsigned* barw; { const Args a0 = get_args(); lo = a0.lo; hi = a0.hi; barw = (unsigned*)(a0.ws + WS_CTL) + 4096; }
    volatile LAS unsigned* bst = (volatile LAS unsigned*)((LAS unsigned char*)lds_raw + LDS_BYTES - 64);
    if (threadIdx.x < 2) bst[threadIdx.x] = 0u;
    __syncthreads();
    const XcdBarrier xbar = xcd_barrier_post(barw, bst);
    for (int ph = lo; ph < hi; ++ph) {
        const Args a = get_args(); unsigned char* ws = a.ws;
        int tid = threadIdx.x; asm volatile("" : "+v"(tid));
        int bid = blockIdx.x, G = gridDim.x; asm volatile("" : "+s"(bid), "+s"(G));
        LAS unsigned char* lds = (LAS unsigned char*)lds_raw; asm volatile("" : "+s"(lds));
        const int lane = tid & 63, wave = __builtin_amdgcn_readfirstlane(tid >> 6), gw = bid * 8 + wave, NGW = G * 8;
        if (ph > lo) {
#if MK_SINGLE
            if (ph == lo + 1) cg::this_grid().sync(); else xcd_barrier(xbar);
#endif
        }
        if (ph == 0) { phase_prologue(a, lds, tid, G); continue; }
        const int layer = (ph - 1) / 10, sub = (ph - 1) % 10;
        const float* xin = layer == 0 ? a.in[0] : a.out;
        switch (sub) {
        case 0: { pg8::Gemm g{(const bf16*)(ws + WS_HN), (const bf16*)(ws + WS_WIN) + layer * WIN_L, TT, NIN, DM}; pg8::StaticOrder S; S.init(TT, NIN, G, bid);
                  pg8::EpiInProj E{(bf16*)(ws + WS_FR), (bf16*)(ws + WS_FXQ), (bf16*)(ws + WS_PL), (float*)(ws + WS_FF)};
                  pg8::gemm_phase<pg8::EpiInProj, pg8::StaticOrder, true, true>(lds, g, S, E); } break;
        case 1: phase_rwkv_pre(a, layer, lds, tid, G); break;
        case 2: phase_cumsum(a, lds, tid, G); break;
        case 3: {
            if (bid < BATCH * NH) { rwkv_scan_chunked(a, layer, bid, lds, tid); }
            else { const int nb = G - BATCH * NH, bi = bid - BATCH * NH;
                float gq = fabsf(a.in[21][layer * HD + lane]), gk = fabsf(a.in[22][layer * HD + lane]);
#pragma unroll
                for (int o = 1; o < 64; o <<= 1) { gq = fmaxf(gq, __shfl_xor(gq, o)); gk = fmaxf(gk, __shfl_xor(gk, o)); }
                const float lim = 30.0f + 2.0f * 8.0f * 1.02f * gq * gk;
                unsigned* ticket = (unsigned*)(ws + WS_CTL) + 64 + layer * 64; LAS int* tk = (LAS int*)(lds + 20480);
                for (;;) { __syncthreads(); if (tid == 0) *tk = (int)atomicAdd(ticket, 1u); __syncthreads(); const int u = *tk; if (u >= BATCH * NH * 64) break;
                    const int qb = 63 - u / (BATCH * NH), bh = u % (BATCH * NH); attn_unit(a, bh / NH, bh % NH, qb, lim, lds, tid); }
                phase_pool(a, layer, bi * 8 + wave, nb * 8, lane); }
        } break;
        case 4: phase_rwkv_out(a, layer, gw, NGW, lane); break;
        case 5: { pg8::Gemm g{(const bf16*)(ws + WS_MIX), (const bf16*)(ws + WS_WOUT) + layer * WOUT_L, TT, DM, DM}; pg8::StaticOrder S; S.init(TT, DM, G, bid);
                  pg8::EpiF32 E{(float*)(ws + WS_TMP), DM};
                  pg8::gemm_phase<pg8::EpiF32, pg8::StaticOrder, true, true>(lds, g, S, E); } break;
        case 6: phase_resnorm((const float*)(ws + WS_TMP), xin, a.out, a.in[2] + layer * DM, a.in[3] + layer * DM, (bf16*)(ws + WS_HN), gw, NGW, lane); break;
        case 7: { pg8::Gemm g{(const bf16*)(ws + WS_HN), (const bf16*)(ws + WS_WGU) + layer * WGU_L, TT, 2 * FFH, DM}; pg8::StaticOrder S; S.init(TT, 2 * FFH, G, bid);
                  pg8::EpiSwiglu E{(bf16*)(ws + WS_H)};
                  pg8::gemm_phase<pg8::EpiSwiglu, pg8::StaticOrder, true, true>(lds, g, S, E); } break;
        case 8: { pg8::Gemm g{(const bf16*)(ws + WS_H), (const bf16*)(ws + WS_WDN) + layer * WDN_L, TT, DM, FFH}; pg8::StaticOrder S; S.init(TT, DM, G, bid);
                  pg8::EpiF32 E{(float*)(ws + WS_TMP), DM};
                  pg8::gemm_phase<pg8::EpiF32, pg8::StaticOrder, true, true>(lds, g, S, E); } break;
        case 9: phase_resnorm((const float*)(ws + WS_TMP), a.out, a.out, a.in[4] + layer * DM, layer + 1 < DEPTH ? a.in[1] + (layer + 1) * DM : nullptr, (bf16*)(ws + WS_HN), gw, NGW, lane); break;
        }
    }
}

extern "C" void kernel_launch(void* const* d_in, const int* in_sizes, int n_in, void* d_out, int out_size, void* d_ws, size_t ws_size, hipStream_t stream) {
    static int grid = 0;
    if (grid == 0) {
        if (n_in != 28 || out_size != TT * DM || ws_size < WS_END) { fprintf(stderr, "kernel_launch: unexpected shapes (n_in %d out %d ws %zu)\n", n_in, out_size, ws_size); grid = -1; return; }
        int dev = 0, cus = 0, per_cu = 0;
        hipGetDevice(&dev); hipDeviceGetAttribute(&cus, hipDeviceAttributeMultiprocessorCount, dev);
        hipFuncSetAttribute((const void*)mega, hipFuncAttributeMaxDynamicSharedMemorySize, LDS_BYTES);
        hipOccupancyMaxActiveBlocksPerMultiprocessor(&per_cu, (const void*)mega, 512, LDS_BYTES);
        if (per_cu < 1) { fprintf(stderr, "kernel_launch: occupancy query says %d blocks per CU\n", per_cu); per_cu = 1; }
        (void)hipGetLastError();
        grid = cus * 1;
    }
    if (grid < 0) return;
    hipMemsetAsync((char*)d_ws + WS_CTL, 0, CTL_BYTES, stream);
    Args a{};
    for (int i = 0; i < 28; ++i) a.in[i] = (const float*)d_in[i];
    a.out = (float*)d_out; a.ws = (unsigned char*)d_ws;
#if MK_SINGLE
    a.lo = 0; a.hi = NPHASE;
    void* args[] = {&a};
    hipError_t e = hipLaunchCooperativeKernel((const void*)mega, dim3(grid), dim3(512), args, LDS_BYTES, stream);
    if (e != hipSuccess) fprintf(stderr, "cooperative launch failed: %s (grid %d)\n", hipGetErrorString(e), grid);
#else
    for (int ph = 0; ph < NPHASE; ++ph) { a.lo = ph; a.hi = ph + 1; hipLaunchKernelGGL(mega, dim3(grid), dim3(512), LDS_BYTES, stream, a); }
#endif
}
```
